# Optimizing an MI355X kernel written in HIP

```python
import math
import jax, jax.numpy as jnp
from jax import lax
import numpy as np

D_MODEL = 1024
BATCH = 16
SEQ = 256
DEPTH = 2
DEC_BATCH = 4
DEC_SEQ = 2048
PAST_LEN = 512

GRID_W = 64
GROUP_W = D_MODEL // 4
HEAD_DIM = 64
MLA_HEADS = GROUP_W // HEAD_DIM
MLA_NOPE = 64
MLA_ROPE = 32
MLA_VDIM = HEAD_DIM
MLA_KV_RANK = 128
MLA_QK = MLA_NOPE + MLA_ROPE
SWA_HEADS = GROUP_W // HEAD_DIM
SWA_KV_HEADS = 2
SWA_HD = HEAD_DIM
SWA_WINDOW = 128
SWA_BLOCK = 128
GDN_HEADS = GROUP_W // HEAD_DIM
GDN_DK = HEAD_DIM
GDN_DV = HEAD_DIM
GDN_CONV = 3
GDN_CHUNK = 64
HY_WIDTH = GROUP_W
HY_ORDER = 2
HY_CONV = 3
HY_BANDS = 8
HY_EMB = 1 + 2 * HY_BANDS
HY_FF = 64
D_FF = 4 * D_MODEL
Q_BLOCK = 128
ROPE_BASE = 10000.0
EPS = 1e-6
F32 = jnp.float32
IN_SIZES = (MLA_HEADS * MLA_QK, MLA_KV_RANK, MLA_ROPE,
            SWA_HEADS * SWA_HD, SWA_KV_HEADS * SWA_HD, SWA_KV_HEADS * SWA_HD,
            GDN_HEADS * (2 * GDN_DK + GDN_DV), GDN_HEADS * GDN_DV, 2 * GDN_HEADS, 2 * GDN_HEADS,
            (HY_ORDER + 1) * HY_WIDTH)
IN_COLS = sum(IN_SIZES)
SPLIT_POINTS = tuple(int(s) for s in np.cumsum(IN_SIZES)[:-1])

kernel_name = 'hybrid_diffusion_prefix_trunk'


def rms_norm(x, g):
    xf = x.astype(F32)
    y = xf * lax.rsqrt(jnp.mean(xf * xf, axis=-1, keepdims=True) + EPS)
    return (y * g.astype(F32)).astype(x.dtype)


def l2norm(x):
    xf = x.astype(F32)
    return xf * lax.rsqrt(jnp.sum(xf * xf, axis=-1, keepdims=True) + EPS)


def axial_rope_angles(row, col, dim):
    n_freq = dim // 4
    inv = ROPE_BASE ** (-jnp.arange(n_freq, dtype=F32) / n_freq)
    ang = jnp.concatenate([row.astype(F32)[:, None] * inv, col.astype(F32)[:, None] * inv], axis=-1)
    return jnp.cos(ang), jnp.sin(ang)


def apply_rope(x, cs):
    cos, sin = cs
    xf = x.astype(F32)
    x1, x2 = xf[..., 0::2], xf[..., 1::2]
    c = cos[None, :, None, :]
    s = sin[None, :, None, :]
    return jnp.stack([x1 * c - x2 * s, x1 * s + x2 * c], axis=-1).reshape(x.shape).astype(x.dtype)


def softmax_with_sink(s, sink):
    m = jnp.maximum(jnp.max(s, axis=-1, keepdims=True), sink)
    p = jnp.exp(s - m)
    return p / (jnp.sum(p, axis=-1, keepdims=True) + jnp.exp(sink - m))


def dense_attention(q, k, v, scale, sink):
    B, Lq, H, dq = q.shape
    Hkv = k.shape[2]
    G = H // Hkv
    nb = Lq // Q_BLOCK
    qb = jnp.moveaxis(q.reshape(B, nb, Q_BLOCK, Hkv, G, dq), 1, 0)

    def one_block(qi):
        s = jnp.einsum('bqhgd,bshd->bhgqs', qi, k, preferred_element_type=F32) * scale
        if sink is None:
            p = jax.nn.softmax(s, axis=-1)
        else:
            p = softmax_with_sink(s, sink.astype(F32).reshape(1, Hkv, G, 1, 1))
        return jnp.einsum('bhgqs,bshd->bqhgd', p.astype(v.dtype), v)

    o = lax.map(one_block, qb)
    return jnp.moveaxis(o, 0, 1).reshape(B, Lq, H, v.shape[-1])


def banded_attention(q, k, v, k_ctx, v_ctx, sink):
    B, L, H, d = q.shape
    Hkv = k.shape[2]
    G = H // Hkv
    W = SWA_BLOCK
    nb = L // W
    pad = ((0, 0), (W, W), (0, 0), (0, 0))
    kp = jnp.pad(k, pad)
    vp = jnp.pad(v, pad)
    idx = jnp.arange(nb)[:, None] * W + jnp.arange(3 * W)[None, :]
    kb = kp[:, idx]
    vb = vp[:, idx]
    qb = q.reshape(B, nb, W, Hkv, G, d)
    scale = d ** -0.5
    s_loc = jnp.einsum('bnqhgd,bnshd->bnhgqs', qb, kb, preferred_element_type=F32) * scale
    qpos = jnp.arange(L).reshape(nb, W)
    kpos = idx - W
    valid = (kpos[:, None, :] >= 0) & (kpos[:, None, :] < L) & (jnp.abs(qpos[:, :, None] - kpos[:, None, :]) <= SWA_WINDOW)
    s_loc = jnp.where(valid[None, :, None, None], s_loc, -jnp.inf)
    s_ctx = jnp.einsum('bnqhgd,bshd->bnhgqs', qb, k_ctx, preferred_element_type=F32) * scale
    s = jnp.concatenate([s_loc, s_ctx], axis=-1)
    p = softmax_with_sink(s, sink.astype(F32).reshape(1, 1, Hkv, G, 1, 1)).astype(v.dtype)
    o = (jnp.einsum('bnhgqs,bnshd->bnqhgd', p[..., :3 * W], vb)
         + jnp.einsum('bnhgqs,bshd->bnqhgd', p[..., 3 * W:], v_ctx))
    return o.reshape(B, L, H, d)


def short_conv(x, w):
    K, C = w.shape
    return lax.conv_general_dilated(x, w.astype(x.dtype)[:, None, :], window_strides=(1,),
                                    padding=[(K // 2, K // 2)],
                                    dimension_numbers=('NWC', 'WIO', 'NWC'),
                                    feature_group_count=C)


def gated_delta_chunked(q, k, v, g_log, beta, s0):
    B, L, H, dk = k.shape
    dv = v.shape[-1]
    C = GDN_CHUNK
    n = L // C
    f = lambda t: t.astype(F32).reshape(B, n, C, H, -1).transpose(1, 0, 3, 2, 4)
    q_, k_, v_ = f(q), f(k), f(v)
    g_ = g_log.astype(F32).reshape(B, n, C, H).transpose(1, 0, 3, 2)
    b_ = beta.astype(F32).reshape(B, n, C, H).transpose(1, 0, 3, 2)
    decay = jnp.cumsum(g_, axis=-1)
    tri = jnp.tril(jnp.ones((C, C), dtype=bool))
    tri_strict = jnp.tril(jnp.ones((C, C), dtype=bool), -1)
    diff = decay[..., :, None] - decay[..., None, :]
    gam = jnp.where(tri, jnp.exp(jnp.where(tri, diff, 0.0)), 0.0)
    kb = k_ * b_[..., None]
    a = jnp.where(tri_strict, jnp.einsum('nbhcd,nbhsd->nbhcs', kb, k_) * gam, 0.0)
    rhs = jnp.concatenate([v_ * b_[..., None], kb * jnp.exp(decay)[..., None]], axis=-1)
    sol = lax.linalg.triangular_solve(a + jnp.eye(C, dtype=F32), rhs, left_side=True, lower=True,
                                      unit_diagonal=True)
    u_v, w = sol[..., :dv], sol[..., dv:]
    attn_qk = jnp.einsum('nbhcd,nbhsd->nbhcs', q_, k_) * gam
    q_dec = q_ * jnp.exp(decay)[..., None]
    k_tail = k_ * jnp.exp(decay[..., -1:] - decay)[..., None]
    tail = jnp.exp(decay[..., -1])

    def step(S, xs):
        uv_c, w_c, aqk_c, qd_c, kt_c, tl_c = xs
        u = uv_c - jnp.einsum('bhck,bhkv->bhcv', w_c, S)
        o = jnp.einsum('bhck,bhkv->bhcv', qd_c, S) + jnp.einsum('bhcs,bhsv->bhcv', aqk_c, u)
        S = S * tl_c[..., None, None] + jnp.einsum('bhck,bhcv->bhkv', kt_c, u)
        return S, o

    s_final, o = lax.scan(step, s0.astype(F32), (u_v, w, attn_qk, q_dec, k_tail, tail))
    return o.transpose(1, 0, 3, 2, 4).reshape(B, L, H, dv), s_final


def gdn_mixer(gqkv, gz, ga, gb, P, s0_f, s0_b):
    B, L, _ = gqkv.shape
    qkv = jax.nn.silu(short_conv(gqkv, P['gdn_conv']))
    q, k, v = jnp.split(qkv, 3, axis=-1)
    q = l2norm(q.reshape(B, L, GDN_HEADS, GDN_DK)) * (GDN_DK ** -0.5)
    k = l2norm(k.reshape(B, L, GDN_HEADS, GDN_DK))
    v = v.reshape(B, L, GDN_HEADS, GDN_DV)
    a = ga.reshape(B, L, 2, GDN_HEADS).astype(F32)
    b = gb.reshape(B, L, 2, GDN_HEADS).astype(F32)
    g_log = -jnp.exp(P['gdn_a_log'].astype(F32)) * jax.nn.softplus(a + P['gdn_dt_bias'].astype(F32))
    beta = jax.nn.sigmoid(b)
    o_f, s_f = gated_delta_chunked(q, k, v, g_log[:, :, 0], beta[:, :, 0], s0_f)
    flip = lambda t: jnp.flip(t, axis=1)
    o_b, s_b = gated_delta_chunked(flip(q), flip(k), flip(v), flip(g_log[:, :, 1]), flip(beta[:, :, 1]), s0_b)
    o = o_f + flip(o_b)
    o = rms_norm(o, P['gdn_norm']) * jax.nn.silu(gz.reshape(B, L, GDN_HEADS, GDN_DV).astype(F32))
    return o.reshape(B, L, GDN_HEADS * GDN_DV), s_f, s_b


def hyena_filters(L, P):
    t = jnp.arange(L, dtype=F32)
    t01 = t / max(L - 1, 1)
    w = 2.0 * math.pi * t / L
    bands = jnp.linspace(1e-4, HY_BANDS - 1, HY_BANDS, dtype=F32)
    feats = jnp.concatenate([t01[:, None], jnp.cos(w[:, None] * bands), -jnp.sin(w[:, None] * bands)], axis=-1)
    freq = P['hy_freq'].astype(F32)
    h = jnp.sin(freq[0] * (feats @ P['hy_w1'].astype(F32) + P['hy_b1'].astype(F32)))
    h = jnp.sin(freq[1] * (h @ P['hy_w2'].astype(F32) + P['hy_b2'].astype(F32)))
    h = h @ P['hy_w3'].astype(F32)
    dist = jnp.abs(t - (L // 2)) / (L / 2)
    h = h * jnp.exp(-dist[:, None] * jnp.abs(P['hy_decay'].astype(F32)))
    return jnp.transpose(h.reshape(L, HY_ORDER, HY_WIDTH), (1, 0, 2))


def long_conv_centred(u, h, bias):
    L = u.shape[1]
    uf = jnp.fft.rfft(u.astype(F32), n=2 * L, axis=1)
    hf = jnp.fft.rfft(h, n=2 * L, axis=0)
    y = jnp.fft.irfft(uf * hf[None], n=2 * L, axis=1)[:, L // 2: L // 2 + L]
    return y + u.astype(F32) * bias.astype(F32)


def hyena_mixer(hu, P):
    L = hu.shape[1]
    u = short_conv(hu, P['hy_conv'])
    v, x1, x2 = jnp.split(u.astype(F32), 3, axis=-1)
    filt = hyena_filters(L, P)
    z = x1 * long_conv_centred(v, filt[0], P['hy_bias'][0])
    return x2 * long_conv_centred(z, filt[1], P['hy_bias'][1])


def project(h, w_in):
    return jnp.split(jnp.einsum('bld,de->ble', h, w_in), SPLIT_POINTS, axis=-1)


def mla_expand(ckv, kpe, w_ukv):
    B, L, _ = ckv.shape
    kv = jnp.einsum('blr,re->ble', ckv, w_ukv).reshape(B, L, MLA_HEADS, MLA_NOPE + MLA_VDIM)
    k = jnp.concatenate([kv[..., :MLA_NOPE], jnp.broadcast_to(kpe[:, :, None, :], (B, L, MLA_HEADS, MLA_ROPE))], axis=-1)
    return k, kv[..., MLA_NOPE:]


def merge_heads(o_a, o_b, o_c, o_d, w_out, dtype):
    B, L = o_a.shape[:2]
    o = jnp.concatenate([t.reshape(B, L, -1).astype(dtype) for t in (o_a, o_b, o_c, o_d)], axis=-1)
    return jnp.einsum('ble,ed->bld', o, w_out)


def mixer_context(h, P):
    B, L, _ = h.shape
    mq, ckv, kpe, sq, sk, sv, gqkv, gz, ga, gb, hu = project(h, P['w_in'])
    ckv = rms_norm(ckv, P['mla_kv_norm'])
    k_a, v_a = mla_expand(ckv, kpe, P['mla_w_ukv'])
    o_a = dense_attention(mq.reshape(B, L, MLA_HEADS, MLA_QK), k_a, v_a, MLA_QK ** -0.5, None)
    k_b = sk.reshape(B, L, SWA_KV_HEADS, SWA_HD)
    v_b = sv.reshape(B, L, SWA_KV_HEADS, SWA_HD)
    o_b = dense_attention(sq.reshape(B, L, SWA_HEADS, SWA_HD), k_b, v_b, SWA_HD ** -0.5, P['swa_sink'])
    zero = jnp.zeros((B, GDN_HEADS, GDN_DK, GDN_DV), F32)
    o_c, s_f, s_b = gdn_mixer(gqkv, gz, ga, gb, P, zero, zero)
    o_d = hyena_mixer(hu, P)
    out = merge_heads(o_a, o_b, o_c, o_d, P['w_out'], h.dtype)
    return out, (ckv, kpe, k_b, v_b, jnp.stack([s_f, s_b], axis=1))


def mixer_latent(h, P, rope_a, rope_b, ctx):
    B, L, _ = h.shape
    ckv_c, kpe_c, k_c, v_c, st = ctx
    mq, ckv, kpe, sq, sk, sv, gqkv, gz, ga, gb, hu = project(h, P['w_in'])
    ckv = rms_norm(ckv, P['mla_kv_norm'])
    kpe = apply_rope(kpe[:, :, None, :], rope_a)[:, :, 0, :]
    q_a = mq.reshape(B, L, MLA_HEADS, MLA_QK)
    q_a = jnp.concatenate([q_a[..., :MLA_NOPE], apply_rope(q_a[..., MLA_NOPE:], rope_a)], axis=-1)
    k_lat, v_lat = mla_expand(ckv, kpe, P['mla_w_ukv'])
    k_ctx, v_ctx = mla_expand(ckv_c, kpe_c, P['mla_w_ukv'])
    o_a = dense_attention(q_a, jnp.concatenate([k_lat, k_ctx], axis=1),
                          jnp.concatenate([v_lat, v_ctx], axis=1), MLA_QK ** -0.5, None)
    q_b = apply_rope(sq.reshape(B, L, SWA_HEADS, SWA_HD), rope_b)
    k_b = apply_rope(sk.reshape(B, L, SWA_KV_HEADS, SWA_HD), rope_b)
    v_b = sv.reshape(B, L, SWA_KV_HEADS, SWA_HD)
    o_b = banded_attention(q_b, k_b, v_b, k_c, v_c, P['swa_sink'])
    o_c, _, _ = gdn_mixer(gqkv, gz, ga, gb, P, st[:, 0], st[:, 1])
    o_d = hyena_mixer(hu, P)
    return merge_heads(o_a, o_b, o_c, o_d, P['w_out'], h.dtype), None


def trunk_layer(x, cond, P, mixer):
    mod = jnp.einsum('bd,de->be', jax.nn.silu(cond), P['w_ada']) + P['b_ada']
    sh1, sc1, gt1, sh2, sc2, gt2 = jnp.split(mod[:, None, :], 6, axis=-1)
    h = rms_norm(x, P['g_pre_mix']) * (1.0 + sc1) + sh1
    o, extra = mixer(h)
    x = x + gt1 * rms_norm(o, P['g_post_mix'])
    h = rms_norm(x, P['g_pre_mlp']) * (1.0 + sc2) + sh2
    m = jnp.einsum('blf,fd->bld', jnp.square(jax.nn.relu(jnp.einsum('bld,df->blf', h, P['mlp_w1']))), P['mlp_w2'])
    x = x + gt2 * rms_norm(m, P['g_post_mlp'])
    return x, extra


def setup_inputs(seed: int = 0) -> dict:
    key = jax.random.key(seed)
    ks = jax.random.split(key, 36)
    D = D_MODEL

    def nrm(i, shape, scale):
        return jax.random.normal(ks[i], shape, F32) * scale

    def unif(i, shape, lo, hi):
        return jax.random.uniform(ks[i], shape, F32, lo, hi)

    dt = jnp.exp(unif(22, (DEPTH, 2, GDN_HEADS), math.log(1e-3), math.log(1e-1)))
    return {
        'x_prompt': nrm(0, (BATCH, SEQ, D), 1.0),
        'x_sample': nrm(1, (DEC_BATCH, DEC_SEQ, D), 1.0),
        'cache_mla_ckv': nrm(2, (DEC_BATCH, DEPTH, PAST_LEN, MLA_KV_RANK), 1.0),
        'cache_mla_kpe': nrm(3, (DEC_BATCH, DEPTH, PAST_LEN, MLA_ROPE), 1.0),
        'cache_swa_k': nrm(4, (DEC_BATCH, DEPTH, PAST_LEN, SWA_KV_HEADS, SWA_HD), 1.0),
        'cache_swa_v': nrm(5, (DEC_BATCH, DEPTH, PAST_LEN, SWA_KV_HEADS, SWA_HD), 1.0),
        'state_gdn': nrm(6, (DEC_BATCH, DEPTH, 2, GDN_HEADS, GDN_DK, GDN_DV), 0.1),
        'c': nrm(7, (DEC_BATCH, D), 1.0),
        'c_ctx': nrm(8, (D,), 1.0),
        'w_ada': nrm(9, (DEPTH, D, 6 * D), 0.5 * D ** -0.5),
        'b_ada': nrm(10, (DEPTH, 6 * D), 0.02),
        'g_pre_mix': 1.0 + nrm(11, (DEPTH, D), 0.05),
        'g_post_mix': 1.0 + nrm(12, (DEPTH, D), 0.05),
        'g_pre_mlp': 1.0 + nrm(13, (DEPTH, D), 0.05),
        'g_post_mlp': 1.0 + nrm(14, (DEPTH, D), 0.05),
        'w_in': nrm(15, (DEPTH, D, IN_COLS), D ** -0.5),
        'w_out': nrm(16, (DEPTH, D, D), D ** -0.5),
        'mla_kv_norm': 1.0 + nrm(17, (DEPTH, MLA_KV_RANK), 0.05),
        'mla_w_ukv': nrm(18, (DEPTH, MLA_KV_RANK, MLA_HEADS * (MLA_NOPE + MLA_VDIM)), MLA_KV_RANK ** -0.5),
        'swa_sink': nrm(19, (DEPTH, SWA_HEADS), 0.5),
        'gdn_conv': nrm(20, (DEPTH, GDN_CONV, GDN_HEADS * (2 * GDN_DK + GDN_DV)), GDN_CONV ** -0.5),
        'gdn_a_log': jnp.log(unif(21, (DEPTH, 2, GDN_HEADS), 1.0, 16.0)),
        'gdn_dt_bias': dt + jnp.log(-jnp.expm1(-dt)),
        'gdn_norm': 1.0 + nrm(23, (DEPTH, GDN_DV), 0.05),
        'hy_conv': nrm(24, (DEPTH, HY_CONV, (HY_ORDER + 1) * HY_WIDTH), HY_CONV ** -0.5),
        'hy_w1': nrm(25, (DEPTH, HY_EMB, HY_FF), HY_EMB ** -0.5),
        'hy_b1': nrm(26, (DEPTH, HY_FF), 0.1),
        'hy_w2': nrm(27, (DEPTH, HY_FF, HY_FF), HY_FF ** -0.5),
        'hy_b2': nrm(28, (DEPTH, HY_FF), 0.1),
        'hy_w3': nrm(29, (DEPTH, HY_FF, HY_ORDER * HY_WIDTH), 0.05 * HY_FF ** -0.5),
        'hy_freq': 1.0 + nrm(30, (DEPTH, 2, HY_FF), 0.1),
        'hy_decay': unif(31, (DEPTH, HY_ORDER * HY_WIDTH), 3.0, 15.0),
        'hy_bias': nrm(32, (DEPTH, HY_ORDER, HY_WIDTH), 0.1),
        'mlp_w1': nrm(33, (DEPTH, D, D_FF), D ** -0.5),
        'mlp_w2': nrm(34, (DEPTH, D_FF, D), D_FF ** -0.5),
    }


def reference(x_prompt, x_sample, cache_mla_ckv, cache_mla_kpe, cache_swa_k, cache_swa_v, state_gdn,
              c, c_ctx, w_ada, b_ada, g_pre_mix, g_post_mix, g_pre_mlp, g_post_mlp, w_in, w_out,
              mla_kv_norm, mla_w_ukv, swa_sink, gdn_conv, gdn_a_log, gdn_dt_bias, gdn_norm,
              hy_conv, hy_w1, hy_b1, hy_w2, hy_b2, hy_w3, hy_freq, hy_decay, hy_bias, mlp_w1, mlp_w2):
    cond_ctx = jnp.broadcast_to(c_ctx[None, :], (x_prompt.shape[0], c_ctx.shape[0]))
    n_lat = x_sample.shape[1]
    rows = n_lat // GRID_W
    row = jnp.repeat(jnp.arange(rows), GRID_W)
    col = jnp.tile(jnp.arange(GRID_W), rows)
    rope_a = axial_rope_angles(row, col, MLA_ROPE)
    rope_b = axial_rope_angles(row, col, SWA_HD)
    xp = x_prompt
    xs = x_sample
    ckv_l, kpe_l, k_l, v_l, st_l = [], [], [], [], []
    for l in range(DEPTH):
        P = dict(w_ada=w_ada[l], b_ada=b_ada[l], g_pre_mix=g_pre_mix[l], g_post_mix=g_post_mix[l],
                 g_pre_mlp=g_pre_mlp[l], g_post_mlp=g_post_mlp[l], w_in=w_in[l], w_out=w_out[l],
                 mla_kv_norm=mla_kv_norm[l], mla_w_ukv=mla_w_ukv[l], swa_sink=swa_sink[l],
                 gdn_conv=gdn_conv[l], gdn_a_log=gdn_a_log[l], gdn_dt_bias=gdn_dt_bias[l],
                 gdn_norm=gdn_norm[l], hy_conv=hy_conv[l], hy_w1=hy_w1[l], hy_b1=hy_b1[l],
                 hy_w2=hy_w2[l], hy_b2=hy_b2[l], hy_w3=hy_w3[l], hy_freq=hy_freq[l],
                 hy_decay=hy_decay[l], hy_bias=hy_bias[l], mlp_w1=mlp_w1[l], mlp_w2=mlp_w2[l])
        xp, new = trunk_layer(xp, cond_ctx, P, lambda h: mixer_context(h, P))
        ckv_l.append(new[0])
        kpe_l.append(new[1])
        k_l.append(new[2])
        v_l.append(new[3])
        st_l.append(new[4])
        ctx = (cache_mla_ckv[:, l], cache_mla_kpe[:, l], cache_swa_k[:, l], cache_swa_v[:, l], state_gdn[:, l])
        xs, _ = trunk_layer(xs, c, P, lambda h: mixer_latent(h, P, rope_a, rope_b, ctx))
    new_mla_ckv = jnp.stack(ckv_l, axis=1)
    new_mla_kpe = jnp.stack(kpe_l, axis=1)
    new_swa_k = jnp.stack(k_l, axis=1)
    new_swa_v = jnp.stack(v_l, axis=1)
    new_gdn_state = jnp.stack(st_l, axis=1)
    return (xp, xs, new_mla_ckv, new_mla_kpe, new_swa_k, new_swa_v, new_gdn_state)
```

```cpp
#include <hip/hip_runtime.h>
#include <hip/hip_cooperative_groups.h>
#include <cstdio>
#include <cstdint>
namespace cg = cooperative_groups;

typedef unsigned short bf16_t;
typedef short bf16x8 __attribute__((ext_vector_type(8)));
typedef float f32x4 __attribute__((ext_vector_type(4)));

#define NT 512
#define EPSV 1e-6f

constexpr int D = 1024, TC = 4096, TL = 8192, T = TC + TL, INC = 2864, INCP = 2944, DFF = 4096;
enum { I_XP = 0, I_XS, I_CCKV, I_CKPE, I_CSK, I_CSV, I_STATE, I_C, I_CCTX, I_WADA, I_BADA, I_GPREMIX, I_GPOSTMIX, I_GPREMLP, I_GPOSTMLP,
       I_WIN, I_WOUT, I_KVNORM, I_WUKV, I_SINK, I_GCONV, I_GALOG, I_GDT, I_GNORM, I_HCONV, I_HW1, I_HB1, I_HW2, I_HB2, I_HW3, I_HFREQ,
       I_HDECAY, I_HBIAS, I_W1, I_W2, N_IN };
constexpr int C_MQ = 0, C_CKV = 384, C_KPE = 512, C_SQ = 544, C_SK = 800, C_SV = 928, C_GQKV = 1056, C_GZ = 1824, C_GA = 2080, C_GB = 2088, C_HU = 2096;
constexpr size_t O_YP = 0, O_YS = (size_t)TC * D, O_CKV = (size_t)T * D, O_KPE = O_CKV + 16 * 2 * 256 * 128, O_SK = O_KPE + 16 * 2 * 256 * 32,
                 O_SV = O_SK + 16 * 2 * 256 * 128, O_ST = O_SV + 16 * 2 * 256 * 128;

constexpr size_t al(size_t x) { return (x + 255) & ~(size_t)255; }
constexpr size_t W_WIN = 0;
constexpr size_t W_WOUT = W_WIN + al((size_t)2 * INCP * D * 2);
constexpr size_t W_W1 = W_WOUT + al((size_t)2 * D * D * 2);
constexpr size_t W_W2 = W_W1 + al((size_t)2 * DFF * D * 2);
constexpr size_t W_WUKV = W_W2 + al((size_t)2 * DFF * D * 2);
constexpr size_t W_CKVC = W_WUKV + al((size_t)2 * 512 * 128 * 2);
constexpr size_t W_KVC = W_CKVC + al((size_t)2 * 2048 * 128 * 2);
constexpr size_t W_KPEC = W_KVC + al((size_t)2 * 2048 * 512 * 2);
constexpr size_t W_KSWC = W_KPEC + al((size_t)2 * 2048 * 32 * 2);
constexpr size_t W_VSWC = W_KSWC + al((size_t)2 * 2048 * 128 * 2);
constexpr size_t W_MODP = W_VSWC + al((size_t)2 * 2048 * 128 * 2);
constexpr size_t W_MOD = W_MODP + al((size_t)16 * 2 * 5 * 6144 * 4);
constexpr size_t W_FILT = W_MOD + al((size_t)2 * 5 * 6144 * 4);
constexpr size_t W_ROPEA = W_FILT + al((size_t)2 * 2304 * 512 * 4);
constexpr size_t W_ROPEB = W_ROPEA + al((size_t)2048 * 16 * 2 * 4);
constexpr size_t W_BAR = W_ROPEB + al((size_t)2048 * 32 * 2 * 4);
constexpr size_t W_H = W_BAR + al(16384);
constexpr size_t W_BIG = W_H + al((size_t)T * D * 2);
constexpr size_t W_PROJ = W_BIG;
constexpr size_t W_CKVN = W_PROJ + al((size_t)T * INC * 2);
constexpr size_t W_KPE = W_CKVN + al((size_t)T * 128 * 2);
constexpr size_t W_QMLA = W_KPE + al((size_t)T * 32 * 2);
constexpr size_t W_QSWA = W_QMLA + al((size_t)T * 384 * 2);
constexpr size_t W_KSWA = W_QSWA + al((size_t)T * 256 * 2);
constexpr size_t W_VSWA = W_KSWA + al((size_t)T * 128 * 2);
constexpr size_t W_GQ = W_VSWA + al((size_t)T * 128 * 2);
constexpr size_t W_GK = W_GQ + al((size_t)T * 256 * 2);
constexpr size_t W_GV = W_GK + al((size_t)T * 256 * 2);
constexpr size_t W_GZ = W_GV + al((size_t)T * 256 * 2);
constexpr size_t W_GG = W_GZ + al((size_t)T * 256 * 2);
constexpr size_t W_GBETA = W_GG + al((size_t)T * 8 * 4);
constexpr size_t W_HV = W_GBETA + al((size_t)T * 8 * 4);
constexpr size_t W_HX1 = W_HV + al((size_t)T * 256 * 2);
constexpr size_t W_HX2 = W_HX1 + al((size_t)T * 256 * 2);
constexpr size_t W_MIX_END = W_HX2 + al((size_t)T * 256 * 2);
constexpr size_t W_KVX = W_PROJ;
constexpr size_t W_OF = W_KVX + al((size_t)T * 512 * 2);
constexpr size_t W_OB = W_OF + al((size_t)T * 256 * 4);
constexpr size_t W_Z = W_OB + al((size_t)T * 256 * 4);
constexpr size_t W_OVL_END = W_Z + al((size_t)T * 256 * 4);
static_assert(W_OVL_END <= W_CKVN, "overlay overflow");
constexpr size_t W_OP = W_PROJ;
static_assert(W_OP + (size_t)T * D * 4 <= W_CKVN, "OP overflow");
constexpr size_t W_HID = W_BIG;
constexpr size_t W_M = W_HID + al((size_t)T * DFF * 2);
constexpr size_t W_END = (W_M + (size_t)T * D * 4) > W_MIX_END ? (W_M + (size_t)T * D * 4) : W_MIX_END;
static_assert(W_END <= (size_t)256 * 1024 * 1024, "workspace overflow");

struct KP {
    const float* in[N_IN];
    float* out;
    unsigned char* ws;
    int ph_lo, ph_hi;
    int tid, pad;
};

__device__ __forceinline__ float bf2f(bf16_t v) { return __uint_as_float(((unsigned)v) << 16); }
__device__ __forceinline__ bf16_t f2bf(float f) {
    unsigned u = __float_as_uint(f);
    u += 0x7fffu + ((u >> 16) & 1u);
    return (bf16_t)(u >> 16);
}
__device__ __forceinline__ float wave_sum(float v) {
#pragma unroll
    for (int o = 32; o > 0; o >>= 1) v += __shfl_xor(v, o);
    return v;
}
__device__ __forceinline__ float siluf(float x) { return x / (1.f + __expf(-x)); }
__device__ __forceinline__ void unpack8(uint4 w, float* o) {
    o[0] = __uint_as_float(w.x << 16); o[1] = __uint_as_float(w.x & 0xffff0000u);
    o[2] = __uint_as_float(w.y << 16); o[3] = __uint_as_float(w.y & 0xffff0000u);
    o[4] = __uint_as_float(w.z << 16); o[5] = __uint_as_float(w.z & 0xffff0000u);
    o[6] = __uint_as_float(w.w << 16); o[7] = __uint_as_float(w.w & 0xffff0000u);
}
__device__ __forceinline__ int cond_row(int tok) { return tok < TC ? 0 : 1 + ((tok - TC) >> 11); }

template <class TT> __device__ __forceinline__ TT* wsp(const KP& p, size_t off) { return (TT*)(p.ws + off); }

__device__ __forceinline__ void tr_unit(const float* __restrict__ src, bf16_t* __restrict__ dst, int K, int N, int Npad, int kt, int nt, float* lds, int tid_) {
    const int tid = tid_, c = tid & 63, r8 = tid >> 6;
#pragma unroll
    for (int i = 0; i < 8; i++) {
        int k = i * 8 + r8, n = nt * 64 + c;
        lds[k * 65 + c] = (n < N) ? src[(size_t)(kt * 64 + k) * N + n] : 0.f;
    }
    __syncthreads();
#pragma unroll
    for (int i = 0; i < 8; i++) {
        int n = i * 8 + r8, gn = nt * 64 + n;
        if (gn < Npad) dst[(size_t)gn * K + kt * 64 + c] = f2bf(lds[c * 65 + n]);
    }
    __syncthreads();
}

__device__ __forceinline__ void ada_unit(const KP& p, int u, float* lds) {
    const int l = u / 192, rem = u % 192, chunk = rem / 12, eb = rem % 12, tid = p.tid, e = eb * 512 + tid;
    if (tid < 320) {
        int r = tid >> 6, d = tid & 63;
        float x = (r == 0) ? p.in[I_CCTX][chunk * 64 + d] : p.in[I_C][(r - 1) * 1024 + chunk * 64 + d];
        lds[r * 64 + d] = x / (1.f + expf(-x));
    }
    __syncthreads();
    float a0 = 0, a1 = 0, a2 = 0, a3 = 0, a4 = 0;
    const float* w = p.in[I_WADA] + ((size_t)l * 1024 + chunk * 64) * 6144 + e;
#pragma unroll 8
    for (int d = 0; d < 64; d++) {
        float wv = w[(size_t)d * 6144];
        a0 += lds[d] * wv; a1 += lds[64 + d] * wv; a2 += lds[128 + d] * wv; a3 += lds[192 + d] * wv; a4 += lds[256 + d] * wv;
    }
    float* mp = wsp<float>(p, W_MODP) + ((size_t)(chunk * 2 + l) * 5) * 6144 + e;
    mp[0] = a0; mp[6144] = a1; mp[2 * 6144] = a2; mp[3 * 6144] = a3; mp[4 * 6144] = a4;
    __syncthreads();
}

__device__ __forceinline__ void filt_unit(const KP& p, int u, float* lds) {
    const int l = u / 288, tg = u % 288, wid = p.tid >> 6, lane = p.tid & 63;
    const int tglob = tg * 8 + wid;
    int L, j;
    if (tglob < 256) { L = 256; j = tglob; } else { L = 2048; j = tglob - 256; }
    float* h1 = lds + wid * 128;
    float* h2 = h1 + 64;
    const float tj = (float)j;
    const float t01 = tj / (float)(L - 1);
    const float w = 6.283185307179586f * tj / (float)L;
    const float* w1 = p.in[I_HW1] + (size_t)l * 17 * 64;
    float s = t01 * w1[lane];
#pragma unroll
    for (int b = 0; b < 8; b++) {
        float band = 1e-4f + (float)b * ((7.0f - 1e-4f) / 7.0f);
        float a = w * band;
        s += cosf(a) * w1[(1 + b) * 64 + lane];
        s += -sinf(a) * w1[(9 + b) * 64 + lane];
    }
    s += p.in[I_HB1][l * 64 + lane];
    h1[lane] = sinf(p.in[I_HFREQ][(l * 2 + 0) * 64 + lane] * s);
    __syncthreads();
    const float* w2 = p.in[I_HW2] + (size_t)l * 64 * 64;
    float s2 = 0;
#pragma unroll 8
    for (int i = 0; i < 64; i++) s2 += h1[i] * w2[i * 64 + lane];
    s2 += p.in[I_HB2][l * 64 + lane];
    h2[lane] = sinf(p.in[I_HFREQ][(l * 2 + 1) * 64 + lane] * s2);
    __syncthreads();
    const float* w3 = p.in[I_HW3] + (size_t)l * 64 * 512;
    const float dist = fabsf(tj - (float)(L / 2)) / (float)(L / 2);
    float* fo = wsp<float>(p, W_FILT) + ((size_t)l * 2304 + tglob) * 512;
#pragma unroll
    for (int m = 0; m < 8; m++) {
        int col = lane + 64 * m;
        float a = 0;
#pragma unroll 8
        for (int i = 0; i < 64; i++) a += h2[i] * w3[i * 512 + col];
        fo[col] = a * expf(-dist * fabsf(p.in[I_HDECAY][l * 512 + col]));
    }
    __syncthreads();
}

__device__ __forceinline__ void cachecvt_unit(const KP& p, int u) {
    const float* src; bf16_t* dst; int Wd; int uu = u;
    if (uu < 128) { src = p.in[I_CCKV]; dst = wsp<bf16_t>(p, W_CKVC); Wd = 128; }
    else if (uu < 160) { uu -= 128; src = p.in[I_CKPE]; dst = wsp<bf16_t>(p, W_KPEC); Wd = 32; }
    else if (uu < 288) { uu -= 160; src = p.in[I_CSK]; dst = wsp<bf16_t>(p, W_KSWC); Wd = 128; }
    else { uu -= 288; src = p.in[I_CSV]; dst = wsp<bf16_t>(p, W_VSWC); Wd = 128; }
#pragma unroll
    for (int i = 0; i < 8; i++) {
        int idx = uu * 4096 + i * 512 + p.tid;
        int per_l = 2048 * Wd;
        int l = idx / per_l, r = idx % per_l, bs = r / Wd, d = r % Wd, b = bs >> 9, s = bs & 511;
        dst[idx] = f2bf(src[((size_t)(b * 2 + l) * 512 + s) * Wd + d]);
    }
}

__device__ __forceinline__ void rope_unit(const KP& p, int u) {
    int idx = u * 512 + p.tid;
    float* ra = wsp<float>(p, W_ROPEA);
    float* rb = wsp<float>(p, W_ROPEB);
    if (idx < 2048 * 16) {
        int t = idx >> 4, pp = idx & 15, row = t >> 6, col = t & 63;
        float inv = powf(10000.f, -(float)(pp & 7) / 8.f);
        float ang = (float)(pp < 8 ? row : col) * inv;
        ra[idx * 2] = cosf(ang); ra[idx * 2 + 1] = sinf(ang);
    } else {
        int i2 = idx - 2048 * 16;
        int t = i2 >> 5, pp = i2 & 31, row = t >> 6, col = t & 63;
        float inv = powf(10000.f, -(float)(pp & 15) / 16.f);
        float ang = (float)(pp < 16 ? row : col) * inv;
        rb[i2 * 2] = cosf(ang); rb[i2 * 2 + 1] = sinf(ang);
    }
}

enum { EPI_BF16 = 0, EPI_F32 = 1, EPI_RELU2 = 2 };
template <int EPI>
__device__ __forceinline__ void gemm_tile(const bf16_t* __restrict__ A, int lda, const bf16_t* __restrict__ Bt, int ldb, int K, int m0, int n0, int N,
                          void* Cout, int ldc, unsigned char* lds, int tid_) {
    const int tid = tid_, wid = tid >> 6, lane = tid & 63, wr = wid >> 1, wc = wid & 1, fr = lane & 15, fq = lane >> 4;
    unsigned char* As = lds;
    unsigned char* Bs = lds + 256 * 144;
    f32x4 acc[4][4];
#pragma unroll
    for (int m = 0; m < 4; m++)
#pragma unroll
        for (int n = 0; n < 4; n++) acc[m][n] = (f32x4){0.f, 0.f, 0.f, 0.f};
    const int nk = K / 64;
    const int lr = tid >> 3, lkc = tid & 7;
    const bf16_t* ga = A + (size_t)(m0 + lr) * lda + lkc * 8;
    const bf16_t* gb = Bt + (size_t)(n0 + lr) * ldb + lkc * 8;
    uint4 ra0, ra1, ra2, ra3, rb0, rb1;
#define GLOAD(kt_) do { \
    ra0 = *(const uint4*)(ga + (kt_) * 64); ra1 = *(const uint4*)(ga + (size_t)64 * lda + (kt_) * 64); \
    ra2 = *(const uint4*)(ga + (size_t)128 * lda + (kt_) * 64); ra3 = *(const uint4*)(ga + (size_t)192 * lda + (kt_) * 64); \
    rb0 = *(const uint4*)(gb + (kt_) * 64); rb1 = *(const uint4*)(gb + (size_t)64 * ldb + (kt_) * 64); } while (0)
    GLOAD(0);
    for (int kt = 0; kt < nk; kt++) {
        __syncthreads();
        *(uint4*)(As + lr * 144 + lkc * 16) = ra0; *(uint4*)(As + (lr + 64) * 144 + lkc * 16) = ra1;
        *(uint4*)(As + (lr + 128) * 144 + lkc * 16) = ra2; *(uint4*)(As + (lr + 192) * 144 + lkc * 16) = ra3;
        *(uint4*)(Bs + lr * 144 + lkc * 16) = rb0; *(uint4*)(Bs + (lr + 64) * 144 + lkc * 16) = rb1;
        __syncthreads();
        if (kt + 1 < nk) GLOAD(kt + 1);
#pragma unroll
        for (int ks = 0; ks < 2; ks++) {
            bf16x8 a[4], b[4];
#pragma unroll
            for (int m = 0; m < 4; m++) a[m] = *(const bf16x8*)(As + (wr * 64 + m * 16 + fr) * 144 + ks * 64 + fq * 16);
#pragma unroll
            for (int n = 0; n < 4; n++) b[n] = *(const bf16x8*)(Bs + (wc * 64 + n * 16 + fr) * 144 + ks * 64 + fq * 16);
#pragma unroll
            for (int m = 0; m < 4; m++)
#pragma unroll
                for (int n = 0; n < 4; n++) acc[m][n] = __builtin_amdgcn_mfma_f32_16x16x32_bf16(b[n], a[m], acc[m][n], 0, 0, 0);
        }
    }
#pragma unroll
    for (int m = 0; m < 4; m++) {
        const int row = m0 + wr * 64 + m * 16 + fr;
#pragma unroll
        for (int n = 0; n < 4; n++) {
            const int col = n0 + wc * 64 + n * 16 + fq * 4;
            if (col < N) {
                f32x4 v = acc[m][n];
                if (EPI == EPI_F32) {
                    *(f32x4*)((float*)Cout + (size_t)row * ldc + col) = v;
                } else {
                    if (EPI == EPI_RELU2) {
#pragma unroll
                        for (int j = 0; j < 4; j++) { float r = fmaxf(v[j], 0.f); v[j] = r * r; }
                    }
                    uint2 w;
                    w.x = (unsigned)f2bf(v[0]) | ((unsigned)f2bf(v[1]) << 16);
                    w.y = (unsigned)f2bf(v[2]) | ((unsigned)f2bf(v[3]) << 16);
                    *(uint2*)((bf16_t*)Cout + (size_t)row * ldc + col) = w;
                }
            }
        }
    }
    __syncthreads();
}

template <int EPI>
__device__ __forceinline__ void gemm_phase(const bf16_t* A, int lda, const bf16_t* Bt, int ldb, int K, int M, int N, void* C, int ldc, unsigned char* lds, int vb, int nvb, int tid_) {
    const int tm = M / 256, tn = (N + 127) / 128;
    for (int u = vb; u < tm * tn; u += nvb) {
        int pm = u % tm, pn = u / tm;
        gemm_tile<EPI>(A, lda, Bt, ldb, K, pm * 256, pn * 128, N, C, ldc, lds, tid_);
    }
}

__device__ __forceinline__ void resnorm_phase(const KP& p, const float* xprompt, const float* xsample, const float* y, const float* g_post, int gate_off, int ly,
                              const float* g_pre, int sc_off, int sh_off, int lh, int vb, int nvb) {
    const int wid = p.tid >> 6, lane = p.tid & 63;
    float* X = p.out;
    bf16_t* H = wsp<bf16_t>(p, W_H);
    const float* MOD = wsp<float>(p, W_MOD);
    for (int u = vb; u < T / 8; u += nvb) {
        const int tok = u * 8 + wid;
        const int cr = cond_row(tok);
        const float* xs = xprompt ? (tok < TC ? xprompt + (size_t)tok * D : xsample + (size_t)(tok - TC) * D) : X + (size_t)tok * D;
        f32x4 xv[4];
#pragma unroll
        for (int i = 0; i < 4; i++) xv[i] = *(const f32x4*)(xs + i * 256 + lane * 4);
        if (y) {
            f32x4 yv[4];
            float ss = 0;
#pragma unroll
            for (int i = 0; i < 4; i++) { yv[i] = *(const f32x4*)(y + (size_t)tok * D + i * 256 + lane * 4); ss += yv[i][0] * yv[i][0] + yv[i][1] * yv[i][1] + yv[i][2] * yv[i][2] + yv[i][3] * yv[i][3]; }
            ss = wave_sum(ss);
            const float rs = rsqrtf(ss * (1.f / 1024.f) + EPSV);
            const float* gate = MOD + (size_t)(ly * 5 + cr) * 6144 + gate_off;
#pragma unroll
            for (int i = 0; i < 4; i++) {
                f32x4 gp = *(const f32x4*)(g_post + i * 256 + lane * 4);
                f32x4 gt = *(const f32x4*)(gate + i * 256 + lane * 4);
#pragma unroll
                for (int j = 0; j < 4; j++) xv[i][j] += gt[j] * (yv[i][j] * rs * gp[j]);
            }
        }
        if (y || xprompt) {
#pragma unroll
            for (int i = 0; i < 4; i++) *(f32x4*)(X + (size_t)tok * D + i * 256 + lane * 4) = xv[i];
        }
        if (g_pre) {
            float ss = 0;
#pragma unroll
            for (int i = 0; i < 4; i++) ss += xv[i][0] * xv[i][0] + xv[i][1] * xv[i][1] + xv[i][2] * xv[i][2] + xv[i][3] * xv[i][3];
            ss = wave_sum(ss);
            const float rs = rsqrtf(ss * (1.f / 1024.f) + EPSV);
            const float* sc = MOD + (size_t)(lh * 5 + cr) * 6144 + sc_off;
            const float* sh = MOD + (size_t)(lh * 5 + cr) * 6144 + sh_off;
#pragma unroll
            for (int i = 0; i < 4; i++) {
                f32x4 gp = *(const f32x4*)(g_pre + i * 256 + lane * 4);
                f32x4 s1 = *(const f32x4*)(sc + i * 256 + lane * 4);
                f32x4 s2 = *(const f32x4*)(sh + i * 256 + lane * 4);
                float h0 = xv[i][0] * rs * gp[0] * (1.f + s1[0]) + s2[0];
                float h1 = xv[i][1] * rs * gp[1] * (1.f + s1[1]) + s2[1];
                float h2 = xv[i][2] * rs * gp[2] * (1.f + s1[2]) + s2[2];
                float h3 = xv[i][3] * rs * gp[3] * (1.f + s1[3]) + s2[3];
                uint2 w;
                w.x = (unsigned)f2bf(h0) | ((unsigned)f2bf(h1) << 16);
                w.y = (unsigned)f2bf(h2) | ((unsigned)f2bf(h3) << 16);
                *(uint2*)(H + (size_t)tok * D + i * 256 + lane * 4) = w;
            }
        }
    }
}

__device__ __forceinline__ void prep_phase(const KP& p, int l, int vb, int nvb) {
    const int wid = p.tid >> 6, lane = p.tid & 63;
    const bf16_t* PROJ = wsp<bf16_t>(p, W_PROJ);
    bf16_t* CKVN = wsp<bf16_t>(p, W_CKVN); bf16_t* KPE = wsp<bf16_t>(p, W_KPE); bf16_t* QMLA = wsp<bf16_t>(p, W_QMLA);
    bf16_t* QSWA = wsp<bf16_t>(p, W_QSWA); bf16_t* KSWA = wsp<bf16_t>(p, W_KSWA); bf16_t* VSWA = wsp<bf16_t>(p, W_VSWA);
    bf16_t* GQ = wsp<bf16_t>(p, W_GQ); bf16_t* GK = wsp<bf16_t>(p, W_GK); bf16_t* GV = wsp<bf16_t>(p, W_GV); bf16_t* GZ = wsp<bf16_t>(p, W_GZ);
    float* GG = wsp<float>(p, W_GG); float* GBETA = wsp<float>(p, W_GBETA);
    bf16_t* HV = wsp<bf16_t>(p, W_HV); bf16_t* HX1 = wsp<bf16_t>(p, W_HX1); bf16_t* HX2 = wsp<bf16_t>(p, W_HX2);
    const float* RA = wsp<float>(p, W_ROPEA); const float* RB = wsp<float>(p, W_ROPEB);
    for (int u = vb; u < T / 8; u += nvb) {
        const int tok = u * 8 + wid;
        const bool lat = tok >= TC;
        int b, t, L;
        if (!lat) { b = tok >> 8; t = tok & 255; L = 256; } else { int q = tok - TC; b = q >> 11; t = q & 2047; L = 2048; }
        const bf16_t* pr = PROJ + (size_t)tok * INC;
        const size_t ob = ((size_t)(b * 2 + l) * 256 + t);
        {
            float c0 = bf2f(pr[C_CKV + lane * 2]), c1 = bf2f(pr[C_CKV + lane * 2 + 1]);
            float ss = wave_sum(c0 * c0 + c1 * c1);
            float rs = rsqrtf(ss * (1.f / 128.f) + EPSV);
            float n0 = c0 * rs * p.in[I_KVNORM][l * 128 + lane * 2], n1 = c1 * rs * p.in[I_KVNORM][l * 128 + lane * 2 + 1];
            CKVN[(size_t)tok * 128 + lane * 2] = f2bf(n0); CKVN[(size_t)tok * 128 + lane * 2 + 1] = f2bf(n1);
            if (!lat) { p.out[O_CKV + ob * 128 + lane * 2] = n0; p.out[O_CKV + ob * 128 + lane * 2 + 1] = n1; }
        }
        if (lane < 16) {
            float x1 = bf2f(pr[C_KPE + 2 * lane]), x2 = bf2f(pr[C_KPE + 2 * lane + 1]);
            if (!lat) {
                p.out[O_KPE + ob * 32 + 2 * lane] = x1; p.out[O_KPE + ob * 32 + 2 * lane + 1] = x2;
                KPE[(size_t)tok * 32 + 2 * lane] = f2bf(x1); KPE[(size_t)tok * 32 + 2 * lane + 1] = f2bf(x2);
            } else {
                float cs = RA[(t * 16 + lane) * 2], sn = RA[(t * 16 + lane) * 2 + 1];
                KPE[(size_t)tok * 32 + 2 * lane] = f2bf(x1 * cs - x2 * sn); KPE[(size_t)tok * 32 + 2 * lane + 1] = f2bf(x1 * sn + x2 * cs);
            }
        }
#pragma unroll
        for (int h = 0; h < 4; h++) QMLA[(size_t)tok * 384 + h * 96 + lane] = pr[C_MQ + h * 96 + lane];
        {
            int h = lane >> 4, pp = lane & 15;
            float x1 = bf2f(pr[C_MQ + h * 96 + 64 + 2 * pp]), x2 = bf2f(pr[C_MQ + h * 96 + 64 + 2 * pp + 1]);
            float o1 = x1, o2 = x2;
            if (lat) { float cs = RA[(t * 16 + pp) * 2], sn = RA[(t * 16 + pp) * 2 + 1]; o1 = x1 * cs - x2 * sn; o2 = x1 * sn + x2 * cs; }
            QMLA[(size_t)tok * 384 + h * 96 + 64 + 2 * pp] = f2bf(o1); QMLA[(size_t)tok * 384 + h * 96 + 64 + 2 * pp + 1] = f2bf(o2);
        }
#pragma unroll
        for (int i = 0; i < 2; i++) {
            int id = lane + 64 * i, h = id >> 5, pp = id & 31;
            float x1 = bf2f(pr[C_SQ + h * 64 + 2 * pp]), x2 = bf2f(pr[C_SQ + h * 64 + 2 * pp + 1]);
            float o1 = x1, o2 = x2;
            if (lat) { float cs = RB[(t * 32 + pp) * 2], sn = RB[(t * 32 + pp) * 2 + 1]; o1 = x1 * cs - x2 * sn; o2 = x1 * sn + x2 * cs; }
            QSWA[(size_t)tok * 256 + h * 64 + 2 * pp] = f2bf(o1); QSWA[(size_t)tok * 256 + h * 64 + 2 * pp + 1] = f2bf(o2);
        }
        {
            int hk = lane >> 5, pp = lane & 31;
            float x1 = bf2f(pr[C_SK + hk * 64 + 2 * pp]), x2 = bf2f(pr[C_SK + hk * 64 + 2 * pp + 1]);
            float o1 = x1, o2 = x2;
            if (lat) { float cs = RB[(t * 32 + pp) * 2], sn = RB[(t * 32 + pp) * 2 + 1]; o1 = x1 * cs - x2 * sn; o2 = x1 * sn + x2 * cs; }
            else { p.out[O_SK + ob * 128 + hk * 64 + 2 * pp] = x1; p.out[O_SK + ob * 128 + hk * 64 + 2 * pp + 1] = x2; }
            KSWA[(size_t)tok * 128 + hk * 64 + 2 * pp] = f2bf(o1); KSWA[(size_t)tok * 128 + hk * 64 + 2 * pp + 1] = f2bf(o2);
            bf16_t v0 = pr[C_SV + lane * 2], v1 = pr[C_SV + lane * 2 + 1];
            VSWA[(size_t)tok * 128 + lane * 2] = v0; VSWA[(size_t)tok * 128 + lane * 2 + 1] = v1;
            if (!lat) { p.out[O_SV + ob * 128 + lane * 2] = bf2f(v0); p.out[O_SV + ob * 128 + lane * 2 + 1] = bf2f(v1); }
        }
        {
            const float* cw = p.in[I_GCONV] + (size_t)l * 3 * 768;
#pragma unroll
            for (int i = 0; i < 12; i++) {
                int ch = lane + 64 * i;
                float xc = bf2f(pr[C_GQKV + ch]);
                float xp = (t > 0) ? bf2f(pr[C_GQKV + ch - INC]) : 0.f;
                float xn = (t < L - 1) ? bf2f(pr[C_GQKV + ch + INC]) : 0.f;
                float yv = xp * cw[ch] + xc * cw[768 + ch] + xn * cw[1536 + ch];
                yv = yv / (1.f + expf(-yv));
                if (i < 8) {
                    float ss = wave_sum(yv * yv);
                    yv *= rsqrtf(ss + EPSV);
                    if (i < 4) { yv *= 0.125f; GQ[(size_t)tok * 256 + ch] = f2bf(yv); }
                    else GK[(size_t)tok * 256 + ch - 256] = f2bf(yv);
                } else GV[(size_t)tok * 256 + ch - 512] = f2bf(yv);
            }
            if (lane < 8) {
                float a = bf2f(pr[C_GA + lane]), bb = bf2f(pr[C_GB + lane]);
                float xx = a + p.in[I_GDT][l * 8 + lane];
                float sp = xx > 20.f ? xx : log1pf(expf(xx));
                GG[(size_t)tok * 8 + lane] = -expf(p.in[I_GALOG][l * 8 + lane]) * sp;
                GBETA[(size_t)tok * 8 + lane] = 1.f / (1.f + expf(-bb));
            }
#pragma unroll
            for (int i = 0; i < 4; i++) GZ[(size_t)tok * 256 + lane + 64 * i] = pr[C_GZ + lane + 64 * i];
        }
        {
            const float* cw = p.in[I_HCONV] + (size_t)l * 3 * 768;
#pragma unroll
            for (int i = 0; i < 12; i++) {
                int ch = lane + 64 * i;
                float xc = bf2f(pr[C_HU + ch]);
                float xp = (t > 0) ? bf2f(pr[C_HU + ch - INC]) : 0.f;
                float xn = (t < L - 1) ? bf2f(pr[C_HU + ch + INC]) : 0.f;
                float yv = xp * cw[ch] + xc * cw[768 + ch] + xn * cw[1536 + ch];
                if (i < 4) HV[(size_t)tok * 256 + ch] = f2bf(yv);
                else if (i < 8) HX1[(size_t)tok * 256 + ch - 256] = f2bf(yv);
                else HX2[(size_t)tok * 256 + ch - 512] = f2bf(yv);
            }
        }
    }
}

template <int D2, bool MASK>
__device__ __forceinline__ void attn_seg(const float* q, float* acc, float& m, float& lsum, const bf16_t* k1, int s1, const bf16_t* k2, int s2,
                                         const bf16_t* v, int sv, int j0, int j1, int tq) {
#pragma unroll 1
    for (int j = j0; j < j1; j += 2) {
        float sa = 0.f, sb = 0.f;
        const bf16_t* kpa = k1 + (size_t)j * s1;
        const bf16_t* kpb = kpa + s1;
#pragma unroll
        for (int c = 0; c < 8; c++) {
            float ka[8], kb[8]; unpack8(*(const uint4*)(kpa + c * 8), ka); unpack8(*(const uint4*)(kpb + c * 8), kb);
#pragma unroll
            for (int e = 0; e < 8; e++) { sa += q[c * 8 + e] * ka[e]; sb += q[c * 8 + e] * kb[e]; }
        }
        if (D2 > 0) {
            const bf16_t* k2a = k2 + (size_t)j * s2;
            const bf16_t* k2b = k2a + s2;
#pragma unroll
            for (int c = 0; c < D2 / 8; c++) {
                float ka[8], kb[8]; unpack8(*(const uint4*)(k2a + c * 8), ka); unpack8(*(const uint4*)(k2b + c * 8), kb);
#pragma unroll
                for (int e = 0; e < 8; e++) { sa += q[64 + c * 8 + e] * ka[e]; sb += q[64 + c * 8 + e] * kb[e]; }
            }
        }
        if (MASK) {
            int dlt = tq - j; if (dlt > 128 || dlt < -128) sa = -1e30f;
            dlt -= 1; if (dlt > 128 || dlt < -128) sb = -1e30f;
        }
        const float mn = fmaxf(m, fmaxf(sa, sb));
        const float alpha = __expf(m - mn);
        const float pa = __expf(sa - mn), pb = __expf(sb - mn);
        lsum = lsum * alpha + pa + pb;
        m = mn;
        const bf16_t* va = v + (size_t)j * sv;
        const bf16_t* vb = va + sv;
#pragma unroll
        for (int c = 0; c < 8; c++) {
            float xa[8], xb[8]; unpack8(*(const uint4*)(va + c * 8), xa); unpack8(*(const uint4*)(vb + c * 8), xb);
#pragma unroll
            for (int e = 0; e < 8; e++) acc[c * 8 + e] = acc[c * 8 + e] * alpha + pa * xa[e] + pb * xb[e];
        }
    }
}

__device__ __forceinline__ void mla_wave(const KP& p, int l, bool lat, int b, int h, int qblk, int lane) {
    const int L = lat ? 2048 : 256, seq0 = lat ? TC + b * 2048 : b * 256;
    const int tq = seq0 + qblk * 64 + lane;
    const bf16_t* QMLA = wsp<bf16_t>(p, W_QMLA);
    const bf16_t* KVX = wsp<bf16_t>(p, W_KVX);
    const bf16_t* KPE = wsp<bf16_t>(p, W_KPE);
    float q[96], acc[64];
    const float scale = 0.10206207261596577f;
#pragma unroll
    for (int c = 0; c < 12; c++) {
        float t8[8]; unpack8(*(const uint4*)(QMLA + (size_t)tq * 384 + h * 96 + c * 8), t8);
#pragma unroll
        for (int e = 0; e < 8; e++) q[c * 8 + e] = t8[e] * scale;
    }
#pragma unroll
    for (int d = 0; d < 64; d++) acc[d] = 0.f;
    float m = -1e30f, lsum = 0.f;
    attn_seg<32, false>(q, acc, m, lsum, KVX + (size_t)seq0 * 512 + h * 128, 512, KPE + (size_t)seq0 * 32, 32, KVX + (size_t)seq0 * 512 + h * 128 + 64, 512, 0, L, 0);
    if (lat) {
        const bf16_t* KVC = wsp<bf16_t>(p, W_KVC) + ((size_t)l * 2048 + b * 512) * 512;
        const bf16_t* KPEC = wsp<bf16_t>(p, W_KPEC) + ((size_t)l * 2048 + b * 512) * 32;
        attn_seg<32, false>(q, acc, m, lsum, KVC + h * 128, 512, KPEC, 32, KVC + h * 128 + 64, 512, 0, 512, 0);
    }
    const float inv = 1.f / lsum;
    bf16_t* O = wsp<bf16_t>(p, W_H) + (size_t)tq * 1024 + h * 64;
#pragma unroll
    for (int c = 0; c < 8; c++) {
        uint4 w;
        w.x = (unsigned)f2bf(acc[c * 8 + 0] * inv) | ((unsigned)f2bf(acc[c * 8 + 1] * inv) << 16);
        w.y = (unsigned)f2bf(acc[c * 8 + 2] * inv) | ((unsigned)f2bf(acc[c * 8 + 3] * inv) << 16);
        w.z = (unsigned)f2bf(acc[c * 8 + 4] * inv) | ((unsigned)f2bf(acc[c * 8 + 5] * inv) << 16);
        w.w = (unsigned)f2bf(acc[c * 8 + 6] * inv) | ((unsigned)f2bf(acc[c * 8 + 7] * inv) << 16);
        *(uint4*)(O + c * 8) = w;
    }
}

__device__ __forceinline__ void swa_wave(const KP& p, int l, bool lat, int b, int h, int qblk, int lane) {
    const int L = lat ? 2048 : 256, seq0 = lat ? TC + b * 2048 : b * 256;
    const int tql = qblk * 64 + lane, tq = seq0 + tql, hk = h >> 1;
    const bf16_t* QSWA = wsp<bf16_t>(p, W_QSWA);
    const bf16_t* KSWA = wsp<bf16_t>(p, W_KSWA);
    const bf16_t* VSWA = wsp<bf16_t>(p, W_VSWA);
    float q[64], acc[64];
#pragma unroll
    for (int c = 0; c < 8; c++) {
        float t8[8]; unpack8(*(const uint4*)(QSWA + (size_t)tq * 256 + h * 64 + c * 8), t8);
#pragma unroll
        for (int e = 0; e < 8; e++) q[c * 8 + e] = t8[e] * 0.125f;
    }
#pragma unroll
    for (int d = 0; d < 64; d++) acc[d] = 0.f;
    float m = p.in[I_SINK][l * 4 + h], lsum = 1.f;
    if (lat) {
        int jlo = qblk * 64 - 128; if (jlo < 0) jlo = 0;
        int jhi = qblk * 64 + 64 + 128; if (jhi > L) jhi = L;
        attn_seg<0, true>(q, acc, m, lsum, KSWA + (size_t)seq0 * 128 + hk * 64, 128, nullptr, 0, VSWA + (size_t)seq0 * 128 + hk * 64, 128, jlo, jhi, tql);
        const bf16_t* KC = wsp<bf16_t>(p, W_KSWC) + ((size_t)l * 2048 + b * 512) * 128 + hk * 64;
        const bf16_t* VC = wsp<bf16_t>(p, W_VSWC) + ((size_t)l * 2048 + b * 512) * 128 + hk * 64;
        attn_seg<0, false>(q, acc, m, lsum, KC, 128, nullptr, 0, VC, 128, 0, 512, 0);
    } else {
        attn_seg<0, false>(q, acc, m, lsum, KSWA + (size_t)seq0 * 128 + hk * 64, 128, nullptr, 0, VSWA + (size_t)seq0 * 128 + hk * 64, 128, 0, L, 0);
    }
    const float inv = 1.f / lsum;
    bf16_t* O = wsp<bf16_t>(p, W_H) + (size_t)tq * 1024 + 256 + h * 64;
#pragma unroll
    for (int c = 0; c < 8; c++) {
        uint4 w;
        w.x = (unsigned)f2bf(acc[c * 8 + 0] * inv) | ((unsigned)f2bf(acc[c * 8 + 1] * inv) << 16);
        w.y = (unsigned)f2bf(acc[c * 8 + 2] * inv) | ((unsigned)f2bf(acc[c * 8 + 3] * inv) << 16);
        w.z = (unsigned)f2bf(acc[c * 8 + 4] * inv) | ((unsigned)f2bf(acc[c * 8 + 5] * inv) << 16);
        w.w = (unsigned)f2bf(acc[c * 8 + 6] * inv) | ((unsigned)f2bf(acc[c * 8 + 7] * inv) << 16);
        *(uint4*)(O + c * 8) = w;
    }
}

__device__ __forceinline__ void gdn_wave(const KP& p, int l, bool lat, int b, int h, int dir, int lane) {
    const int L = lat ? 2048 : 256, seq0 = lat ? TC + b * 2048 : b * 256;
    const bf16_t* GQ = wsp<bf16_t>(p, W_GQ); const bf16_t* GK = wsp<bf16_t>(p, W_GK); const bf16_t* GV = wsp<bf16_t>(p, W_GV);
    const float* GG = wsp<float>(p, W_GG); const float* GBETA = wsp<float>(p, W_GBETA);
    float* OUT = wsp<float>(p, dir ? W_OB : W_OF);
    float S[64];
    if (lat) {
        const float* st = p.in[I_STATE] + ((((size_t)b * 2 + l) * 2 + dir) * 4 + h) * 4096;
#pragma unroll
        for (int k = 0; k < 64; k++) S[k] = st[k * 64 + lane];
    } else {
#pragma unroll
        for (int k = 0; k < 64; k++) S[k] = 0.f;
    }
    uint4 kA[8], kB[8], qC[8]; float vA, gA, bA, vB, gB, bB;
#define GDN_LOAD(K_, V_, G_, B_, i_) do { int t_ = dir ? L - 1 - (i_) : (i_); size_t tok_ = seq0 + t_; \
    _Pragma("unroll") for (int c = 0; c < 8; c++) { K_[c] = *(const uint4*)(GK + tok_ * 256 + h * 64 + c * 8); } \
    V_ = bf2f(GV[tok_ * 256 + h * 64 + lane]); G_ = GG[tok_ * 8 + dir * 4 + h]; B_ = GBETA[tok_ * 8 + dir * 4 + h]; } while (0)
#define GDN_STEP(K_, V_, G_, B_, i_) do { const int t_ = dir ? L - 1 - (i_) : (i_); const size_t tok_ = seq0 + t_; \
    _Pragma("unroll") for (int c = 0; c < 8; c++) qC[c] = *(const uint4*)(GQ + tok_ * 256 + h * 64 + c * 8); \
    const float eg = __expf(G_); float ks0 = 0, ks1 = 0, ks2 = 0, ks3 = 0; \
    _Pragma("unroll") for (int c = 0; c < 8; c++) { float kk[8]; unpack8(K_[c], kk); \
        _Pragma("unroll") for (int e = 0; e < 8; e += 4) { \
            S[c * 8 + e] *= eg; S[c * 8 + e + 1] *= eg; S[c * 8 + e + 2] *= eg; S[c * 8 + e + 3] *= eg; \
            ks0 += kk[e] * S[c * 8 + e]; ks1 += kk[e + 1] * S[c * 8 + e + 1]; ks2 += kk[e + 2] * S[c * 8 + e + 2]; ks3 += kk[e + 3] * S[c * 8 + e + 3]; } } \
    const float uu = B_ * (V_ - ((ks0 + ks1) + (ks2 + ks3))); float o0 = 0, o1 = 0, o2 = 0, o3 = 0; \
    _Pragma("unroll") for (int c = 0; c < 8; c++) { float kk[8], qq[8]; unpack8(K_[c], kk); unpack8(qC[c], qq); \
        _Pragma("unroll") for (int e = 0; e < 8; e += 4) { \
            S[c * 8 + e] += kk[e] * uu; S[c * 8 + e + 1] += kk[e + 1] * uu; S[c * 8 + e + 2] += kk[e + 2] * uu; S[c * 8 + e + 3] += kk[e + 3] * uu; \
            o0 += qq[e] * S[c * 8 + e]; o1 += qq[e + 1] * S[c * 8 + e + 1]; o2 += qq[e + 2] * S[c * 8 + e + 2]; o3 += qq[e + 3] * S[c * 8 + e + 3]; } } \
    OUT[tok_ * 256 + h * 64 + lane] = (o0 + o1) + (o2 + o3); } while (0)
    GDN_LOAD(kA, vA, gA, bA, 0);
#pragma unroll 1
    for (int i = 0; i < L; i += 2) {
        GDN_LOAD(kB, vB, gB, bB, i + 1);
        GDN_STEP(kA, vA, gA, bA, i);
        if (i + 2 < L) GDN_LOAD(kA, vA, gA, bA, i + 2);
        GDN_STEP(kB, vB, gB, bB, i + 1);
    }
    if (!lat) {
        float* so = p.out + O_ST + ((((size_t)b * 2 + l) * 2 + dir) * 4 + h) * 4096;
#pragma unroll
        for (int k = 0; k < 64; k++) so[k * 64 + lane] = S[k];
    }
}

template <int ORDER>
__device__ __forceinline__ void hyena_unit(const KP& p, int l, bool lat, int b, int tb) {
    const int L = lat ? 2048 : 256, seq0 = lat ? TC + b * 2048 : b * 256, fbase = lat ? 256 : 0;
    const int c = p.tid & 255, tg = p.tid >> 8, t0 = tb * 16 + tg * 8, half = L / 2;
    const float* F = wsp<float>(p, W_FILT) + ((size_t)l * 2304 + fbase) * 512 + ORDER * 256 + c;
    const bf16_t* HV = wsp<bf16_t>(p, W_HV);
    const float* Z = wsp<float>(p, W_Z);
    float acc[8], hw[8];
#pragma unroll
    for (int i = 0; i < 8; i++) acc[i] = 0.f;
    int slo = t0 - half + 1; if (slo < 0) slo = 0;
    int shi = t0 + 7 + half; if (shi > L - 1) shi = L - 1;
#pragma unroll
    for (int i = 0; i < 8; i++) { int idx = t0 + i + half - slo; hw[i] = (idx >= 0 && idx < L) ? F[(size_t)idx * 512] : 0.f; }
    for (int s = slo; s <= shi; s++) {
        float u = (ORDER == 0) ? bf2f(HV[(size_t)(seq0 + s) * 256 + c]) : Z[(size_t)(seq0 + s) * 256 + c];
#pragma unroll
        for (int i = 0; i < 8; i++) acc[i] += u * hw[i];
        int idxn = t0 + half - s - 1;
        float nh = (idxn >= 0 && idxn < L) ? F[(size_t)idxn * 512] : 0.f;
#pragma unroll
        for (int i = 7; i > 0; i--) hw[i] = hw[i - 1];
        hw[0] = nh;
    }
    const float bias = p.in[I_HBIAS][(l * 2 + ORDER) * 256 + c];
#pragma unroll
    for (int i = 0; i < 8; i++) {
        size_t tok = seq0 + t0 + i;
        if (ORDER == 0) {
            float v = bf2f(HV[tok * 256 + c]);
            float x1 = bf2f(wsp<bf16_t>(p, W_HX1)[tok * 256 + c]);
            wsp<float>(p, W_Z)[tok * 256 + c] = x1 * (acc[i] + v * bias);
        } else {
            float zz = Z[tok * 256 + c];
            float x2 = bf2f(wsp<bf16_t>(p, W_HX2)[tok * 256 + c]);
            wsp<bf16_t>(p, W_H)[tok * 1024 + 768 + c] = f2bf(x2 * (acc[i] + zz * bias));
        }
    }
}

__device__ __forceinline__ void mix_a_phase(const KP& p, int l, int vb, int nvb) {
    const int wid = __builtin_amdgcn_readfirstlane(p.tid >> 6), lane = p.tid & 63;
    for (int u = vb; u < 980; u += nvb) {
        int v = u, type, b, x1 = 0, x2 = 0; bool lat;
        if (v < 4) { type = 0; lat = true; b = v; x1 = wid >> 1; x2 = wid & 1; }
        else if ((v -= 4) < 16) { type = 0; lat = false; b = v; x1 = wid >> 1; x2 = wid & 1; }
        else if ((v -= 16) < 64) { type = 1; lat = true; b = v >> 4; x1 = (v >> 2) & 3; x2 = (v & 3) * 8 + wid; }
        else if ((v -= 64) < 64) { type = 2; lat = true; b = v >> 4; x1 = (v >> 2) & 3; x2 = (v & 3) * 8 + wid; }
        else if ((v -= 64) < 512) { type = 3; lat = true; b = v >> 7; x1 = v & 127; }
        else if ((v -= 512) < 32) { type = 1; lat = false; int bh = v * 2 + (wid >> 2); b = bh >> 2; x1 = bh & 3; x2 = wid & 3; }
        else if ((v -= 32) < 32) { type = 2; lat = false; int bh = v * 2 + (wid >> 2); b = bh >> 2; x1 = bh & 3; x2 = wid & 3; }
        else { v -= 32; type = 3; lat = false; b = v >> 4; x1 = v & 15; }
        KP q = p;
        asm volatile("" : "+v"(q.tid));
        const int ln = q.tid & 63;
        if (type == 0) gdn_wave(q, l, lat, b, x1, x2, ln);
        else if (type == 1) mla_wave(q, l, lat, b, x1, x2, ln);
        else if (type == 2) swa_wave(q, l, lat, b, x1, x2, ln);
        else hyena_unit<0>(q, l, lat, b, x1);
    }
}

__device__ __forceinline__ void mix_b_phase(const KP& p, int l, int vb, int nvb) {
    const int wid = p.tid >> 6, lane = p.tid & 63;
    for (int u = vb; u < 768 + 1536; u += nvb) {
        int v = u;
        if (v < 768) {
            bool lat = v < 512; int vv = lat ? v : v - 512;
            hyena_unit<1>(p, l, lat, lat ? (vv >> 7) : (vv >> 4), lat ? (vv & 127) : (vv & 15));
            continue;
        }
        v -= 768;
        const size_t tok = (size_t)v * 8 + wid;
        const float* OF = wsp<float>(p, W_OF); const float* OB = wsp<float>(p, W_OB);
        const bf16_t* GZ = wsp<bf16_t>(p, W_GZ);
        bf16_t* O = wsp<bf16_t>(p, W_H);
#pragma unroll
        for (int h = 0; h < 4; h++) {
            float o = OF[tok * 256 + h * 64 + lane] + OB[tok * 256 + h * 64 + lane];
            float ss = wave_sum(o * o);
            float r = rsqrtf(ss * (1.f / 64.f) + EPSV);
            float gz = bf2f(GZ[tok * 256 + h * 64 + lane]);
            O[tok * 1024 + 512 + h * 64 + lane] = f2bf(o * r * p.in[I_GNORM][l * 64 + lane] * siluf(gz));
        }
    }
}

__device__ __forceinline__ void phase_a(const KP& p, int vb, int nvb, unsigned char* lds) {
    for (int u = vb; u < 6112 + 384 + 576 + 416 + 192; u += nvb) {
        int v = u;
        if (v < 6112) {
            int l = v / 3056, r = v % 3056;
            if (r < 736) tr_unit(p.in[I_WIN] + (size_t)l * D * INC, wsp<bf16_t>(p, W_WIN) + (size_t)l * INCP * D, D, INC, INCP, r / 46, r % 46, (float*)lds, p.tid);
            else if (r < 992) { r -= 736; tr_unit(p.in[I_WOUT] + (size_t)l * D * D, wsp<bf16_t>(p, W_WOUT) + (size_t)l * D * D, D, D, D, r / 16, r % 16, (float*)lds, p.tid); }
            else if (r < 2016) { r -= 992; tr_unit(p.in[I_W1] + (size_t)l * D * DFF, wsp<bf16_t>(p, W_W1) + (size_t)l * DFF * D, D, DFF, DFF, r / 64, r % 64, (float*)lds, p.tid); }
            else if (r < 3040) { r -= 2016; tr_unit(p.in[I_W2] + (size_t)l * DFF * D, wsp<bf16_t>(p, W_W2) + (size_t)l * D * DFF, DFF, D, D, r / 16, r % 16, (float*)lds, p.tid); }
            else { r -= 3040; tr_unit(p.in[I_WUKV] + (size_t)l * 128 * 512, wsp<bf16_t>(p, W_WUKV) + (size_t)l * 512 * 128, 128, 512, 512, r / 8, r % 8, (float*)lds, p.tid); }
            continue;
        }
        v -= 6112;
        if (v < 384) { ada_unit(p, v, (float*)lds); continue; }
        v -= 384;
        if (v < 576) { filt_unit(p, v, (float*)lds); continue; }
        v -= 576;
        if (v < 416) { cachecvt_unit(p, v); continue; }
        v -= 416;
        rope_unit(p, v);
    }
}

__device__ __forceinline__ void phase_b(const KP& p, int vb, int nvb, unsigned char* lds) {
    for (int u = vb; u < 120 + 64; u += nvb) {
        if (u < 120) {
            int idx = u * 512 + p.tid;
            int l = idx / 30720, rem = idx % 30720, r = rem / 6144, e = rem % 6144;
            float s = p.in[I_BADA][l * 6144 + e];
            const float* mp = wsp<float>(p, W_MODP);
#pragma unroll
            for (int ch = 0; ch < 16; ch++) s += mp[((size_t)(ch * 2 + l) * 5 + r) * 6144 + e];
            wsp<float>(p, W_MOD)[idx] = s;
        } else {
            int v = u - 120, l = v >> 5, tt = v & 31, pm = tt & 7, pn = tt >> 3;
            gemm_tile<EPI_BF16>(wsp<bf16_t>(p, W_CKVC) + (size_t)l * 2048 * 128, 128, wsp<bf16_t>(p, W_WUKV) + (size_t)l * 512 * 128, 128, 128, pm * 256, pn * 128, 512,
                                wsp<bf16_t>(p, W_KVC) + (size_t)l * 2048 * 512, 512, lds, p.tid);
        }
    }
}

constexpr int NPH = 24;
__device__ __forceinline__ void run_phase(const KP& p, int ph, int vb, int nvb, unsigned char* lds) {
    if (ph == 0) { phase_a(p, vb, nvb, lds); return; }
    if (ph == 1) { phase_b(p, vb, nvb, lds); return; }
    const int l = (ph - 2) / 11, s = (ph - 2) % 11;
    const float* MODl = nullptr; (void)MODl;
    switch (s) {
    case 0:
        if (l == 0) resnorm_phase(p, p.in[I_XP], p.in[I_XS], nullptr, nullptr, 0, 0, p.in[I_GPREMIX], 1024, 0, 0, vb, nvb);
        break;
    case 1: gemm_phase<EPI_BF16>(wsp<bf16_t>(p, W_H), D, wsp<bf16_t>(p, W_WIN) + (size_t)l * INCP * D, D, D, T, INC, wsp<bf16_t>(p, W_PROJ), INC, lds, vb, nvb, p.tid); break;
    case 2: prep_phase(p, l, vb, nvb); break;
    case 3: gemm_phase<EPI_BF16>(wsp<bf16_t>(p, W_CKVN), 128, wsp<bf16_t>(p, W_WUKV) + (size_t)l * 512 * 128, 128, 128, T, 512, wsp<bf16_t>(p, W_KVX), 512, lds, vb, nvb, p.tid); break;
    case 4: mix_a_phase(p, l, vb, nvb); break;
    case 5: mix_b_phase(p, l, vb, nvb); break;
    case 6: gemm_phase<EPI_F32>(wsp<bf16_t>(p, W_H), D, wsp<bf16_t>(p, W_WOUT) + (size_t)l * D * D, D, D, T, D, wsp<float>(p, W_OP), D, lds, vb, nvb, p.tid); break;
    case 7: resnorm_phase(p, nullptr, nullptr, wsp<float>(p, W_OP), p.in[I_GPOSTMIX] + l * D, 2048, l, p.in[I_GPREMLP] + l * D, 4096, 3072, l, vb, nvb); break;
    case 8: gemm_phase<EPI_RELU2>(wsp<bf16_t>(p, W_H), D, wsp<bf16_t>(p, W_W1) + (size_t)l * DFF * D, D, D, T, DFF, wsp<bf16_t>(p, W_HID), DFF, lds, vb, nvb, p.tid); break;
    case 9: gemm_phase<EPI_F32>(wsp<bf16_t>(p, W_HID), DFF, wsp<bf16_t>(p, W_W2) + (size_t)l * D * DFF, DFF, DFF, T, D, wsp<float>(p, W_M), D, lds, vb, nvb, p.tid); break;
    case 10:
        if (l == 0) resnorm_phase(p, nullptr, nullptr, wsp<float>(p, W_M), p.in[I_GPOSTMLP] + l * D, 5120, l, p.in[I_GPREMIX] + (l + 1) * D, 1024, 0, l + 1, vb, nvb);
        else resnorm_phase(p, nullptr, nullptr, wsp<float>(p, W_M), p.in[I_GPOSTMLP] + l * D, 5120, l, nullptr, 0, 0, 0, vb, nvb);
        break;
    }
}

__global__ void __launch_bounds__(NT) trunk_kernel(KP p) {
    __shared__ __attribute__((aligned(16))) unsigned char lds[57344];
    cg::grid_group grid = cg::this_grid();
    for (int ph = p.ph_lo; ph < p.ph_hi; ph++) {
        KP q = p;
        q.tid = threadIdx.x;
        asm volatile("" : "+v"(q.tid));
        asm volatile("" : "+s"(q.ws), "+s"(q.out));
        run_phase(q, ph, blockIdx.x, gridDim.x, lds);
        if (ph + 1 < p.ph_hi) grid.sync();
    }
}

extern "C" void kernel_launch(void* const* d_in, const int* in_sizes, int n_in, void* d_out, int out_size, void* d_ws, size_t ws_size, hipStream_t stream) {
    KP p{};
    for (int i = 0; i < N_IN; i++) p.in[i] = (const float*)d_in[i];
    p.out = (float*)d_out;
    p.ws = (unsigned char*)d_ws;
    const int grid = 256;
    for (int ph = 0; ph < NPH; ph++) {
        if (ph == 13) continue;
        p.ph_lo = ph; p.ph_hi = ph + 1;
        hipLaunchKernelGGL(trunk_kernel, dim3(grid), dim3(NT), 0, stream, p);
    }
}
```

```cpp
#include <hip/hip_runtime.h>
#include <hip/hip_cooperative_groups.h>
#include <cstdio>
#include <cstdint>
namespace cg = cooperative_groups;

typedef unsigned short bf16_t;
typedef short bf16x8 __attribute__((ext_vector_type(8)));
typedef float f32x4 __attribute__((ext_vector_type(4)));

#define NT 512
#define EPSV 1e-6f

constexpr int D = 1024, TC = 4096, TL = 8192, T = TC + TL, INC = 2864, INCP = 3072, DFF = 4096;
enum { I_XP = 0, I_XS, I_CCKV, I_CKPE, I_CSK, I_CSV, I_STATE, I_C, I_CCTX, I_WADA, I_BADA, I_GPREMIX, I_GPOSTMIX, I_GPREMLP, I_GPOSTMLP,
       I_WIN, I_WOUT, I_KVNORM, I_WUKV, I_SINK, I_GCONV, I_GALOG, I_GDT, I_GNORM, I_HCONV, I_HW1, I_HB1, I_HW2, I_HB2, I_HW3, I_HFREQ,
       I_HDECAY, I_HBIAS, I_W1, I_W2, N_IN };
constexpr int C_MQ = 0, C_CKV = 384, C_KPE = 512, C_SQ = 544, C_SK = 800, C_SV = 928, C_GQKV = 1056, C_GZ = 1824, C_GA = 2080, C_GB = 2088, C_HU = 2096;
constexpr size_t O_YP = 0, O_YS = (size_t)TC * D, O_CKV = (size_t)T * D, O_KPE = O_CKV + 16 * 2 * 256 * 128, O_SK = O_KPE + 16 * 2 * 256 * 32,
                 O_SV = O_SK + 16 * 2 * 256 * 128, O_ST = O_SV + 16 * 2 * 256 * 128;

constexpr size_t al(size_t x) { return (x + 255) & ~(size_t)255; }
constexpr size_t W_WIN = 0;
constexpr size_t W_WOUT = W_WIN + al((size_t)2 * INCP * D * 2);
constexpr size_t W_W1 = W_WOUT + al((size_t)2 * D * D * 2);
constexpr size_t W_W2 = W_W1 + al((size_t)2 * DFF * D * 2);
constexpr size_t W_WUKV = W_W2 + al((size_t)2 * DFF * D * 2);
constexpr size_t W_CKVC = W_WUKV + al((size_t)2 * 512 * 128 * 2);
constexpr size_t W_KVC = W_CKVC + al((size_t)2 * 2048 * 128 * 2);
constexpr size_t W_KPEC = W_KVC + al((size_t)2 * 2048 * 512 * 2);
constexpr size_t W_KSWC = W_KPEC + al((size_t)2 * 2048 * 32 * 2);
constexpr size_t W_VSWC = W_KSWC + al((size_t)2 * 2048 * 128 * 2);
constexpr size_t W_MODP = W_VSWC + al((size_t)2 * 2048 * 128 * 2);
constexpr size_t W_MOD = W_MODP + al((size_t)16 * 2 * 5 * 6144 * 4);
constexpr size_t W_FILT = W_MOD + al((size_t)2 * 5 * 6144 * 4);
constexpr size_t W_ROPEA = W_FILT + al((size_t)2 * 2304 * 512 * 4);
constexpr size_t W_ROPEB = W_ROPEA + al((size_t)2048 * 16 * 2 * 4);
constexpr size_t W_BAR = W_ROPEB + al((size_t)2048 * 32 * 2 * 4);
constexpr size_t W_H = W_BAR + al(16384);
constexpr size_t W_BIG = W_H + al((size_t)T * D * 2);
constexpr size_t W_PROJ = W_BIG;
constexpr size_t W_CKVN = W_PROJ + al((size_t)T * INC * 2);
constexpr size_t W_KPE = W_CKVN + al((size_t)T * 128 * 2);
constexpr size_t W_QMLA = W_KPE + al((size_t)T * 32 * 2);
constexpr size_t W_QSWA = W_QMLA + al((size_t)T * 384 * 2);
constexpr size_t W_KSWA = W_QSWA + al((size_t)T * 256 * 2);
constexpr size_t W_VSWA = W_KSWA + al((size_t)T * 128 * 2);
constexpr size_t W_GQ = W_VSWA + al((size_t)T * 128 * 2);
constexpr size_t W_GK = W_GQ + al((size_t)T * 256 * 2);
constexpr size_t W_GV = W_GK + al((size_t)T * 256 * 2);
constexpr size_t W_GZ = W_GV + al((size_t)T * 256 * 2);
constexpr size_t W_GG = W_GZ + al((size_t)T * 256 * 2);
constexpr size_t W_GBETA = W_GG + al((size_t)T * 8 * 4);
constexpr size_t W_HV = W_GBETA + al((size_t)T * 8 * 4);
constexpr size_t W_HX1 = W_HV + al((size_t)T * 256 * 2);
constexpr size_t W_HX2 = W_HX1 + al((size_t)T * 256 * 2);
constexpr size_t W_GAQK = W_HX2 + al((size_t)T * 256 * 2);
constexpr size_t W_GKTT = W_GAQK + al((size_t)1536 * 4096 * 2);
constexpr size_t W_GEDEC = W_GKTT + al((size_t)1536 * 4096 * 2);
constexpr size_t W_GTAIL = W_GEDEC + al((size_t)1536 * 64 * 4);
constexpr size_t W_MIX_END = W_GTAIL + al((size_t)1536 * 4);
constexpr size_t W_KVX = W_PROJ;
constexpr size_t W_OF = W_KVX + al((size_t)T * 512 * 2);
constexpr size_t W_OB = W_OF + al((size_t)T * 256 * 2);
constexpr size_t W_YT = W_OB + al((size_t)T * 256 * 2);
constexpr size_t W_GUV = W_YT + al((size_t)T * 256 * 2);
constexpr size_t W_GW = W_GUV + al((size_t)1536 * 4096 * 2);
constexpr size_t W_OVL_END = W_GW + al((size_t)1536 * 4096 * 2);
static_assert(W_OVL_END <= W_CKVN, "overlay overflow");
constexpr size_t W_OP = W_PROJ;
static_assert(W_OP + (size_t)T * D * 4 <= W_CKVN, "OP overflow");
constexpr size_t W_HID = W_BIG;
constexpr size_t W_M = W_HID + al((size_t)T * DFF * 2);
constexpr size_t W_END = (W_M + (size_t)T * D * 4) > W_MIX_END ? (W_M + (size_t)T * D * 4) : W_MIX_END;
static_assert(W_END <= (size_t)256 * 1024 * 1024, "workspace overflow");

struct KP {
    const float* in[N_IN];
    float* out;
    unsigned char* ws;
    int ph_lo, ph_hi;
    int tid, pad;
};

__device__ __forceinline__ float bf2f(bf16_t v) { return __uint_as_float(((unsigned)v) << 16); }
__device__ __forceinline__ bf16_t f2bf(float f) {
    unsigned u = __float_as_uint(f);
    u += 0x7fffu + ((u >> 16) & 1u);
    return (bf16_t)(u >> 16);
}
__device__ __forceinline__ float wave_sum(float v) {
#pragma unroll
    for (int o = 32; o > 0; o >>= 1) v += __shfl_xor(v, o);
    return v;
}
__device__ __forceinline__ float siluf(float x) { return x / (1.f + __expf(-x)); }
__device__ __forceinline__ void unpack8(uint4 w, float* o) {
    o[0] = __uint_as_float(w.x << 16); o[1] = __uint_as_float(w.x & 0xffff0000u);
    o[2] = __uint_as_float(w.y << 16); o[3] = __uint_as_float(w.y & 0xffff0000u);
    o[4] = __uint_as_float(w.z << 16); o[5] = __uint_as_float(w.z & 0xffff0000u);
    o[6] = __uint_as_float(w.w << 16); o[7] = __uint_as_float(w.w & 0xffff0000u);
}
__device__ __forceinline__ int cond_row(int tok) { return tok < TC ? 0 : 1 + ((tok - TC) >> 11); }

template <class TT> __device__ __forceinline__ TT* wsp(const KP& p, size_t off) { return (TT*)(p.ws + off); }

__device__ __forceinline__ void tr_unit(const float* __restrict__ src, bf16_t* __restrict__ dst, int K, int N, int Npad, int kt, int nt, float* lds, int tid_) {
    const int tid = tid_;
#pragma unroll
    for (int i = 0; i < 2; i++) {
        const int c = tid + i * 512, k = c >> 4, n4 = (c & 15) * 4, n = nt * 64 + n4;
        f32x4 v = (f32x4){0.f, 0.f, 0.f, 0.f};
        if (n < N) v = *(const f32x4*)(src + (size_t)(kt * 64 + k) * N + n);
        lds[k * 65 + n4] = v[0]; lds[k * 65 + n4 + 1] = v[1]; lds[k * 65 + n4 + 2] = v[2]; lds[k * 65 + n4 + 3] = v[3];
    }
    __syncthreads();
    {
        const int n = tid >> 3, k8 = (tid & 7) * 8, gn = nt * 64 + n;
        float f[8];
#pragma unroll
        for (int e = 0; e < 8; e++) f[e] = lds[(k8 + e) * 65 + n];
        uint4 w;
        w.x = (unsigned)f2bf(f[0]) | ((unsigned)f2bf(f[1]) << 16); w.y = (unsigned)f2bf(f[2]) | ((unsigned)f2bf(f[3]) << 16);
        w.z = (unsigned)f2bf(f[4]) | ((unsigned)f2bf(f[5]) << 16); w.w = (unsigned)f2bf(f[6]) | ((unsigned)f2bf(f[7]) << 16);
        if (gn < Npad) *(uint4*)(dst + (size_t)gn * K + kt * 64 + k8) = w;
    }
    __syncthreads();
}

__device__ __forceinline__ void ada_unit(const KP& p, int u, float* lds) {
    const int l = u / 192, rem = u % 192, chunk = rem / 12, eb = rem % 12, tid = p.tid, e = eb * 512 + tid;
    if (tid < 320) {
        int r = tid >> 6, d = tid & 63;
        float x = (r == 0) ? p.in[I_CCTX][chunk * 64 + d] : p.in[I_C][(r - 1) * 1024 + chunk * 64 + d];
        lds[r * 64 + d] = x / (1.f + __expf(-x));
    }
    __syncthreads();
    float a0 = 0, a1 = 0, a2 = 0, a3 = 0, a4 = 0;
    const float* w = p.in[I_WADA] + ((size_t)l * 1024 + chunk * 64) * 6144 + e;
#pragma unroll 8
    for (int d = 0; d < 64; d++) {
        float wv = w[(size_t)d * 6144];
        a0 += lds[d] * wv; a1 += lds[64 + d] * wv; a2 += lds[128 + d] * wv; a3 += lds[192 + d] * wv; a4 += lds[256 + d] * wv;
    }
    float* mp = wsp<float>(p, W_MODP) + ((size_t)(chunk * 2 + l) * 5) * 6144 + e;
    mp[0] = a0; mp[6144] = a1; mp[2 * 6144] = a2; mp[3 * 6144] = a3; mp[4 * 6144] = a4;
    __syncthreads();
}

__device__ __forceinline__ void filt_unit(const KP& p, int u, float* lds) {
    const int l = u / 288, tg = u % 288, wid = p.tid >> 6, lane = p.tid & 63;
    const int tglob = tg * 8 + wid;
    int L, j;
    if (tglob < 256) { L = 256; j = tglob; } else { L = 2048; j = tglob - 256; }
    float* h1 = lds + wid * 128;
    float* h2 = h1 + 64;
    const float tj = (float)j;
    const float t01 = tj / (float)(L - 1);
    const float w = 6.283185307179586f * tj / (float)L;
    const float* w1 = p.in[I_HW1] + (size_t)l * 17 * 64;
    float s = t01 * w1[lane];
#pragma unroll
    for (int b = 0; b < 8; b++) {
        float band = 1e-4f + (float)b * ((7.0f - 1e-4f) / 7.0f);
        float a = w * band;
        s += __cosf(a) * w1[(1 + b) * 64 + lane];
        s += -__sinf(a) * w1[(9 + b) * 64 + lane];
    }
    s += p.in[I_HB1][l * 64 + lane];
    h1[lane] = __sinf(p.in[I_HFREQ][(l * 2 + 0) * 64 + lane] * s);
    __syncthreads();
    const float* w2 = p.in[I_HW2] + (size_t)l * 64 * 64;
    float s2 = 0;
#pragma unroll 8
    for (int i = 0; i < 64; i++) s2 += h1[i] * w2[i * 64 + lane];
    s2 += p.in[I_HB2][l * 64 + lane];
    h2[lane] = __sinf(p.in[I_HFREQ][(l * 2 + 1) * 64 + lane] * s2);
    __syncthreads();
    const float* w3 = p.in[I_HW3] + (size_t)l * 64 * 512;
    const float dist = fabsf(tj - (float)(L / 2)) / (float)(L / 2);
    float* stage = lds + 1024 + wid * 512;
#pragma unroll
    for (int m = 0; m < 8; m++) {
        int col = lane + 64 * m;
        float a = 0;
#pragma unroll 8
        for (int i = 0; i < 64; i++) a += h2[i] * w3[i * 512 + col];
        stage[col] = a * __expf(-dist * fabsf(p.in[I_HDECAY][l * 512 + col]));
    }
    __syncthreads();
    {
        const int col = p.tid;
        const int j0 = (tg < 32) ? tg * 8 : tg * 8 - 256;
        const int Lt = (tg < 32) ? 256 : 2048;
        bf16_t* ft = wsp<bf16_t>(p, W_FILT) + (size_t)l * 1179648 + (tg < 32 ? 0 : 131072) + (size_t)col * Lt + j0;
        unsigned w[4];
#pragma unroll
        for (int e = 0; e < 8; e += 2) w[e >> 1] = (unsigned)f2bf(lds[1024 + e * 512 + col]) | ((unsigned)f2bf(lds[1024 + (e + 1) * 512 + col]) << 16);
        *(uint4*)ft = make_uint4(w[0], w[1], w[2], w[3]);
    }
    __syncthreads();
}

__device__ __forceinline__ void cachecvt_unit(const KP& p, int u) {
    const float* src; bf16_t* dst; int Wd; int uu = u;
    if (uu < 128) { src = p.in[I_CCKV]; dst = wsp<bf16_t>(p, W_CKVC); Wd = 128; }
    else if (uu < 160) { uu -= 128; src = p.in[I_CKPE]; dst = wsp<bf16_t>(p, W_KPEC); Wd = 32; }
    else if (uu < 288) { uu -= 160; src = p.in[I_CSK]; dst = wsp<bf16_t>(p, W_KSWC); Wd = 128; }
    else { uu -= 288; src = p.in[I_CSV]; dst = wsp<bf16_t>(p, W_VSWC); Wd = 128; }
#pragma unroll
    for (int i = 0; i < 8; i++) {
        int idx = uu * 4096 + i * 512 + p.tid;
        int per_l = 2048 * Wd;
        int l = idx / per_l, r = idx % per_l, bs = r / Wd, d = r % Wd, b = bs >> 9, s = bs & 511;
        dst[idx] = f2bf(src[((size_t)(b * 2 + l) * 512 + s) * Wd + d]);
    }
}

__device__ __forceinline__ void rope_unit(const KP& p, int u) {
    int idx = u * 512 + p.tid;
    float* ra = wsp<float>(p, W_ROPEA);
    float* rb = wsp<float>(p, W_ROPEB);
    if (idx < 2048 * 16) {
        int t = idx >> 4, pp = idx & 15, row = t >> 6, col = t & 63;
        float inv = __builtin_amdgcn_exp2f(-(float)(pp & 7) * (13.287712379549449f / 8.f));
        float ang = (float)(pp < 8 ? row : col) * inv;
        ra[idx * 2] = __cosf(ang); ra[idx * 2 + 1] = __sinf(ang);
    } else {
        int i2 = idx - 2048 * 16;
        int t = i2 >> 5, pp = i2 & 31, row = t >> 6, col = t & 63;
        float inv = __builtin_amdgcn_exp2f(-(float)(pp & 15) * (13.287712379549449f / 16.f));
        float ang = (float)(pp < 16 ? row : col) * inv;
        rb[i2 * 2] = __cosf(ang); rb[i2 * 2 + 1] = __sinf(ang);
    }
}

enum { EPI_BF16 = 0, EPI_F32 = 1, EPI_RELU2 = 2 };
template <int EPI>
__device__ __forceinline__ void gemm_tile(const bf16_t* __restrict__ A, int lda, const bf16_t* __restrict__ Bt, int ldb, int K, int m0, int n0, int N,
                          void* Cout, int ldc, unsigned char* lds, int tid_) {
    const int tid = tid_, wid = tid >> 6, lane = tid & 63, wr = wid >> 1, wc = wid & 1, fr = lane & 15, fq = lane >> 4;
    unsigned char* As = lds;
    unsigned char* Bs = lds + 256 * 144;
    f32x4 acc[4][4];
#pragma unroll
    for (int m = 0; m < 4; m++)
#pragma unroll
        for (int n = 0; n < 4; n++) acc[m][n] = (f32x4){0.f, 0.f, 0.f, 0.f};
    const int nk = K / 64;
    const int lr = tid >> 3, lkc = tid & 7;
    const bf16_t* ga = A + (size_t)(m0 + lr) * lda + lkc * 8;
    const bf16_t* gb = Bt + (size_t)(n0 + lr) * ldb + lkc * 8;
    uint4 ra0, ra1, ra2, ra3, rb0, rb1;
#define GLOAD(kt_) do { \
    ra0 = *(const uint4*)(ga + (kt_) * 64); ra1 = *(const uint4*)(ga + (size_t)64 * lda + (kt_) * 64); \
    ra2 = *(const uint4*)(ga + (size_t)128 * lda + (kt_) * 64); ra3 = *(const uint4*)(ga + (size_t)192 * lda + (kt_) * 64); \
    rb0 = *(const uint4*)(gb + (kt_) * 64); rb1 = *(const uint4*)(gb + (size_t)64 * ldb + (kt_) * 64); } while (0)
    GLOAD(0);
    for (int kt = 0; kt < nk; kt++) {
        __syncthreads();
        *(uint4*)(As + lr * 144 + lkc * 16) = ra0; *(uint4*)(As + (lr + 64) * 144 + lkc * 16) = ra1;
        *(uint4*)(As + (lr + 128) * 144 + lkc * 16) = ra2; *(uint4*)(As + (lr + 192) * 144 + lkc * 16) = ra3;
        *(uint4*)(Bs + lr * 144 + lkc * 16) = rb0; *(uint4*)(Bs + (lr + 64) * 144 + lkc * 16) = rb1;
        __syncthreads();
        if (kt + 1 < nk) GLOAD(kt + 1);
#pragma unroll
        for (int ks = 0; ks < 2; ks++) {
            bf16x8 a[4], b[4];
#pragma unroll
            for (int m = 0; m < 4; m++) a[m] = *(const bf16x8*)(As + (wr * 64 + m * 16 + fr) * 144 + ks * 64 + fq * 16);
#pragma unroll
            for (int n = 0; n < 4; n++) b[n] = *(const bf16x8*)(Bs + (wc * 64 + n * 16 + fr) * 144 + ks * 64 + fq * 16);
#pragma unroll
            for (int m = 0; m < 4; m++)
#pragma unroll
                for (int n = 0; n < 4; n++) acc[m][n] = __builtin_amdgcn_mfma_f32_16x16x32_bf16(b[n], a[m], acc[m][n], 0, 0, 0);
        }
    }
#pragma unroll
    for (int m = 0; m < 4; m++) {
        const int row = m0 + wr * 64 + m * 16 + fr;
#pragma unroll
        for (int n = 0; n < 4; n++) {
            const int col = n0 + wc * 64 + n * 16 + fq * 4;
            if (col < N) {
                f32x4 v = acc[m][n];
                if (EPI == EPI_F32) {
                    *(f32x4*)((float*)Cout + (size_t)row * ldc + col) = v;
                } else {
                    if (EPI == EPI_RELU2) {
#pragma unroll
                        for (int j = 0; j < 4; j++) { float r = fmaxf(v[j], 0.f); v[j] = r * r; }
                    }
                    uint2 w;
                    w.x = (unsigned)f2bf(v[0]) | ((unsigned)f2bf(v[1]) << 16);
                    w.y = (unsigned)f2bf(v[2]) | ((unsigned)f2bf(v[3]) << 16);
                    *(uint2*)((bf16_t*)Cout + (size_t)row * ldc + col) = w;
                }
            }
        }
    }
    __syncthreads();
}

template <int EPI>
__device__ __forceinline__ void gemm_phase(const bf16_t* A, int lda, const bf16_t* Bt, int ldb, int K, int M, int N, void* C, int ldc, unsigned char* lds, int vb, int nvb, int tid_) {
    const int tm = M / 256, tn = (N + 127) / 128;
    for (int u = vb; u < tm * tn; u += nvb) {
        int pm = u % tm, pn = u / tm;
        gemm_tile<EPI>(A, lda, Bt, ldb, K, pm * 256, pn * 128, N, C, ldc, lds, tid_);
    }
}


namespace pg8 {
#define PG8_LAS __attribute__((address_space(3)))
typedef unsigned u32x4 __attribute__((ext_vector_type(4)));
constexpr int BM = 256, BK = 64, HALF = 128, HTB = HALF * BK * 2, STAGE_BYTES = 8 * HTB, NXCD = 8, WGM = 8;
__device__ __forceinline__ int lds_byte(int r, int c) { const int st = (r >> 4) * 2 + (c >> 5), rr = r & 15, cc = c & 31, ob = rr * 64 + cc * 2; return st * 1024 + (ob ^ (((ob >> 9) & 1) << 5)); }
__device__ __forceinline__ void stage_rc(int b, int& R, int& C) { const int st = b / 1024, sb = b % 1024, swz = sb ^ (((sb >> 9) & 1) << 5); R = (st >> 1) * 16 + swz / 64; C = (st & 1) * 32 + (swz % 64) / 2; }
__device__ __forceinline__ int perm32(int rho) { const int n = rho >> 4, i = rho & 15; return 8 * (i >> 2) + 4 * n + (i & 3); }
struct Unit { int pm, pn; };
struct Gemm { const bf16_t* A; const bf16_t* Bt; int M, N, K; };
struct StaticOrder {
    int nM, nN, nwg, G, c;
    __device__ void init(int M, int N, int G_, int c_) { nM = M / BM; nN = N / BM; nwg = nM * nN; G = G_; c = c_; }
    __device__ bool next(int i, Unit& u) const {
        const long L = (long)i * G + c; if (L >= nwg) return false;
        int wgid = (int)L; { const int q = nwg / NXCD, r = nwg % NXCD, xcd = wgid % NXCD, off = wgid / NXCD; wgid = (xcd < r ? xcd * (q + 1) : r * (q + 1) + (xcd - r) * q) + off; }
        const int nig = WGM * nN, gid = wgid / nig, fm = gid * WGM, gsz = (nM - fm) < WGM ? (nM - fm) : WGM;
        u.pm = fm + ((wgid % nig) % gsz); u.pn = (wgid % nig) / gsz; return true;
    }
};
__device__ __forceinline__ unsigned cvt_pk_bf16(float lo, float hi) { unsigned r; asm volatile("v_cvt_pk_bf16_f32 %0, %1, %2" : "=v"(r) : "v"(lo), "v"(hi)); return r; }
struct EpiF32 {
    static constexpr bool PERM = false;
    float* C; int ldc;
    __device__ __forceinline__ void operator()(const f32x4 (&acc)[2][2][4][2], const Unit& u, int wr, int wc, int fr, int fq) const {
        const int row0 = u.pm * BM + wr * 64 + fr, col0 = u.pn * BM + wc * 32 + 4 * fq;
#pragma unroll
        for (int ai = 0; ai < 2; ++ai)
#pragma unroll
            for (int m = 0; m < 4; ++m) { float* rowp = C + (size_t)(row0 + ai * HALF + m * 16) * ldc + col0;
#pragma unroll
                for (int bj = 0; bj < 2; ++bj)
#pragma unroll
                    for (int n = 0; n < 2; ++n) *(f32x4*)(rowp + bj * HALF + n * 16) = acc[ai][bj][m][n]; }
    }
};
template <int ACT  > struct EpiBf16 {
    static constexpr bool PERM = true;
    bf16_t* O; int ldc; int ncols;
    __device__ __forceinline__ void operator()(const f32x4 (&acc)[2][2][4][2], const Unit& u, int wr, int wc, int fr, int fq) const {
        const int row0 = u.pm * BM + wr * 64 + fr, col0 = u.pn * BM + wc * 32 + 8 * fq;
#pragma unroll
        for (int ai = 0; ai < 2; ++ai)
#pragma unroll
            for (int m = 0; m < 4; ++m) { bf16_t* rowp = O + (size_t)(row0 + ai * HALF + m * 16) * ldc + col0;
#pragma unroll
                for (int bj = 0; bj < 2; ++bj) { f32x4 v0 = acc[ai][bj][m][0], v1 = acc[ai][bj][m][1];
                    if (ACT == 1) {
#pragma unroll
                        for (int j = 0; j < 4; ++j) { const float a = fmaxf(v0[j], 0.f), b = fmaxf(v1[j], 0.f); v0[j] = a * a; v1[j] = b * b; } }
                    u32x4 w; w.x = cvt_pk_bf16(v0[0], v0[1]); w.y = cvt_pk_bf16(v0[2], v0[3]); w.z = cvt_pk_bf16(v1[0], v1[1]); w.w = cvt_pk_bf16(v1[2], v1[3]);
                    if (col0 + bj * HALF < ncols) *(u32x4*)(rowp + bj * HALF) = w; } }
    }
};

template <class Epi>
__device__ __forceinline__ void gemm_phase(PG8_LAS unsigned char* lds, const Gemm g, const StaticOrder& S, const Epi& E, const int tid) {
    const int wid = __builtin_amdgcn_readfirstlane(tid >> 6), lane = tid & 63, wr = wid >> 2, wc = wid & 3, fr = lane & 15, fq = lane >> 4;
    const int K = g.K, nt = K / BK;
    unsigned voffA[2], voffB[2];
#pragma unroll
    for (int i = 0; i < 2; ++i) { int R, C; stage_rc(tid * 16 + i * 8192, R, C); const int Rb = Epi::PERM ? ((R & ~31) + perm32(R & 31)) : R;
        voffA[i] = (unsigned)(R * K + C) * 2u; voffB[i] = (unsigned)(Rb * K + C) * 2u; }
    const size_t kstep = (size_t)(BK * 2);
    const size_t hstep = (size_t)HALF * K * 2;
    const size_t tstep = 2 * hstep;
    const unsigned ldsw = (unsigned)wid * 1024u;
    const int aoff = lds_byte(wr * 64 + fr, fq * 8), boff = lds_byte(wc * 32 + fr, fq * 8);
#define PG8_SA(b, h) (((b) * 2 + (h)) * HTB)
#define PG8_SB(b, h) ((4 + (b) * 2 + (h)) * HTB)
#define PG8_STAGE(bufoff, gbase, voff) do { _Pragma("unroll") for (int _i = 0; _i < 2; ++_i) \
        __builtin_amdgcn_global_load_lds((const unsigned*)((const char*)(gbase) + (voff)[_i]), (PG8_LAS unsigned*)(lds + (bufoff) + ldsw + _i * 8192), 16, 0, 0); } while (0)
#define PG8_LDA(dst, b, h) do { _Pragma("unroll") for (int m = 0; m < 4; ++m) _Pragma("unroll") for (int k = 0; k < 2; ++k) dst[m][k] = *(const PG8_LAS bf16x8*)(lds + PG8_SA(b, h) + aoff + m * 2048 + k * 1024); } while (0)
#define PG8_LDB(dst, b, h) do { _Pragma("unroll") for (int n = 0; n < 2; ++n) _Pragma("unroll") for (int k = 0; k < 2; ++k) dst[n][k] = *(const PG8_LAS bf16x8*)(lds + PG8_SB(b, h) + boff + n * 2048 + k * 1024); } while (0)
#define PG8_MMA(ai, bj, At, Bt) do { __builtin_amdgcn_s_setprio(1); _Pragma("unroll") for (int m = 0; m < 4; ++m) _Pragma("unroll") for (int n = 0; n < 2; ++n) _Pragma("unroll") for (int k = 0; k < 2; ++k) \
        acc[ai][bj][m][n] = __builtin_amdgcn_mfma_f32_16x16x32_bf16(Bt[n][k], At[m][k], acc[ai][bj][m][n], 0, 0, 0); __builtin_amdgcn_s_setprio(0); } while (0)
#define PG8_WAIT_V(n) asm volatile("s_waitcnt vmcnt(" #n ")" ::: "memory")
#define PG8_WAIT_L(n) asm volatile("s_waitcnt lgkmcnt(" #n ")" ::: "memory")
#define PG8_BAR __builtin_amdgcn_s_barrier()
#define PG8_SCHED __builtin_amdgcn_sched_barrier(0)
    Unit cur, nxt; int ui = 0;
    if (!S.next(0, cur)) return;
    f32x4 acc[2][2][4][2];
#pragma unroll
    for (int a = 0; a < 2; ++a)
#pragma unroll
        for (int b = 0; b < 2; ++b)
#pragma unroll
            for (int m = 0; m < 4; ++m)
#pragma unroll
                for (int n = 0; n < 2; ++n) acc[a][b][m][n] = (f32x4){0.f, 0.f, 0.f, 0.f};
    bf16x8 At[4][2], B0[2][2], B1[2][2];
    const char* cA = (const char*)g.A + (size_t)cur.pm * tstep; const char* cB = (const char*)g.Bt + (size_t)cur.pn * tstep;
    PG8_STAGE(PG8_SB(0, 0), cB, voffB); PG8_STAGE(PG8_SA(0, 0), cA, voffA); PG8_STAGE(PG8_SB(0, 1), cB + hstep, voffB); PG8_STAGE(PG8_SA(0, 1), cA + hstep, voffA);
    if (wr == 1) PG8_BAR;
    PG8_WAIT_V(4); PG8_BAR;
    PG8_STAGE(PG8_SB(1, 0), cB + kstep, voffB); PG8_STAGE(PG8_SA(1, 0), cA + kstep, voffA); PG8_STAGE(PG8_SB(1, 1), cB + hstep + kstep, voffB);
    PG8_WAIT_V(6); PG8_BAR;
    for (;;) {
        const bool has_next = S.next(ui + 1, nxt);
        const char* nA = has_next ? (const char*)g.A + (size_t)nxt.pm * tstep : cA; const char* nB = has_next ? (const char*)g.Bt + (size_t)nxt.pn * tstep : cB;
        for (int t = 0; t < nt; t += 2) {
            const bool last = (t == nt - 2);
            const char* a1 = cA + (size_t)(t + 1) * kstep;
            const char* a2 = last ? nA : cA + (size_t)(t + 2) * kstep; const char* b2 = last ? nB : cB + (size_t)(t + 2) * kstep;
            const char* a3 = a2 + kstep; const char* b3 = b2 + kstep;
            PG8_LDB(B0, 0, 0); PG8_SCHED; PG8_LDA(At, 0, 0); PG8_STAGE(PG8_SA(1, 1), a1 + hstep, voffA);
            PG8_WAIT_L(8); PG8_BAR; PG8_WAIT_L(0); PG8_MMA(0, 0, At, B0); PG8_BAR; PG8_SCHED;
            PG8_LDB(B1, 0, 1); PG8_STAGE(PG8_SB(0, 0), b2, voffB);
            PG8_BAR; PG8_WAIT_L(0); PG8_MMA(0, 1, At, B1); PG8_BAR;
            PG8_LDA(At, 0, 1); PG8_STAGE(PG8_SA(0, 0), a2, voffA);
            PG8_BAR; PG8_WAIT_L(0); PG8_MMA(1, 0, At, B0); PG8_BAR; PG8_SCHED;
            PG8_STAGE(PG8_SB(0, 1), b2 + hstep, voffB);
            PG8_WAIT_V(6); PG8_BAR; PG8_MMA(1, 1, At, B1); PG8_BAR;
            PG8_LDB(B0, 1, 0); PG8_SCHED; PG8_LDA(At, 1, 0); PG8_STAGE(PG8_SA(0, 1), a2 + hstep, voffA);
            PG8_WAIT_L(8); PG8_BAR; PG8_WAIT_L(0); PG8_MMA(0, 0, At, B0); PG8_BAR; PG8_SCHED;
            PG8_LDB(B1, 1, 1); PG8_STAGE(PG8_SB(1, 0), b3, voffB);
            PG8_BAR; PG8_WAIT_L(0); PG8_MMA(0, 1, At, B1); PG8_BAR;
            PG8_LDA(At, 1, 1); PG8_STAGE(PG8_SA(1, 0), a3, voffA);
            PG8_BAR; PG8_WAIT_L(0); PG8_MMA(1, 0, At, B0); PG8_BAR; PG8_SCHED;
            PG8_STAGE(PG8_SB(1, 1), b3 + hstep, voffB);
            PG8_WAIT_V(6); PG8_BAR; PG8_MMA(1, 1, At, B1); PG8_BAR;
        }
        E(acc, cur, wr, wc, fr, fq);
        if (!has_next) break;
#pragma unroll
        for (int a = 0; a < 2; ++a)
#pragma unroll
            for (int b = 0; b < 2; ++b)
#pragma unroll
                for (int m = 0; m < 4; ++m)
#pragma unroll
                    for (int n = 0; n < 2; ++n) acc[a][b][m][n] = (f32x4){0.f, 0.f, 0.f, 0.f};
        cur = nxt; cA = nA; cB = nB; ++ui;
    }
    PG8_WAIT_V(0);
    if (wr == 0) PG8_BAR;
    PG8_BAR;
#undef PG8_SA
#undef PG8_SB
#undef PG8_STAGE
#undef PG8_LDA
#undef PG8_LDB
#undef PG8_MMA
#undef PG8_WAIT_V
#undef PG8_WAIT_L
#undef PG8_BAR
#undef PG8_SCHED
}
}

template <class Epi>
__device__ __forceinline__ void gemm8_phase(const bf16_t* A, const bf16_t* Bt, int M, int N, int K, const Epi& E, unsigned char* lds, int vb, int nvb, int tid) {
    pg8::Gemm g{A, Bt, M, N, K};
    pg8::StaticOrder S; S.init(M, N, nvb, vb);
    __syncthreads();
    pg8::gemm_phase<Epi>((PG8_LAS unsigned char*)lds, g, S, E, tid);
    __syncthreads();
}

__device__ __forceinline__ void resnorm_phase(const KP& p, const float* xprompt, const float* xsample, const bf16_t* y, const float* g_post, int gate_off, int ly,
                              const float* g_pre, int sc_off, int sh_off, int lh, int vb, int nvb) {
    const int wid = p.tid >> 6, lane = p.tid & 63;
    float* X = p.out;
    bf16_t* H = wsp<bf16_t>(p, W_H);
    const float* MOD = wsp<float>(p, W_MOD);
    for (int u = vb; u < T / 32; u += nvb) {
        const int tok0 = u * 32 + wid * 4;
        const int cr = cond_row(tok0);
        f32x4 xv[4][4];
        uint4 yw[4][2];
#pragma unroll
        for (int r = 0; r < 4; r++) {
            const int tok = tok0 + r;
            const float* xs = xprompt ? (tok < TC ? xprompt + (size_t)tok * D : xsample + (size_t)(tok - TC) * D) : X + (size_t)tok * D;
#pragma unroll
            for (int i = 0; i < 2; i++) {
                xv[r][2 * i] = *(const f32x4*)(xs + i * 512 + lane * 8);
                xv[r][2 * i + 1] = *(const f32x4*)(xs + i * 512 + lane * 8 + 4);
                if (y) yw[r][i] = *(const uint4*)(y + (size_t)tok * D + i * 512 + lane * 8);
            }
        }
        if (y) {
            const float* gate = MOD + (size_t)(ly * 5 + cr) * 6144 + gate_off;
            f32x4 gg[4];
#pragma unroll
            for (int i = 0; i < 2; i++)
#pragma unroll
                for (int hh = 0; hh < 2; hh++) {
                    const f32x4 gp = *(const f32x4*)(g_post + i * 512 + lane * 8 + hh * 4);
                    const f32x4 gt = *(const f32x4*)(gate + i * 512 + lane * 8 + hh * 4);
                    gg[2 * i + hh] = gp * gt;
                }
#pragma unroll
            for (int r = 0; r < 4; r++) {
                float yf[16];
                unpack8(yw[r][0], yf); unpack8(yw[r][1], yf + 8);
                float ss = 0.f;
#pragma unroll
                for (int e = 0; e < 16; e++) ss += yf[e] * yf[e];
                ss = wave_sum(ss);
                const float rs = rsqrtf(ss * (1.f / 1024.f) + EPSV);
#pragma unroll
                for (int q4 = 0; q4 < 4; q4++)
#pragma unroll
                    for (int j = 0; j < 4; j++) xv[r][q4][j] += gg[q4][j] * (yf[q4 * 4 + j] * rs);
            }
        }
        if (y || xprompt) {
#pragma unroll
            for (int r = 0; r < 4; r++)
#pragma unroll
                for (int i = 0; i < 2; i++) {
                    *(f32x4*)(X + (size_t)(tok0 + r) * D + i * 512 + lane * 8) = xv[r][2 * i];
                    *(f32x4*)(X + (size_t)(tok0 + r) * D + i * 512 + lane * 8 + 4) = xv[r][2 * i + 1];
                }
        }
        if (g_pre) {
            const float* sc = MOD + (size_t)(lh * 5 + cr) * 6144 + sc_off;
            const float* sh = MOD + (size_t)(lh * 5 + cr) * 6144 + sh_off;
            f32x4 mm[4], aa[4];
#pragma unroll
            for (int q4 = 0; q4 < 4; q4++) {
                const int co = (q4 >> 1) * 512 + lane * 8 + (q4 & 1) * 4;
                const f32x4 gp = *(const f32x4*)(g_pre + co);
                const f32x4 s1 = *(const f32x4*)(sc + co);
                aa[q4] = *(const f32x4*)(sh + co);
                mm[q4] = gp * (s1 + 1.f);
            }
#pragma unroll
            for (int r = 0; r < 4; r++) {
                float ss = 0.f;
#pragma unroll
                for (int q4 = 0; q4 < 4; q4++) ss += xv[r][q4][0] * xv[r][q4][0] + xv[r][q4][1] * xv[r][q4][1] + xv[r][q4][2] * xv[r][q4][2] + xv[r][q4][3] * xv[r][q4][3];
                ss = wave_sum(ss);
                const float rs = rsqrtf(ss * (1.f / 1024.f) + EPSV);
#pragma unroll
                for (int i = 0; i < 2; i++) {
                    float hv[8];
#pragma unroll
                    for (int j = 0; j < 4; j++) { hv[j] = xv[r][2 * i][j] * rs * mm[2 * i][j] + aa[2 * i][j]; hv[4 + j] = xv[r][2 * i + 1][j] * rs * mm[2 * i + 1][j] + aa[2 * i + 1][j]; }
                    uint4 w;
                    w.x = pg8::cvt_pk_bf16(hv[0], hv[1]); w.y = pg8::cvt_pk_bf16(hv[2], hv[3]); w.z = pg8::cvt_pk_bf16(hv[4], hv[5]); w.w = pg8::cvt_pk_bf16(hv[6], hv[7]);
                    *(uint4*)(H + (size_t)(tok0 + r) * D + i * 512 + lane * 8) = w;
                }
            }
        }
    }
}

__device__ __forceinline__ void tok_decode(int tok, bool& lat, int& b, int& t, int& L) {
    lat = tok >= TC;
    if (!lat) { b = tok >> 8; t = tok & 255; L = 256; } else { const int q = tok - TC; b = q >> 11; t = q & 2047; L = 2048; }
}
__device__ __forceinline__ uint4 pack8(const float* f) {
    uint4 w;
    w.x = pg8::cvt_pk_bf16(f[0], f[1]); w.y = pg8::cvt_pk_bf16(f[2], f[3]); w.z = pg8::cvt_pk_bf16(f[4], f[5]); w.w = pg8::cvt_pk_bf16(f[6], f[7]);
    return w;
}
template <int U, class LD, class CP>
__device__ __forceinline__ void run_task(int nbi, int vb, int nvb, int tid, LD load, CP comp) {
    for (int u0 = vb; u0 < nbi; u0 += nvb * U) {
        if constexpr (U == 1) { auto d0 = load(u0 * NT + tid); comp(u0 * NT + tid, d0); }
        if constexpr (U == 2) {
            const int i0 = u0 * NT + tid, i1 = ((u0 + nvb < nbi) ? u0 + nvb : u0) * NT + tid;
            auto d0 = load(i0); auto d1 = load(i1);
            comp(i0, d0); comp(i1, d1);
        }
        if constexpr (U == 4) {
            const int i0 = u0 * NT + tid, i1 = ((u0 + nvb < nbi) ? u0 + nvb : u0) * NT + tid, i2 = ((u0 + 2 * nvb < nbi) ? u0 + 2 * nvb : u0) * NT + tid,
                      i3 = ((u0 + 3 * nvb < nbi) ? u0 + 3 * nvb : u0) * NT + tid;
            auto d0 = load(i0); auto d1 = load(i1); auto d2 = load(i2); auto d3 = load(i3);
            comp(i0, d0); comp(i1, d1); comp(i2, d2); comp(i3, d3);
        }
    }
}
struct Ld1 { uint4 a; };
struct Ld2 { uint4 a, b; };
struct Ld3 { uint4 a, b, c; };
__device__ __forceinline__ void prep_phase(const KP& p, int l, int vb, int nvb) {
    const int tid = p.tid;
    const bf16_t* PROJ = wsp<bf16_t>(p, W_PROJ);
    const float* RA = wsp<float>(p, W_ROPEA); const float* RB = wsp<float>(p, W_ROPEB);
    {
        const float* cw = p.in[I_GCONV] + (size_t)l * 3 * 768;
        bf16_t* GQ = wsp<bf16_t>(p, W_GQ);
        static_assert(W_GK == W_GQ + (size_t)T * 256 * 2 && W_GV == W_GK + (size_t)T * 256 * 2, "GQ/GK/GV must be contiguous");
        run_task<2>(T * 96 / NT, vb, nvb, tid,
            [&](int idx) __attribute__((always_inline)) { const int tok = idx / 96, grp = idx - tok * 96; bool lat; int b, t, L; tok_decode(tok, lat, b, t, L);
                const bf16_t* s = PROJ + (size_t)tok * INC + C_GQKV + grp * 8; Ld3 d;
                d.b = *(const uint4*)s;
                d.a = (t > 0) ? *(const uint4*)(s - INC) : make_uint4(0u, 0u, 0u, 0u);
                d.c = (t < L - 1) ? *(const uint4*)(s + INC) : make_uint4(0u, 0u, 0u, 0u);
                return d; },
            [&](int idx, const Ld3& d) __attribute__((always_inline)) { const int tok = idx / 96, grp = idx - tok * 96;
                float xp[8], xc[8], xn[8], y[8]; unpack8(d.a, xp); unpack8(d.b, xc); unpack8(d.c, xn);
                float ss = 0.f;
#pragma unroll
                for (int e = 0; e < 8; e++) {
                    const int ch = grp * 8 + e;
                    float v = xp[e] * cw[ch] + xc[e] * cw[768 + ch] + xn[e] * cw[1536 + ch];
                    v = v / (1.f + __expf(-v));
                    y[e] = v; ss += v * v;
                }
                ss += __shfl_xor(ss, 1); ss += __shfl_xor(ss, 2); ss += __shfl_xor(ss, 4);
                if (grp < 64) { const float sc = rsqrtf(ss + EPSV) * (grp < 32 ? 0.125f : 1.f);
#pragma unroll
                    for (int e = 0; e < 8; e++) y[e] *= sc; }
                bf16_t* dst = GQ + (size_t)(grp >> 5) * ((size_t)T * 256) + (size_t)tok * 256 + (grp & 31) * 8;
                *(uint4*)dst = pack8(y); });
    }
    {
        bf16_t* CKVN = wsp<bf16_t>(p, W_CKVN);
        run_task<4>(T * 16 / NT, vb, nvb, tid,
            [&](int idx) __attribute__((always_inline)) { const int tok = idx >> 4, grp = idx & 15; Ld1 d; d.a = *(const uint4*)(PROJ + (size_t)tok * INC + C_CKV + grp * 8); return d; },
            [&](int idx, const Ld1& d) __attribute__((always_inline)) { const int tok = idx >> 4, grp = idx & 15; bool lat; int b, t, L; tok_decode(tok, lat, b, t, L);
                float x[8]; unpack8(d.a, x);
                float ss = 0.f;
#pragma unroll
                for (int e = 0; e < 8; e++) ss += x[e] * x[e];
                ss += __shfl_xor(ss, 1); ss += __shfl_xor(ss, 2); ss += __shfl_xor(ss, 4); ss += __shfl_xor(ss, 8);
                const float rs = rsqrtf(ss * (1.f / 128.f) + EPSV);
                const float* gw = p.in[I_KVNORM] + l * 128 + grp * 8;
#pragma unroll
                for (int e = 0; e < 8; e++) x[e] = x[e] * rs * gw[e];
                *(uint4*)(CKVN + (size_t)tok * 128 + grp * 8) = pack8(x);
                if (!lat) { float* o = p.out + O_CKV + ((size_t)(b * 2 + l) * 256 + t) * 128 + grp * 8;
                    *(f32x4*)o = (f32x4){x[0], x[1], x[2], x[3]}; *(f32x4*)(o + 4) = (f32x4){x[4], x[5], x[6], x[7]}; } });
    }
    {
        run_task<4>(T * 148 / NT, vb, nvb, tid,
            [&](int idx) __attribute__((always_inline)) { const int tok = idx / 148, sg = idx - tok * 148; int col;
                if (sg < 4) col = C_KPE + sg * 8; else if (sg < 52) col = C_MQ + (sg - 4) * 8; else if (sg < 84) col = C_SQ + (sg - 52) * 8;
                else if (sg < 100) col = C_SK + (sg - 84) * 8; else if (sg < 116) col = C_SV + (sg - 100) * 8; else col = C_GZ + (sg - 116) * 8;
                Ld1 d; d.a = *(const uint4*)(PROJ + (size_t)tok * INC + col); return d; },
            [&](int idx, const Ld1& d) __attribute__((always_inline)) { const int tok = idx / 148, sg = idx - tok * 148; bool lat; int b, t, L; tok_decode(tok, lat, b, t, L);
                bf16_t* dst; const float* rope = nullptr; float* cout = nullptr; const size_t ob = (size_t)(b * 2 + l) * 256 + t;
                if (sg < 4) { dst = wsp<bf16_t>(p, W_KPE) + (size_t)tok * 32 + sg * 8; rope = RA + (t * 16 + sg * 4) * 2; cout = p.out + O_KPE + ob * 32 + sg * 8; }
                else if (sg < 52) { const int g2 = sg - 4, part = g2 % 12; dst = wsp<bf16_t>(p, W_QMLA) + (size_t)tok * 384 + g2 * 8; if (part >= 8) rope = RA + (t * 16 + (part - 8) * 4) * 2; }
                else if (sg < 84) { const int g2 = sg - 52; dst = wsp<bf16_t>(p, W_QSWA) + (size_t)tok * 256 + g2 * 8; rope = RB + (t * 32 + (g2 & 7) * 4) * 2; }
                else if (sg < 100) { const int g2 = sg - 84; dst = wsp<bf16_t>(p, W_KSWA) + (size_t)tok * 128 + g2 * 8; rope = RB + (t * 32 + (g2 & 7) * 4) * 2; cout = p.out + O_SK + ob * 128 + g2 * 8; }
                else if (sg < 116) { const int g2 = sg - 100; dst = wsp<bf16_t>(p, W_VSWA) + (size_t)tok * 128 + g2 * 8; cout = p.out + O_SV + ob * 128 + g2 * 8; }
                else { const int g2 = sg - 116; dst = wsp<bf16_t>(p, W_GZ) + (size_t)tok * 256 + g2 * 8; }
                uint4 w = d.a;
                if (lat) {
                    if (rope) {
                        float x[8]; unpack8(d.a, x);
                        const f32x4 c0 = *(const f32x4*)rope, c1 = *(const f32x4*)(rope + 4);
                        float y[8];
                        y[0] = x[0] * c0[0] - x[1] * c0[1]; y[1] = x[0] * c0[1] + x[1] * c0[0];
                        y[2] = x[2] * c0[2] - x[3] * c0[3]; y[3] = x[2] * c0[3] + x[3] * c0[2];
                        y[4] = x[4] * c1[0] - x[5] * c1[1]; y[5] = x[4] * c1[1] + x[5] * c1[0];
                        y[6] = x[6] * c1[2] - x[7] * c1[3]; y[7] = x[6] * c1[3] + x[7] * c1[2];
                        w = pack8(y);
                    }
                } else if (cout) {
                    float x[8]; unpack8(d.a, x);
                    *(f32x4*)cout = (f32x4){x[0], x[1], x[2], x[3]}; *(f32x4*)(cout + 4) = (f32x4){x[4], x[5], x[6], x[7]};
                }
                *(uint4*)dst = w; });
    }
    {
        float* GG = wsp<float>(p, W_GG); float* GBETA = wsp<float>(p, W_GBETA);
        run_task<2>(T / NT, vb, nvb, tid,
            [&](int idx) __attribute__((always_inline)) { Ld2 d; d.a = *(const uint4*)(PROJ + (size_t)idx * INC + C_GA); d.b = *(const uint4*)(PROJ + (size_t)idx * INC + C_GB); return d; },
            [&](int idx, const Ld2& d) __attribute__((always_inline)) { float a[8], bb[8], go[8], bo[8]; unpack8(d.a, a); unpack8(d.b, bb);
#pragma unroll
                for (int e = 0; e < 8; e++) {
                    const float xx = a[e] + p.in[I_GDT][l * 8 + e];
                    const float sp = xx > 20.f ? xx : __logf(1.f + __expf(xx));
                    go[e] = -__expf(p.in[I_GALOG][l * 8 + e]) * sp;
                    bo[e] = 1.f / (1.f + __expf(-bb[e]));
                }
                *(f32x4*)(GG + (size_t)idx * 8) = (f32x4){go[0], go[1], go[2], go[3]}; *(f32x4*)(GG + (size_t)idx * 8 + 4) = (f32x4){go[4], go[5], go[6], go[7]};
                *(f32x4*)(GBETA + (size_t)idx * 8) = (f32x4){bo[0], bo[1], bo[2], bo[3]}; *(f32x4*)(GBETA + (size_t)idx * 8 + 4) = (f32x4){bo[4], bo[5], bo[6], bo[7]}; });
    }
}

template <int D2, bool MASK>
__device__ __forceinline__ void attn_seg(const float* q, float* acc, float& m, float& lsum, const bf16_t* k1, int s1, const bf16_t* k2, int s2,
                                         const bf16_t* v, int sv, int j0, int j1, int tq) {
#pragma unroll 1
    for (int j = j0; j < j1; j += 2) {
        float sa = 0.f, sb = 0.f;
        const bf16_t* kpa = k1 + (size_t)j * s1;
        const bf16_t* kpb = kpa + s1;
#pragma unroll
        for (int c = 0; c < 8; c++) {
            float ka[8], kb[8]; unpack8(*(const uint4*)(kpa + c * 8), ka); unpack8(*(const uint4*)(kpb + c * 8), kb);
#pragma unroll
            for (int e = 0; e < 8; e++) { sa += q[c * 8 + e] * ka[e]; sb += q[c * 8 + e] * kb[e]; }
        }
        if (D2 > 0) {
            const bf16_t* k2a = k2 + (size_t)j * s2;
            const bf16_t* k2b = k2a + s2;
#pragma unroll
            for (int c = 0; c < D2 / 8; c++) {
                float ka[8], kb[8]; unpack8(*(const uint4*)(k2a + c * 8), ka); unpack8(*(const uint4*)(k2b + c * 8), kb);
#pragma unroll
                for (int e = 0; e < 8; e++) { sa += q[64 + c * 8 + e] * ka[e]; sb += q[64 + c * 8 + e] * kb[e]; }
            }
        }
        if (MASK) {
            int dlt = tq - j; if (dlt > 128 || dlt < -128) sa = -1e30f;
            dlt -= 1; if (dlt > 128 || dlt < -128) sb = -1e30f;
        }
        const float mn = fmaxf(m, fmaxf(sa, sb));
        const float alpha = __expf(m - mn);
        const float pa = __expf(sa - mn), pb = __expf(sb - mn);
        lsum = lsum * alpha + pa + pb;
        m = mn;
        const bf16_t* va = v + (size_t)j * sv;
        const bf16_t* vb = va + sv;
#pragma unroll
        for (int c = 0; c < 8; c++) {
            float xa[8], xb[8]; unpack8(*(const uint4*)(va + c * 8), xa); unpack8(*(const uint4*)(vb + c * 8), xb);
#pragma unroll
            for (int e = 0; e < 8; e++) acc[c * 8 + e] = acc[c * 8 + e] * alpha + pa * xa[e] + pb * xb[e];
        }
    }
}

__device__ __forceinline__ void mla_wave(const KP& p, int l, bool lat, int b, int h, int qblk, int lane) {
    const int L = lat ? 2048 : 256, seq0 = lat ? TC + b * 2048 : b * 256;
    const int tq = seq0 + qblk * 64 + lane;
    const bf16_t* QMLA = wsp<bf16_t>(p, W_QMLA);
    const bf16_t* KVX = wsp<bf16_t>(p, W_KVX);
    const bf16_t* KPE = wsp<bf16_t>(p, W_KPE);
    float q[96], acc[64];
    const float scale = 0.10206207261596577f;
#pragma unroll
    for (int c = 0; c < 12; c++) {
        float t8[8]; unpack8(*(const uint4*)(QMLA + (size_t)tq * 384 + h * 96 + c * 8), t8);
#pragma unroll
        for (int e = 0; e < 8; e++) q[c * 8 + e] = t8[e] * scale;
    }
#pragma unroll
    for (int d = 0; d < 64; d++) acc[d] = 0.f;
    float m = -1e30f, lsum = 0.f;
    attn_seg<32, false>(q, acc, m, lsum, KVX + (size_t)seq0 * 512 + h * 128, 512, KPE + (size_t)seq0 * 32, 32, KVX + (size_t)seq0 * 512 + h * 128 + 64, 512, 0, L, 0);
    if (lat) {
        const bf16_t* KVC = wsp<bf16_t>(p, W_KVC) + ((size_t)l * 2048 + b * 512) * 512;
        const bf16_t* KPEC = wsp<bf16_t>(p, W_KPEC) + ((size_t)l * 2048 + b * 512) * 32;
        attn_seg<32, false>(q, acc, m, lsum, KVC + h * 128, 512, KPEC, 32, KVC + h * 128 + 64, 512, 0, 512, 0);
    }
    const float inv = 1.f / lsum;
    bf16_t* O = wsp<bf16_t>(p, W_H) + (size_t)tq * 1024 + h * 64;
#pragma unroll
    for (int c = 0; c < 8; c++) {
        uint4 w;
        w.x = (unsigned)f2bf(acc[c * 8 + 0] * inv) | ((unsigned)f2bf(acc[c * 8 + 1] * inv) << 16);
        w.y = (unsigned)f2bf(acc[c * 8 + 2] * inv) | ((unsigned)f2bf(acc[c * 8 + 3] * inv) << 16);
        w.z = (unsigned)f2bf(acc[c * 8 + 4] * inv) | ((unsigned)f2bf(acc[c * 8 + 5] * inv) << 16);
        w.w = (unsigned)f2bf(acc[c * 8 + 6] * inv) | ((unsigned)f2bf(acc[c * 8 + 7] * inv) << 16);
        *(uint4*)(O + c * 8) = w;
    }
}

__device__ __forceinline__ void swa_wave(const KP& p, int l, bool lat, int b, int h, int qblk, int lane) {
    const int L = lat ? 2048 : 256, seq0 = lat ? TC + b * 2048 : b * 256;
    const int tql = qblk * 64 + lane, tq = seq0 + tql, hk = h >> 1;
    const bf16_t* QSWA = wsp<bf16_t>(p, W_QSWA);
    const bf16_t* KSWA = wsp<bf16_t>(p, W_KSWA);
    const bf16_t* VSWA = wsp<bf16_t>(p, W_VSWA);
    float q[64], acc[64];
#pragma unroll
    for (int c = 0; c < 8; c++) {
        float t8[8]; unpack8(*(const uint4*)(QSWA + (size_t)tq * 256 + h * 64 + c * 8), t8);
#pragma unroll
        for (int e = 0; e < 8; e++) q[c * 8 + e] = t8[e] * 0.125f;
    }
#pragma unroll
    for (int d = 0; d < 64; d++) acc[d] = 0.f;
    float m = p.in[I_SINK][l * 4 + h], lsum = 1.f;
    if (lat) {
        int jlo = qblk * 64 - 128; if (jlo < 0) jlo = 0;
        int jhi = qblk * 64 + 64 + 128; if (jhi > L) jhi = L;
        attn_seg<0, true>(q, acc, m, lsum, KSWA + (size_t)seq0 * 128 + hk * 64, 128, nullptr, 0, VSWA + (size_t)seq0 * 128 + hk * 64, 128, jlo, jhi, tql);
        const bf16_t* KC = wsp<bf16_t>(p, W_KSWC) + ((size_t)l * 2048 + b * 512) * 128 + hk * 64;
        const bf16_t* VC = wsp<bf16_t>(p, W_VSWC) + ((size_t)l * 2048 + b * 512) * 128 + hk * 64;
        attn_seg<0, false>(q, acc, m, lsum, KC, 128, nullptr, 0, VC, 128, 0, 512, 0);
    } else {
        attn_seg<0, false>(q, acc, m, lsum, KSWA + (size_t)seq0 * 128 + hk * 64, 128, nullptr, 0, VSWA + (size_t)seq0 * 128 + hk * 64, 128, 0, L, 0);
    }
    const float inv = 1.f / lsum;
    bf16_t* O = wsp<bf16_t>(p, W_H) + (size_t)tq * 1024 + 256 + h * 64;
#pragma unroll
    for (int c = 0; c < 8; c++) {
        uint4 w;
        w.x = (unsigned)f2bf(acc[c * 8 + 0] * inv) | ((unsigned)f2bf(acc[c * 8 + 1] * inv) << 16);
        w.y = (unsigned)f2bf(acc[c * 8 + 2] * inv) | ((unsigned)f2bf(acc[c * 8 + 3] * inv) << 16);
        w.z = (unsigned)f2bf(acc[c * 8 + 4] * inv) | ((unsigned)f2bf(acc[c * 8 + 5] * inv) << 16);
        w.w = (unsigned)f2bf(acc[c * 8 + 6] * inv) | ((unsigned)f2bf(acc[c * 8 + 7] * inv) << 16);
        *(uint4*)(O + c * 8) = w;
    }
}


__device__ __forceinline__ float xmax16(float v) { auto r = __builtin_amdgcn_permlane16_swap(__float_as_uint(v), __float_as_uint(v), false, false); return fmaxf(__uint_as_float(r[0]), __uint_as_float(r[1])); }
__device__ __forceinline__ float xmax32(float v) { auto r = __builtin_amdgcn_permlane32_swap(__float_as_uint(v), __float_as_uint(v), false, false); return fmaxf(__uint_as_float(r[0]), __uint_as_float(r[1])); }
__device__ __forceinline__ float xsum16(float v) { auto r = __builtin_amdgcn_permlane16_swap(__float_as_uint(v), __float_as_uint(v), false, false); return __uint_as_float(r[0]) + __uint_as_float(r[1]); }
__device__ __forceinline__ float xsum32(float v) { auto r = __builtin_amdgcn_permlane32_swap(__float_as_uint(v), __float_as_uint(v), false, false); return __uint_as_float(r[0]) + __uint_as_float(r[1]); }
typedef short s16x4 __attribute__((ext_vector_type(4)));
#define LDS_AS __attribute__((address_space(3)))
template <int TYPE  >
__device__ __forceinline__ void attn_unit(const KP& p, int l, bool lat, int b, int h, int qb, unsigned char* lds) {
    constexpr int NKS = TYPE == 0 ? 3 : 2;
    constexpr int KSTR = TYPE == 0 ? 208 : 144;
    constexpr int VSTR = 160;
    constexpr int KT = 128, MT = KT / 16;
    constexpr int KBUF = KT * KSTR, VBUF = KT * VSTR;
    const int tid = p.tid, wid = tid >> 6, lane = tid & 63, fr = lane & 15, g = lane >> 4;
    const int L = lat ? 2048 : 256, seq0 = lat ? TC + b * 2048 : b * 256;
    const int q0 = qb * 128;
    const int tql = q0 + wid * 16 + fr;
    const int hk = h >> 1;
    bf16x8 qf[NKS];
    {
        const bf16_t* qp = TYPE == 0 ? wsp<bf16_t>(p, W_QMLA) + (size_t)(seq0 + tql) * 384 + h * 96 : wsp<bf16_t>(p, W_QSWA) + (size_t)(seq0 + tql) * 256 + h * 64;
#pragma unroll
        for (int ks = 0; ks < NKS; ks++) qf[ks] = *(const bf16x8*)(qp + ks * 32 + g * 8);
    }
    const float sc2 = (TYPE == 0 ? 0.10206207261596577f : 0.125f) * 1.4426950408889634f;
    float m2 = TYPE == 0 ? -1e30f : p.in[I_SINK][l * 4 + h] * 1.4426950408889634f;
    float lsum = (TYPE == 1 && g == 0) ? 1.f : 0.f;
    f32x4 oacc[4];
#pragma unroll
    for (int i = 0; i < 4; i++) oacc[i] = (f32x4){0.f, 0.f, 0.f, 0.f};
    int j0 = 0, j1 = L;
    if (TYPE == 1 && lat) { j0 = q0 - 128; if (j0 < 0) j0 = 0; j1 = q0 + 256; if (j1 > L) j1 = L; }
    const int nt0 = (j1 - j0) / KT, nt = nt0 + (lat ? 512 / KT : 0);
    uint4 ra0, ra1, ra2, ra3, ra4, rb0, rb1, rb2, rb3, rb4;
    auto tile_ptrs = [&](int it, const bf16_t*& kb, int& kstr, const bf16_t*& pb, const bf16_t*& vb, int& vstr) __attribute__((always_inline)) {
        if (it < nt0) {
            const size_t t0 = (size_t)seq0 + j0 + it * KT;
            if (TYPE == 0) { kb = wsp<bf16_t>(p, W_KVX) + t0 * 512 + h * 128; kstr = 512; pb = wsp<bf16_t>(p, W_KPE) + t0 * 32; vb = kb + 64; vstr = 512; }
            else { kb = wsp<bf16_t>(p, W_KSWA) + t0 * 128 + hk * 64; kstr = 128; pb = nullptr; vb = wsp<bf16_t>(p, W_VSWA) + t0 * 128 + hk * 64; vstr = 128; }
        } else {
            const size_t t0 = (size_t)l * 2048 + b * 512 + (it - nt0) * KT;
            if (TYPE == 0) { kb = wsp<bf16_t>(p, W_KVC) + t0 * 512 + h * 128; kstr = 512; pb = wsp<bf16_t>(p, W_KPEC) + t0 * 32; vb = kb + 64; vstr = 512; }
            else { kb = wsp<bf16_t>(p, W_KSWC) + t0 * 128 + hk * 64; kstr = 128; pb = nullptr; vb = wsp<bf16_t>(p, W_VSWC) + t0 * 128 + hk * 64; vstr = 128; }
        }
    };
#define ATT_GLOAD(R0, R1, R2, R3, R4, it_) do { const bf16_t* kb_; const bf16_t* pb_; const bf16_t* vb_; int ks_, vs_; tile_ptrs((it_), kb_, ks_, pb_, vb_, vs_); \
        R0 = *(const uint4*)(kb_ + (size_t)(tid >> 3) * ks_ + (tid & 7) * 8); R1 = *(const uint4*)(kb_ + (size_t)(64 + (tid >> 3)) * ks_ + (tid & 7) * 8); \
        R2 = *(const uint4*)(vb_ + (size_t)(tid >> 3) * vs_ + (tid & 7) * 8); R3 = *(const uint4*)(vb_ + (size_t)(64 + (tid >> 3)) * vs_ + (tid & 7) * 8); \
        if (TYPE == 0) R4 = *(const uint4*)(pb_ + (size_t)(tid >> 2) * 32 + (tid & 3) * 8); } while (0)
#define ATT_LSTORE(R0, R1, R2, R3, R4, buf_) do { unsigned char* kd_ = lds + (buf_) * (KBUF + VBUF); unsigned char* vd_ = kd_ + KBUF; \
        *(uint4*)(kd_ + (tid >> 3) * KSTR + (tid & 7) * 16) = R0; *(uint4*)(kd_ + (64 + (tid >> 3)) * KSTR + (tid & 7) * 16) = R1; \
        *(uint4*)(vd_ + (tid >> 3) * VSTR + (tid & 7) * 16) = R2; *(uint4*)(vd_ + (64 + (tid >> 3)) * VSTR + (tid & 7) * 16) = R3; \
        if (TYPE == 0) *(uint4*)(kd_ + (tid >> 2) * KSTR + 128 + (tid & 3) * 16) = R4; } while (0)
    auto compute_tile = [&](int it) __attribute__((always_inline)) {
        const unsigned char* kd = lds + (it & 1) * (KBUF + VBUF);
        const unsigned char* vd = kd + KBUF;
        f32x4 sacc[MT];
#pragma unroll
        for (int mt = 0; mt < MT; mt++) sacc[mt] = (f32x4){0.f, 0.f, 0.f, 0.f};
#pragma unroll
        for (int ks = 0; ks < NKS; ks++)
#pragma unroll
            for (int mt = 0; mt < MT; mt++) {
                bf16x8 a = *(const bf16x8*)(kd + (mt * 16 + fr) * KSTR + ks * 64 + g * 16);
                sacc[mt] = __builtin_amdgcn_mfma_f32_16x16x32_bf16(a, qf[ks], sacc[mt], 0, 0, 0);
            }
        float mx = -3e38f;
        const bool domask = (TYPE == 1) && lat && (it < nt0);
        const int jbase = j0 + it * KT + 4 * g;
#pragma unroll
        for (int mt = 0; mt < MT; mt++)
#pragma unroll
            for (int r = 0; r < 4; r++) {
                float s = sacc[mt][r] * sc2;
                if (domask) { int dlt = tql - (jbase + mt * 16 + r); if (dlt > 128 || dlt < -128) s = -1e30f; }
                sacc[mt][r] = s;
                mx = fmaxf(mx, s);
            }
        mx = xmax16(mx);
        mx = xmax32(mx);
        const float mn = fmaxf(m2, mx);
        const float alpha = __builtin_amdgcn_exp2f(m2 - mn);
        m2 = mn;
        float ps = 0.f;
#pragma unroll
        for (int mt = 0; mt < MT; mt++)
#pragma unroll
            for (int r = 0; r < 4; r++) { float pv = __builtin_amdgcn_exp2f(sacc[mt][r] - mn); sacc[mt][r] = pv; ps += pv; }
        lsum = lsum * alpha + ps;
#pragma unroll
        for (int i = 0; i < 4; i++) oacc[i] *= alpha;
        bf16x8 pf[MT / 2];
#pragma unroll
        for (int s = 0; s < MT / 2; s++) {
            union { unsigned u[4]; bf16x8 v; } cv;
            cv.u[0] = pg8::cvt_pk_bf16(sacc[2 * s][0], sacc[2 * s][1]); cv.u[1] = pg8::cvt_pk_bf16(sacc[2 * s][2], sacc[2 * s][3]);
            cv.u[2] = pg8::cvt_pk_bf16(sacc[2 * s + 1][0], sacc[2 * s + 1][1]); cv.u[3] = pg8::cvt_pk_bf16(sacc[2 * s + 1][2], sacc[2 * s + 1][3]);
            pf[s] = cv.v;
        }
#pragma unroll
        for (int md = 0; md < 4; md++)
#pragma unroll
            for (int s = 0; s < MT / 2; s++) {
                const unsigned char* va = vd + (32 * s + 4 * g + (fr >> 2)) * VSTR + (md * 16 + (fr & 3) * 4) * 2;
                s16x4 lo = __builtin_amdgcn_ds_read_tr16_b64_v4i16((LDS_AS s16x4*)(va));
                s16x4 hi = __builtin_amdgcn_ds_read_tr16_b64_v4i16((LDS_AS s16x4*)(va + 16 * VSTR));
                bf16x8 a;
                a[0] = lo[0]; a[1] = lo[1]; a[2] = lo[2]; a[3] = lo[3]; a[4] = hi[0]; a[5] = hi[1]; a[6] = hi[2]; a[7] = hi[3];
                oacc[md] = __builtin_amdgcn_mfma_f32_16x16x32_bf16(a, pf[s], oacc[md], 0, 0, 0);
            }
    };
    __syncthreads();
    ATT_GLOAD(ra0, ra1, ra2, ra3, ra4, 0);
    ATT_LSTORE(ra0, ra1, ra2, ra3, ra4, 0);
    if (nt > 1) ATT_GLOAD(rb0, rb1, rb2, rb3, rb4, 1);
    __syncthreads();
#pragma unroll 1
    for (int it = 0; it < nt; it += 2) {
        if (it + 2 < nt) ATT_GLOAD(ra0, ra1, ra2, ra3, ra4, it + 2);
        compute_tile(it);
        if (it + 1 < nt) ATT_LSTORE(rb0, rb1, rb2, rb3, rb4, 1);
        __syncthreads();
        if (it + 1 < nt) {
            if (it + 3 < nt) ATT_GLOAD(rb0, rb1, rb2, rb3, rb4, it + 3);
            compute_tile(it + 1);
            if (it + 2 < nt) ATT_LSTORE(ra0, ra1, ra2, ra3, ra4, 0);
            __syncthreads();
        }
    }
    lsum = xsum16(lsum);
    lsum = xsum32(lsum);
    const float inv = 1.f / lsum;
    bf16_t* O = wsp<bf16_t>(p, W_H) + (size_t)(seq0 + tql) * 1024 + (TYPE == 0 ? 0 : 256) + h * 64;
#pragma unroll
    for (int md = 0; md < 4; md++) {
        uint2 w;
        w.x = (unsigned)f2bf(oacc[md][0] * inv) | ((unsigned)f2bf(oacc[md][1] * inv) << 16);
        w.y = (unsigned)f2bf(oacc[md][2] * inv) | ((unsigned)f2bf(oacc[md][3] * inv) << 16);
        *(uint2*)(O + md * 16 + 4 * g) = w;
    }
}

struct GdnCombo { bool lat; int b, dir, h, L, seq0, nch, ubase; };
__device__ __forceinline__ GdnCombo gdn_combo(int cid  ) {
    GdnCombo c;
    c.lat = cid >= 128;
    const int x = c.lat ? cid - 128 : cid;
    c.b = x >> 3; c.dir = (x >> 2) & 1; c.h = x & 3;
    c.L = c.lat ? 2048 : 256; c.seq0 = c.lat ? TC + c.b * 2048 : c.b * 256; c.nch = c.lat ? 32 : 4;
    c.ubase = c.lat ? 512 + x * 32 : x * 4;
    return c;
}
constexpr int G1_SLOT = 64 * 68 * 4 + 512 + 4096;
__device__ __forceinline__ void gdn_g1_unit(const KP& p, int l, int bu  , unsigned char* lds) {
    const int tid = p.tid, wid = tid >> 6, lane = tid & 63, fr = lane & 15, g = lane >> 4;
    const int slot = wid >> 1, half = wid & 1, tl = half * 64 + lane;
    int cid, n0;
    if (bu < 128) { cid = bu; n0 = 0; } else { cid = 128 + ((bu - 128) >> 3); n0 = ((bu - 128) & 7) * 4; }
    const GdnCombo cb = gdn_combo(cid);
    const int n = n0 + slot, nu = cb.ubase + n;
    float* As = (float*)(lds + slot * G1_SLOT);
    float* decs = As + 64 * 68;
    float* betas = decs + 64;
    const bf16_t* GQ = wsp<bf16_t>(p, W_GQ); const bf16_t* GK = wsp<bf16_t>(p, W_GK); const bf16_t* GV = wsp<bf16_t>(p, W_GV);
    const float* GG = wsp<float>(p, W_GG); const float* GBETA = wsp<float>(p, W_GBETA);
    auto tok_of = [&](int c) __attribute__((always_inline)) -> size_t { int pos = n * 64 + c; return (size_t)cb.seq0 + (cb.dir ? cb.L - 1 - pos : pos); };
    __syncthreads();
    if (half == 0) {
        const size_t tk = tok_of(lane);
        float gv = GG[tk * 8 + cb.dir * 4 + cb.h];
#pragma unroll
        for (int o = 1; o < 64; o <<= 1) { float t = __shfl_up(gv, o); if (lane >= o) gv += t; }
        decs[lane] = gv;
        betas[lane] = GBETA[tk * 8 + cb.dir * 4 + cb.h];
    }
    __syncthreads();
    {
        bf16x8 kf[4][2], qf[4][2];
#pragma unroll
        for (int x = 0; x < 4; x++) {
            const size_t tk = tok_of(16 * x + fr);
#pragma unroll
            for (int ks = 0; ks < 2; ks++) {
                kf[x][ks] = *(const bf16x8*)(GK + tk * 256 + cb.h * 64 + ks * 32 + g * 8);
                if (half == 1) qf[x][ks] = *(const bf16x8*)(GQ + tk * 256 + cb.h * 64 + ks * 32 + g * 8);
                else qf[x][ks] = kf[x][ks];
            }
        }
#pragma unroll
        for (int nt = 0; nt < 4; nt++) {
            const int c = 16 * nt + fr;
            const float dc = decs[c], bc = betas[c];
#pragma unroll
            for (int mt = 0; mt < 4; mt++) {
                f32x4 acc = (f32x4){0.f, 0.f, 0.f, 0.f};
#pragma unroll
                for (int ks = 0; ks < 2; ks++) acc = __builtin_amdgcn_mfma_f32_16x16x32_bf16(kf[mt][ks], qf[nt][ks], acc, 0, 0, 0);
                const int s0 = 16 * mt + 4 * g;
                f32x4 ds = *(const f32x4*)(decs + s0);
                f32x4 o;
#pragma unroll
                for (int r = 0; r < 4; r++) {
                    const int s = s0 + r;
                    const float gm = __expf(dc - ds[r]);
                    if (half == 0) o[r] = (s < c) ? bc * acc[r] * gm : 0.f;
                    else o[r] = (s <= c) ? acc[r] * gm : 0.f;
                }
                if (half == 0) *(f32x4*)(As + c * 68 + s0) = o;
                else {
                    uint2 w;
                    w.x = (unsigned)f2bf(o[0]) | ((unsigned)f2bf(o[1]) << 16);
                    w.y = (unsigned)f2bf(o[2]) | ((unsigned)f2bf(o[3]) << 16);
                    *(uint2*)(wsp<bf16_t>(p, W_GAQK) + (size_t)nu * 4096 + c * 64 + 32 * (mt >> 1) + 8 * g + 4 * (mt & 1)) = w;
                }
            }
        }
    }
    __syncthreads();
    float* Tl = betas + 64;
    if (half == 0) {
        const int bi = lane >> 4, j = lane & 15;
        float t[16];
#pragma unroll
        for (int c = 0; c < 16; c++) {
            float s = (c == j) ? 1.f : 0.f;
#pragma unroll
            for (int s2 = 0; s2 < c; s2++) s -= As[(16 * bi + c) * 68 + 16 * bi + s2] * t[s2];
            t[c] = s;
        }
#pragma unroll
        for (int c = 0; c < 16; c++) Tl[(bi * 16 + c) * 16 + j] = t[c];
    }
    __syncthreads();
    {
        f32x4 X[4][4];
#pragma unroll
        for (int i = 0; i < 4; i++) {
#pragma unroll
            for (int r = 0; r < 4; r++) {
                const int row = 16 * i + 4 * g + r;
                const size_t tk = tok_of(row);
                const float sc = half ? betas[row] * __expf(decs[row]) : betas[row];
                const bf16_t* srcp = (half ? GK : GV) + tk * 256 + cb.h * 64 + fr;
#pragma unroll
                for (int nt = 0; nt < 4; nt++) X[i][nt][r] = bf2f(srcp[16 * nt]) * sc;
            }
#pragma unroll
            for (int j = 0; j < 4; j++) {
                if (j < i) {
#pragma unroll
                    for (int ks = 0; ks < 4; ks++) {
                        const float av = -As[(16 * i + fr) * 68 + 16 * j + 4 * g + ks];
#pragma unroll
                        for (int nt = 0; nt < 4; nt++) X[i][nt] = __builtin_amdgcn_mfma_f32_16x16x4f32(av, X[j][nt][ks], X[i][nt], 0, 0, 0);
                    }
                }
            }
            f32x4 Y[4];
#pragma unroll
            for (int nt = 0; nt < 4; nt++) Y[nt] = (f32x4){0.f, 0.f, 0.f, 0.f};
#pragma unroll
            for (int ks = 0; ks < 4; ks++) {
                const float tv = Tl[(i * 16 + fr) * 16 + 4 * g + ks];
#pragma unroll
                for (int nt = 0; nt < 4; nt++) Y[nt] = __builtin_amdgcn_mfma_f32_16x16x4f32(tv, X[i][nt][ks], Y[nt], 0, 0, 0);
            }
#pragma unroll
            for (int nt = 0; nt < 4; nt++) X[i][nt] = Y[nt];
        }
        if (half == 0) {
            bf16_t* dst = wsp<bf16_t>(p, W_GUV) + (size_t)nu * 4096 + lane * 4;
#pragma unroll
            for (int i = 0; i < 4; i++)
#pragma unroll
                for (int nt = 0; nt < 4; nt++) {
                    uint2 w; w.x = pg8::cvt_pk_bf16(X[i][nt][0], X[i][nt][1]); w.y = pg8::cvt_pk_bf16(X[i][nt][2], X[i][nt][3]);
                    *(uint2*)(dst + (nt * 4 + i) * 256) = w;
                }
        } else {
            bf16_t* dst = wsp<bf16_t>(p, W_GW) + (size_t)nu * 4096;
#pragma unroll
            for (int nt = 0; nt < 4; nt++) {
                const int d = 16 * nt + fr;
                const int pcol = 32 * (d >> 5) + 8 * ((d >> 2) & 3) + 4 * ((d >> 4) & 1) + (d & 3);
#pragma unroll
                for (int i = 0; i < 4; i++)
#pragma unroll
                    for (int r = 0; r < 4; r++) dst[(16 * i + 4 * g + r) * 64 + pcol] = f2bf(-X[i][nt][r]);
            }
        }
    }
    {
        const int dkk = tl & 63, chalf = tl >> 6;
        const float dlast = decs[63];
        bf16_t* dst = wsp<bf16_t>(p, W_GKTT) + (size_t)nu * 4096 + dkk * 64 + chalf * 32;
#pragma unroll
        for (int c8 = 0; c8 < 4; c8++) {
            unsigned w[4];
#pragma unroll
            for (int e = 0; e < 8; e += 2) {
                const int c0 = chalf * 32 + c8 * 8 + e;
                float v0 = bf2f(GK[tok_of(c0) * 256 + cb.h * 64 + dkk]) * __expf(dlast - decs[c0]);
                float v1 = bf2f(GK[tok_of(c0 + 1) * 256 + cb.h * 64 + dkk]) * __expf(dlast - decs[c0 + 1]);
                w[e >> 1] = (unsigned)f2bf(v0) | ((unsigned)f2bf(v1) << 16);
            }
            *(uint2*)(dst + 16 * (c8 & 1) + 4 * (c8 >> 1)) = make_uint2(w[0], w[1]);
            *(uint2*)(dst + 16 * (c8 & 1) + 8 + 4 * (c8 >> 1)) = make_uint2(w[2], w[3]);
        }
        if (tl < 64) wsp<float>(p, W_GEDEC)[(size_t)nu * 64 + tl] = __expf(decs[tl]);
        if (tl == 0) wsp<float>(p, W_GTAIL)[nu] = __expf(dlast);
    }
}

constexpr int G2_ROW = 144, G2_MAT = 64 * G2_ROW, G2_UV = 4 * G2_MAT, G2_ED = G2_UV + 8192, G2_BUF = G2_ED + 512, G2_X = 2 * G2_BUF;
__device__ __forceinline__ void gdn_g2_unit(const KP& p, int l, int bu  , unsigned char* lds) {
    const int tid = p.tid, wid = __builtin_amdgcn_readfirstlane(tid >> 6), lane = tid & 63, fr = lane & 15, g = lane >> 4;
    const int cid = (bu < 32) ? 128 + bu : bu - 32;
    const int nb = wid & 3, mh = wid >> 2;
    const GdnCombo cb = gdn_combo(cid);
    const bf16_t* GQ = wsp<bf16_t>(p, W_GQ);
    f32x4 S[4];
    if (cb.lat) {
        const float* st = p.in[I_STATE] + ((((size_t)cb.b * 2 + l) * 2 + cb.dir) * 4 + cb.h) * 4096;
#pragma unroll
        for (int mt = 0; mt < 4; mt++)
#pragma unroll
            for (int r = 0; r < 4; r++) S[mt][r] = st[(16 * mt + 4 * g + r) * 64 + 16 * nb + fr];
    } else {
#pragma unroll
        for (int mt = 0; mt < 4; mt++) S[mt] = (f32x4){0.f, 0.f, 0.f, 0.f};
    }
    bf16_t* OUT = wsp<bf16_t>(p, cb.dir ? W_OB : W_OF);
    const int lrow = tid >> 3, lpart = tid & 7;
    uint4 rw, rq, ra, rk, ru, re; float rtail;
#define G2_GLOAD(n_) do { const size_t nu_ = (size_t)cb.ubase + (n_); \
        rw = *(const uint4*)(wsp<bf16_t>(p, W_GW) + nu_ * 4096 + lrow * 64 + lpart * 8); \
        ra = *(const uint4*)(wsp<bf16_t>(p, W_GAQK) + nu_ * 4096 + lrow * 64 + lpart * 8); \
        rk = *(const uint4*)(wsp<bf16_t>(p, W_GKTT) + nu_ * 4096 + lrow * 64 + lpart * 8); \
        ru = *(const uint4*)(wsp<bf16_t>(p, W_GUV) + nu_ * 4096 + tid * 8); \
        { const int pos_ = (n_) * 64 + lrow; const size_t tk_ = (size_t)cb.seq0 + (cb.dir ? cb.L - 1 - pos_ : pos_); \
          rq = *(const uint4*)(GQ + tk_ * 256 + cb.h * 64 + lpart * 8); } \
        re = *(const uint4*)(wsp<float>(p, W_GEDEC) + nu_ * 64 + (tid & 15) * 4); \
        rtail = wsp<float>(p, W_GTAIL)[nu_]; } while (0)
#define G2_LSTORE(buf_) do { unsigned char* b_ = lds + (buf_) * G2_BUF; \
        *(uint4*)(b_ + lrow * G2_ROW + lpart * 16) = rw; *(uint4*)(b_ + G2_MAT + lrow * G2_ROW + lpart * 16) = rq; \
        *(uint4*)(b_ + 2 * G2_MAT + lrow * G2_ROW + lpart * 16) = ra; *(uint4*)(b_ + 3 * G2_MAT + lrow * G2_ROW + lpart * 16) = rk; \
        *(uint4*)(b_ + G2_UV + tid * 16) = ru; \
        if (tid < 16) *(uint4*)(b_ + G2_ED + tid * 16) = re; if (tid == 16) *(float*)(b_ + G2_ED + 256) = rtail; } while (0)
    __syncthreads();
    G2_GLOAD(0);
    G2_LSTORE(0);
    __syncthreads();
#pragma unroll 1
    for (int n = 0; n < cb.nch; n++) {
        if (n + 1 < cb.nch) G2_GLOAD(n + 1);
        const unsigned char* bb = lds + (n & 1) * G2_BUF;
        bf16x8 sb[2];
#pragma unroll
        for (int s = 0; s < 2; s++) {
            union { unsigned u[4]; bf16x8 v; } cv;
            cv.u[0] = pg8::cvt_pk_bf16(S[2 * s][0], S[2 * s][1]); cv.u[1] = pg8::cvt_pk_bf16(S[2 * s][2], S[2 * s][3]);
            cv.u[2] = pg8::cvt_pk_bf16(S[2 * s + 1][0], S[2 * s + 1][1]); cv.u[3] = pg8::cvt_pk_bf16(S[2 * s + 1][2], S[2 * s + 1][3]);
            sb[s] = cv.v;
        }
        f32x4 uacc[2], oq[2], oa[2];
#pragma unroll
        for (int i = 0; i < 2; i++) {
            const int mt = 2 * mh + i;
            const uint2 uvw = *(const uint2*)(bb + G2_UV + ((nb * 4 + mt) * 64 + lane) * 8);
            uacc[i][0] = __uint_as_float(uvw.x << 16); uacc[i][1] = __uint_as_float(uvw.x & 0xffff0000u);
            uacc[i][2] = __uint_as_float(uvw.y << 16); uacc[i][3] = __uint_as_float(uvw.y & 0xffff0000u);
            oq[i] = (f32x4){0.f, 0.f, 0.f, 0.f};
            oa[i] = (f32x4){0.f, 0.f, 0.f, 0.f};
#pragma unroll
            for (int s = 0; s < 2; s++) {
                const bf16x8 wf = *(const bf16x8*)(bb + (16 * mt + fr) * G2_ROW + s * 64 + g * 16);
                const unsigned char* qrow = bb + G2_MAT + (16 * mt + fr) * G2_ROW + s * 64 + g * 8;
                const uint2 qlo = *(const uint2*)(qrow), qhi = *(const uint2*)(qrow + 32);
                union { uint4 u; bf16x8 v; } qf; qf.u = make_uint4(qlo.x, qlo.y, qhi.x, qhi.y);
                uacc[i] = __builtin_amdgcn_mfma_f32_16x16x32_bf16(wf, sb[s], uacc[i], 0, 0, 0);
                oq[i] = __builtin_amdgcn_mfma_f32_16x16x32_bf16(qf.v, sb[s], oq[i], 0, 0, 0);
            }
        }
        union { uint4 u; bf16x8 v; } uown, uoth;
        uown.u = make_uint4(pg8::cvt_pk_bf16(uacc[0][0], uacc[0][1]), pg8::cvt_pk_bf16(uacc[0][2], uacc[0][3]), pg8::cvt_pk_bf16(uacc[1][0], uacc[1][1]), pg8::cvt_pk_bf16(uacc[1][2], uacc[1][3]));
        *(uint4*)(lds + G2_X + ((nb * 2 + mh) * 64 + lane) * 16) = uown.u;
        __syncthreads();
        uoth.u = *(const uint4*)(lds + G2_X + ((nb * 2 + (1 - mh)) * 64 + lane) * 16);
        bf16x8 ub[2];
        ub[0] = mh == 0 ? uown.v : uoth.v;
        ub[1] = mh == 0 ? uoth.v : uown.v;
        const float tail = *(const float*)(bb + G2_ED + 256);
#pragma unroll
        for (int i = 0; i < 2; i++) {
            const int mt = 2 * mh + i;
#pragma unroll
            for (int s = 0; s < 2; s++) {
                const bf16x8 af = *(const bf16x8*)(bb + 2 * G2_MAT + (16 * mt + fr) * G2_ROW + s * 64 + g * 16);
                oa[i] = __builtin_amdgcn_mfma_f32_16x16x32_bf16(af, ub[s], oa[i], 0, 0, 0);
            }
        }
#pragma unroll
        for (int mt = 0; mt < 4; mt++) {
            S[mt] *= tail;
#pragma unroll
            for (int s = 0; s < 2; s++) {
                const bf16x8 kt = *(const bf16x8*)(bb + 3 * G2_MAT + (16 * mt + fr) * G2_ROW + s * 64 + g * 16);
                S[mt] = __builtin_amdgcn_mfma_f32_16x16x32_bf16(kt, ub[s], S[mt], 0, 0, 0);
            }
        }
#pragma unroll
        for (int i = 0; i < 2; i++) {
            const int mt = 2 * mh + i;
            const f32x4 ed = *(const f32x4*)(bb + G2_ED + (16 * mt + 4 * g) * 4);
#pragma unroll
            for (int r = 0; r < 4; r++) {
                const int pos = n * 64 + 16 * mt + 4 * g + r;
                const size_t tk = (size_t)cb.seq0 + (cb.dir ? cb.L - 1 - pos : pos);
                OUT[tk * 256 + cb.h * 64 + 16 * nb + fr] = f2bf(ed[r] * oq[i][r] + oa[i][r]);
            }
        }
        if (n + 1 < cb.nch) G2_LSTORE((n + 1) & 1);
        __syncthreads();
    }
    if (!cb.lat && mh == 0) {
        float* so = p.out + O_ST + ((((size_t)cb.b * 2 + l) * 2 + cb.dir) * 4 + cb.h) * 4096;
#pragma unroll
        for (int mt = 0; mt < 4; mt++)
#pragma unroll
            for (int r = 0; r < 4; r++) so[(16 * mt + 4 * g + r) * 64 + 16 * nb + fr] = S[mt][r];
    }
}

__device__ __forceinline__ void hyprep_unit(const KP& p, int l, int tu  ) {
    const int tok0 = tu * 32;
    const bool lat = tok0 >= TC;
    const int L = lat ? 2048 : 256;
    const int t0 = lat ? ((tok0 - TC) & 2047) : (tok0 & 255);
    const bf16_t* PROJ = wsp<bf16_t>(p, W_PROJ);
    const float* cw = p.in[I_HCONV] + (size_t)l * 3 * 768;
#pragma unroll 1
    for (int pass = 0; pass < 2; pass++) {
        const int ch = p.tid + 512 * pass;
        if (ch < 768) {
            const float w0 = cw[ch], w1 = cw[768 + ch], w2 = cw[1536 + ch];
            const bf16_t* src = PROJ + (size_t)tok0 * INC + C_HU + ch;
            bf16_t* dst = wsp<bf16_t>(p, ch < 256 ? W_HV : (ch < 512 ? W_HX1 : W_HX2)) + (size_t)(ch & 255) * T + tok0;
            float xr[34];
            xr[0] = (t0 > 0) ? bf2f(src[-INC]) : 0.f;
#pragma unroll
            for (int t = 0; t < 32; t++) xr[t + 1] = bf2f(src[(size_t)t * INC]);
            xr[33] = (t0 + 32 < L) ? bf2f(src[(size_t)32 * INC]) : 0.f;
#pragma unroll
            for (int k8 = 0; k8 < 4; k8++) {
                float y[8];
#pragma unroll
                for (int e = 0; e < 8; e++) { const int t = k8 * 8 + e; y[e] = xr[t] * w0 + xr[t + 1] * w1 + xr[t + 2] * w2; }
                *(uint4*)(dst + k8 * 8) = pack8(y);
            }
        }
    }
}

template <int L, int NBATCH>
__device__ __forceinline__ void hyena_mfma_unit(const KP& p, int l, int c, unsigned char* lds) {
    constexpr int NB = L / 16, HRLEN = L + 48, XOFF = L / 2 + 31, UBL = L + 512, NTW = (L / 256) * NBATCH / 8;
    constexpr bool LAT = (L == 2048);
    const int tid = p.tid, wid = __builtin_amdgcn_readfirstlane(tid >> 6), lane = tid & 63, fr = lane & 15, g = lane >> 4;
    bf16_t* hr = (bf16_t*)lds;
    bf16_t* ubuf = hr + 4 * HRLEN;
    bf16_t* zbuf = ubuf + NBATCH * UBL;
    const bf16_t* HVt = wsp<bf16_t>(p, W_HV) + (size_t)c * T;
    const bf16_t* HX1t = wsp<bf16_t>(p, W_HX1) + (size_t)c * T;
    const bf16_t* HX2t = wsp<bf16_t>(p, W_HX2) + (size_t)c * T;
    bf16_t* YT = wsp<bf16_t>(p, W_YT) + (size_t)c * T;
    const bf16_t* FT = wsp<bf16_t>(p, W_FILT) + (size_t)l * 1179648 + (LAT ? 131072 : 0);
    const int sbase = LAT ? TC : 0;
    __syncthreads();
    { unsigned zz = 0u; asm volatile("" : "+v"(zz)); const uint4 z4 = make_uint4(zz, zz, zz, zz);
      for (int i = tid; i < 2 * NBATCH * UBL / 8; i += NT) ((uint4*)ubuf)[i] = z4; }
    for (int x = tid; x < HRLEN; x += NT) {
#pragma unroll
        for (int o = 0; o < 2; o++) {
            const bf16_t* f = FT + (size_t)(o * 256 + c) * L;
            const int i0 = L + 31 - x, i1 = L + 30 - x;
            hr[(o * 2 + 0) * HRLEN + x] = (i0 >= 0 && i0 < L) ? f[i0] : (bf16_t)0;
            hr[(o * 2 + 1) * HRLEN + x] = (i1 >= 0 && i1 < L) ? f[i1] : (bf16_t)0;
        }
    }
    __syncthreads();
    for (int i = tid; i < NBATCH * L / 8; i += NT) {
        const int bt = i / (L / 8), s8 = i % (L / 8);
        *(uint4*)(ubuf + bt * UBL + 256 + s8 * 8) = *(const uint4*)(HVt + sbase + bt * L + s8 * 8);
    }
    __syncthreads();
    const int i0blk = LAT ? 16 * wid : 0;
    int dlo = -(NB / 2); if (i0blk - NB > dlo) dlo = i0blk - NB;
    int dhi = NB / 2; if (i0blk + 15 < dhi) dhi = i0blk + 15;
    const int P = 1 - (fr & 1);
    const float bias0 = p.in[I_HBIAS][(l * 2 + 0) * 256 + c], bias1 = p.in[I_HBIAS][(l * 2 + 1) * 256 + c];
#pragma unroll 1
    for (int order = 0; order < 2; order++) {
        const bf16_t* hrp = hr + (order * 2 + P) * HRLEN;
        const bf16_t* ub = order == 0 ? ubuf : zbuf;
        f32x4 acc[NTW];
#pragma unroll
        for (int nt = 0; nt < NTW; nt++) acc[nt] = (f32x4){0.f, 0.f, 0.f, 0.f};
#pragma unroll 1
        for (int d = dlo; d <= dhi; d += 2) {
            const int x0 = XOFF - 16 * d - 16 * (g >> 1) + 8 * (g & 1) - fr;
            const unsigned* ap = (const unsigned*)(hrp + (x0 - P));
            union { unsigned u[4]; bf16x8 v; } af;
            af.u[0] = ap[0]; af.u[1] = ap[1]; af.u[2] = ap[2]; af.u[3] = ap[3];
            const int uoff = 16 * (i0blk + fr - d - (g >> 1)) + 8 * (g & 1) + 256;
#pragma unroll
            for (int nt = 0; nt < NTW; nt++) {
                const int bt = LAT ? nt : 2 * wid + nt;
                const bf16x8 bf = *(const bf16x8*)(ub + bt * UBL + uoff);
                acc[nt] = __builtin_amdgcn_mfma_f32_16x16x32_bf16(af.v, bf, acc[nt], 0, 0, 0);
            }
        }
        const int t4 = 16 * (i0blk + fr) + 4 * g;
#pragma unroll
        for (int nt = 0; nt < NTW; nt++) {
            const int bt = LAT ? nt : 2 * wid + nt;
            const uint2 uw = *(const uint2*)(ub + bt * UBL + 256 + t4);
            const uint2 xw = *(const uint2*)((order == 0 ? HX1t : HX2t) + sbase + bt * L + t4);
            const float bias = order == 0 ? bias0 : bias1;
            float o0 = __uint_as_float(xw.x << 16) * (acc[nt][0] + __uint_as_float(uw.x << 16) * bias);
            float o1 = __uint_as_float(xw.x & 0xffff0000u) * (acc[nt][1] + __uint_as_float(uw.x & 0xffff0000u) * bias);
            float o2 = __uint_as_float(xw.y << 16) * (acc[nt][2] + __uint_as_float(uw.y << 16) * bias);
            float o3 = __uint_as_float(xw.y & 0xffff0000u) * (acc[nt][3] + __uint_as_float(uw.y & 0xffff0000u) * bias);
            uint2 w;
            w.x = (unsigned)f2bf(o0) | ((unsigned)f2bf(o1) << 16);
            w.y = (unsigned)f2bf(o2) | ((unsigned)f2bf(o3) << 16);
            if (order == 0) *(uint2*)(zbuf + bt * UBL + 256 + t4) = w;
            else *(uint2*)(YT + sbase + bt * L + t4) = w;
        }
        __syncthreads();
    }
}

__device__ __forceinline__ void yt_transpose_unit(const KP& p, int tu, unsigned char* lds) {
    const int tok0 = tu * 64, tid = p.tid;
    bf16_t* tl = (bf16_t*)lds;
    const bf16_t* YT = wsp<bf16_t>(p, W_YT);
    __syncthreads();
#pragma unroll
    for (int i = 0; i < 4; i++) {
        const int idx = tid + i * 512, c = idx >> 3, part = idx & 7;
        const uint4 v = *(const uint4*)(YT + (size_t)c * T + tok0 + part * 8);
        const unsigned w[4] = {v.x, v.y, v.z, v.w};
#pragma unroll
        for (int e = 0; e < 8; e++) tl[(part * 8 + e) * 264 + c] = (bf16_t)((e & 1) ? (w[e >> 1] >> 16) : (w[e >> 1] & 0xffffu));
    }
    __syncthreads();
    bf16_t* O = wsp<bf16_t>(p, W_H);
#pragma unroll
    for (int i = 0; i < 4; i++) {
        const int idx = tid + i * 512, tk = idx >> 5, cp = idx & 31;
        *(uint4*)(O + (size_t)(tok0 + tk) * 1024 + 768 + cp * 8) = *(const uint4*)(tl + tk * 264 + cp * 8);
    }
}

constexpr size_t W_CTR = W_BAR + 14336;
__device__ __forceinline__ unsigned queue_issue(const KP& p, int ph, int nvb) {
    unsigned nx = 0u;
    if (p.tid == 0) nx = (unsigned)nvb + __hip_atomic_fetch_add((unsigned*)(p.ws + W_CTR) + ph + 32 * p.pad, 1u, __ATOMIC_RELAXED, __HIP_MEMORY_SCOPE_AGENT);
    return nx;
}
__device__ __forceinline__ int queue_get(const KP& p, unsigned nx, unsigned char* lds) {
    volatile __attribute__((address_space(3))) unsigned* w = (volatile __attribute__((address_space(3))) unsigned*)(lds + 131072 + 8);
    __syncthreads();
    if (p.tid == 0) *w = nx;
    __syncthreads();
    return (int)*w;
}

__device__ __forceinline__ void mix_a_phase(const KP& p, int l, int vb, int nvb, unsigned char* lds) {
    unsigned nxq;
    for (int u = vb; u < 32 + 256 + 256 + 256 + 128 + 128 + 128 + 256; u = queue_get(p, nxq, lds)) {
        nxq = queue_issue(p, 2 + 11 * l + 4, nvb);
        int v = u, type, b = 0, x1 = 0, x2 = 0; bool lat = true;
        if (v < 32) { type = 0; x1 = v; }
        else if ((v -= 32) < 256) { type = 1; lat = true; b = v >> 6; x1 = (v >> 4) & 3; x2 = v & 15; }
        else if ((v -= 256) < 256) { type = 3; x1 = v; }
        else if ((v -= 256) < 256) { type = 2; lat = true; b = v >> 6; x1 = (v >> 4) & 3; x2 = v & 15; }
        else if ((v -= 256) < 128) { type = 0; x1 = 32 + v; }
        else if ((v -= 128) < 128) { type = 1; lat = false; b = v >> 3; x1 = (v >> 1) & 3; x2 = v & 1; }
        else if ((v -= 128) < 128) { type = 2; lat = false; b = v >> 3; x1 = (v >> 1) & 3; x2 = v & 1; }
        else { v -= 128; type = 4; x1 = v; }
        KP q = p;
        asm volatile("" : "+v"(q.tid));
        if (type == 0) gdn_g2_unit(q, l, x1, lds);
        else if (type == 1) attn_unit<0>(q, l, lat, b, x1, x2, lds);
        else if (type == 2) attn_unit<1>(q, l, lat, b, x1, x2, lds);
        else if (type == 3) hyena_mfma_unit<2048, 4>(q, l, x1, lds);
        else hyena_mfma_unit<256, 16>(q, l, x1, lds);
    }
}

__device__ __forceinline__ void mix_b_phase(const KP& p, int l, int vb, int nvb, unsigned char* lds) {
    const int wid = p.tid >> 6, lane = p.tid & 63;
    for (int u = vb; u < 192 + 1536; u += nvb) {
        if (u < 192) { yt_transpose_unit(p, u, lds); continue; }
        const size_t tok = (size_t)(u - 192) * 8 + wid;
        const bf16_t* OF = wsp<bf16_t>(p, W_OF); const bf16_t* OB = wsp<bf16_t>(p, W_OB);
        const bf16_t* GZ = wsp<bf16_t>(p, W_GZ);
        bf16_t* O = wsp<bf16_t>(p, W_H);
#pragma unroll
        for (int h = 0; h < 4; h++) {
            float o = bf2f(OF[tok * 256 + h * 64 + lane]) + bf2f(OB[tok * 256 + h * 64 + lane]);
            float ss = wave_sum(o * o);
            float r = rsqrtf(ss * (1.f / 64.f) + EPSV);
            float gz = bf2f(GZ[tok * 256 + h * 64 + lane]);
            O[tok * 1024 + 512 + h * 64 + lane] = f2bf(o * r * p.in[I_GNORM][l * 64 + lane] * siluf(gz));
        }
    }
}

__device__ __forceinline__ void tr_job(const KP& p, int l, int r, unsigned char* lds) {
    if (r < 768) tr_unit(p.in[I_WIN] + (size_t)l * D * INC, wsp<bf16_t>(p, W_WIN) + (size_t)l * INCP * D, D, INC, INCP, r / 48, r % 48, (float*)lds, p.tid);
    else if (r < 1024) { r -= 768; tr_unit(p.in[I_WOUT] + (size_t)l * D * D, wsp<bf16_t>(p, W_WOUT) + (size_t)l * D * D, D, D, D, r / 16, r % 16, (float*)lds, p.tid); }
    else if (r < 2048) { r -= 1024; tr_unit(p.in[I_W1] + (size_t)l * D * DFF, wsp<bf16_t>(p, W_W1) + (size_t)l * DFF * D, D, DFF, DFF, r / 64, r % 64, (float*)lds, p.tid); }
    else if (r < 3072) { r -= 2048; tr_unit(p.in[I_W2] + (size_t)l * DFF * D, wsp<bf16_t>(p, W_W2) + (size_t)l * D * DFF, DFF, D, D, r / 16, r % 16, (float*)lds, p.tid); }
    else { r -= 3072; tr_unit(p.in[I_WUKV] + (size_t)l * 128 * 512, wsp<bf16_t>(p, W_WUKV) + (size_t)l * 512 * 128, 128, 512, 512, r / 8, r % 8, (float*)lds, p.tid); }
}
struct TrDesc { const float* src; bf16_t* dst; int K, N, Npad, kt, nt; };
__device__ __forceinline__ TrDesc tr_desc(const KP& p, int l, int r) {
    TrDesc d;
    if (r < 768) { d.src = p.in[I_WIN] + (size_t)l * D * INC; d.dst = wsp<bf16_t>(p, W_WIN) + (size_t)l * INCP * D; d.K = D; d.N = INC; d.Npad = INCP; d.kt = r / 48; d.nt = r % 48; }
    else if (r < 1024) { r -= 768; d.src = p.in[I_WOUT] + (size_t)l * D * D; d.dst = wsp<bf16_t>(p, W_WOUT) + (size_t)l * D * D; d.K = D; d.N = D; d.Npad = D; d.kt = r / 16; d.nt = r % 16; }
    else if (r < 2048) { r -= 1024; d.src = p.in[I_W1] + (size_t)l * D * DFF; d.dst = wsp<bf16_t>(p, W_W1) + (size_t)l * DFF * D; d.K = D; d.N = DFF; d.Npad = DFF; d.kt = r / 64; d.nt = r % 64; }
    else { r -= 2048; d.src = p.in[I_W2] + (size_t)l * DFF * D; d.dst = wsp<bf16_t>(p, W_W2) + (size_t)l * D * DFF; d.K = DFF; d.N = D; d.Npad = D; d.kt = r / 16; d.nt = r % 16; }
    return d;
}
__device__ __forceinline__ void tr_filler(const KP& p, int l, int jlo, int jhi, int first, int vb, int nvb, unsigned char* lds) {
    if (vb < first) return;
    const int tid = p.tid, stride = nvb - first;
    float* tl = (float*)lds;
    for (int j = jlo + (vb - first); j < jhi; j += 4 * stride) {
        f32x4 v[4][2];
        TrDesc d[4];
#pragma unroll
        for (int q = 0; q < 4; q++) {
            const int jq = (j + q * stride < jhi) ? j + q * stride : j;
            d[q] = tr_desc(p, l, jq);
#pragma unroll
            for (int i = 0; i < 2; i++) {
                const int c = tid + i * 512, k = c >> 4, n = d[q].nt * 64 + (c & 15) * 4;
                v[q][i] = (n < d[q].N) ? *(const f32x4*)(d[q].src + (size_t)(d[q].kt * 64 + k) * d[q].N + n) : (f32x4){0.f, 0.f, 0.f, 0.f};
            }
        }
        __syncthreads();
#pragma unroll
        for (int q = 0; q < 4; q++)
#pragma unroll
            for (int i = 0; i < 2; i++) {
                const int c = tid + i * 512, k = c >> 4, n4 = (c & 15) * 4;
                float* t = tl + q * 64 * 65 + k * 65 + n4;
                t[0] = v[q][i][0]; t[1] = v[q][i][1]; t[2] = v[q][i][2]; t[3] = v[q][i][3];
            }
        __syncthreads();
#pragma unroll
        for (int q = 0; q < 4; q++) {
            const int n = tid >> 3, k8 = (tid & 7) * 8, gn = d[q].nt * 64 + n;
            float f[8];
#pragma unroll
            for (int e = 0; e < 8; e++) f[e] = tl[q * 64 * 65 + (k8 + e) * 65 + n];
            if (gn < d[q].Npad) *(uint4*)(d[q].dst + (size_t)gn * d[q].K + d[q].kt * 64 + k8) = pack8(f);
        }
    }
    __syncthreads();
}

__device__ __forceinline__ void phase_a(const KP& p, int vb, int nvb, unsigned char* lds) {
    for (int u = vb; u < 768 + 32 + 384 + 576 + 416 + 192; u += nvb) {
        int v = u;
        if (v < 768) { tr_job(p, 0, v, lds); continue; }
        v -= 768;
        if (v < 32) { tr_job(p, v >> 4, 3072 + (v & 15), lds); continue; }
        v -= 32;
        if (v < 384) { ada_unit(p, v, (float*)lds); continue; }
        v -= 384;
        if (v < 576) { filt_unit(p, v, (float*)lds); continue; }
        v -= 576;
        if (v < 416) { cachecvt_unit(p, v); continue; }
        v -= 416;
        rope_unit(p, v);
    }
}

__device__ __forceinline__ void phase_b(const KP& p, int vb, int nvb, unsigned char* lds) {
    for (int u = vb; u < 120 + 64; u += nvb) {
        if (u < 120) {
            int idx = u * 512 + p.tid;
            int l = idx / 30720, rem = idx % 30720, r = rem / 6144, e = rem % 6144;
            float s = p.in[I_BADA][l * 6144 + e];
            const float* mp = wsp<float>(p, W_MODP);
#pragma unroll
            for (int ch = 0; ch < 16; ch++) s += mp[((size_t)(ch * 2 + l) * 5 + r) * 6144 + e];
            wsp<float>(p, W_MOD)[idx] = s;
        } else {
            int v = u - 120, l = v >> 5, tt = v & 31, pm = tt & 7, pn = tt >> 3;
            gemm_tile<EPI_BF16>(wsp<bf16_t>(p, W_CKVC) + (size_t)l * 2048 * 128, 128, wsp<bf16_t>(p, W_WUKV) + (size_t)l * 512 * 128, 128, 128, pm * 256, pn * 128, 512,
                                wsp<bf16_t>(p, W_KVC) + (size_t)l * 2048 * 512, 512, lds, p.tid);
        }
    }
}

constexpr int NPH = 24;
__device__ __forceinline__ void run_phase(const KP& p, int ph, int vb, int nvb, unsigned char* lds) {
    if (ph == 0) { phase_a(p, vb, nvb, lds); return; }
    if (ph == 1) { phase_b(p, vb, nvb, lds); return; }
    const int l = (ph - 2) / 11, s = (ph - 2) % 11;
    const float* MODl = nullptr; (void)MODl;
    switch (s) {
    case 0:
        if (l == 0) resnorm_phase(p, p.in[I_XP], p.in[I_XS], nullptr, nullptr, 0, 0, p.in[I_GPREMIX], 1024, 0, 0, vb, nvb);
        break;
    case 1:
        gemm8_phase(wsp<bf16_t>(p, W_H), wsp<bf16_t>(p, W_WIN) + (size_t)l * INCP * D, T, INCP, D, pg8::EpiBf16<0>{wsp<bf16_t>(p, W_PROJ), INC, INC}, lds, vb, nvb, p.tid);
        if (l == 0) tr_filler(p, 0, 768, 3072, 64, vb, nvb, lds);
        break;
    case 2:
        prep_phase(p, l, vb, nvb);
        for (int u = vb; u < T / 32; u += nvb) hyprep_unit(p, l, u);
        break;
    case 3:
        for (int u = vb; u < 384; u += nvb) { KP q = p; asm volatile("" : "+v"(q.tid)); gdn_g1_unit(q, l, u, lds); }
        for (int u = (vb + 128) % nvb; u < 192; u += nvb) { KP q = p; asm volatile("" : "+v"(q.tid));
            gemm_tile<EPI_BF16>(wsp<bf16_t>(p, W_CKVN), 128, wsp<bf16_t>(p, W_WUKV) + (size_t)l * 512 * 128, 128, 128, (u % 48) * 256, (u / 48) * 128, 512, wsp<bf16_t>(p, W_KVX), 512, lds, q.tid); }
        break;
    case 4: mix_a_phase(p, l, vb, nvb, lds); break;
    case 5: mix_b_phase(p, l, vb, nvb, lds); break;
    case 6:
        gemm8_phase(wsp<bf16_t>(p, W_H), wsp<bf16_t>(p, W_WOUT) + (size_t)l * D * D, T, D, D, pg8::EpiBf16<0>{wsp<bf16_t>(p, W_OP), D, D}, lds, vb, nvb, p.tid);
        if (l == 0) tr_filler(p, 1, 0, 640, 192, vb, nvb, lds);
        break;
    case 7: resnorm_phase(p, nullptr, nullptr, wsp<bf16_t>(p, W_OP), p.in[I_GPOSTMIX] + l * D, 2048, l, p.in[I_GPREMLP] + l * D, 4096, 3072, l, vb, nvb); break;
    case 8: gemm8_phase(wsp<bf16_t>(p, W_H), wsp<bf16_t>(p, W_W1) + (size_t)l * DFF * D, T, DFF, D, pg8::EpiBf16<1>{wsp<bf16_t>(p, W_HID), DFF, DFF}, lds, vb, nvb, p.tid); break;
    case 9:
        gemm8_phase(wsp<bf16_t>(p, W_HID), wsp<bf16_t>(p, W_W2) + (size_t)l * D * DFF, T, D, DFF, pg8::EpiBf16<0>{wsp<bf16_t>(p, W_M), D, D}, lds, vb, nvb, p.tid);
        if (l == 0) tr_filler(p, 1, 640, 3072, 192, vb, nvb, lds);
        break;
    case 10:
        if (l == 0) resnorm_phase(p, nullptr, nullptr, wsp<bf16_t>(p, W_M), p.in[I_GPOSTMLP] + l * D, 5120, l, p.in[I_GPREMIX] + (l + 1) * D, 1024, 0, l + 1, vb, nvb);
        else resnorm_phase(p, nullptr, nullptr, wsp<bf16_t>(p, W_M), p.in[I_GPOSTMLP] + l * D, 5120, l, nullptr, 0, 0, 0, vb, nvb);
        break;
    }
}


#define XB_TMO      128
#define XB_XCNT(j)  (256  + 64 * (j))
#define XB_XSUB(j)  (1280 + 64 * (j))
#define XB_XGEN(j)  (2304 + 64 * (j))
#define XB_TOP      3328
#define XB_TOPGEN   3392
#define XCD_BAR_WORDS 3456
#define XB_SPIN_CAP (1u << 20)
#define LAS3 __attribute__((address_space(3)))
__device__ __forceinline__ unsigned xb_ld(unsigned* p) { return __hip_atomic_load(p, __ATOMIC_RELAXED, __HIP_MEMORY_SCOPE_AGENT); }
__device__ __forceinline__ unsigned xb_add(unsigned* p, unsigned v) { return __hip_atomic_fetch_add(p, v, __ATOMIC_RELAXED, __HIP_MEMORY_SCOPE_AGENT); }
__device__ __forceinline__ unsigned xb_xcc_id() { return (unsigned)__builtin_amdgcn_s_getreg((3 << 11) | 20) & 0xFu; }
#define XB_SPIN(cond, bar) do { unsigned _sp = 0; while (cond) { __builtin_amdgcn_s_sleep(1); \
    if ((++_sp & 255u) == 0u) { if (xb_ld(&(bar)[XB_TMO])) break; if (_sp > XB_SPIN_CAP) { atomicAdd(&(bar)[XB_TMO], 1u); break; } } } } while (0)
struct XcdBarrier { unsigned* bar; unsigned x; volatile LAS3 unsigned* st; };
__device__ __forceinline__ XcdBarrier xcd_barrier_post(unsigned* bar, volatile LAS3 unsigned* st) {
    XcdBarrier b; b.bar = bar; b.x = xb_xcc_id(); b.st = st;
    if (threadIdx.x == 0) (void)xb_add(&bar[XB_XCNT(b.x)], 1u);
    return b;
}
__device__ __forceinline__ void xcd_barrier_complete(unsigned* bar, unsigned x, unsigned& nloc, unsigned& nx) {
    const unsigned G = gridDim.x * gridDim.y * gridDim.z;
    unsigned sum, cnt, mine, sp = 0u;
    for (;;) {
        sum = 0u; cnt = 0u; mine = 0u;
#pragma unroll
        for (unsigned j = 0; j < 16; ++j) { const unsigned c = xb_ld(&bar[XB_XCNT(j)]); sum += c; cnt += (c > 0u) ? 1u : 0u; mine = (j == x) ? c : mine; }
        if (sum == G) break;
        __builtin_amdgcn_s_sleep(1);
        if ((++sp & 255u) == 0u) { if (xb_ld(&bar[XB_TMO])) break; if (sp > XB_SPIN_CAP) { atomicAdd(&bar[XB_TMO], 1u); break; } }
    }
    nloc = mine > 0u ? mine : 1u; nx = cnt > 0u ? cnt : 1u;
}
__device__ __forceinline__ void xcd_barrier(const XcdBarrier& b) {
    asm volatile("s_waitcnt vmcnt(0)" ::: "memory");
    __syncthreads();
    if (threadIdx.x == 0) {
        unsigned* bar = b.bar;
        __builtin_amdgcn_s_waitcnt(0);
        unsigned nloc = b.st[0], nx = b.st[1];
        if (nloc == 0u) { xcd_barrier_complete(bar, b.x, nloc, nx); b.st[0] = nloc; b.st[1] = nx; }
        const unsigned old = xb_add(&bar[XB_XSUB(b.x)], 1u);
        const unsigned gen = old / nloc;
        if (old + 1u == (gen + 1u) * nloc) {
            __builtin_amdgcn_fence(__ATOMIC_RELEASE, "agent");
            asm volatile("s_waitcnt vmcnt(0)" ::: "memory");
            const unsigned og = xb_add(&bar[XB_TOP], 1u);
            const unsigned tg = og / nx;
            if (og + 1u == (tg + 1u) * nx) xb_add(&bar[XB_TOPGEN], 1u);
            else XB_SPIN(xb_ld(&bar[XB_TOPGEN]) == tg, bar);
            __builtin_amdgcn_fence(__ATOMIC_ACQUIRE, "agent");
            xb_add(&bar[XB_XGEN(b.x)], 1u);
            asm volatile("s_waitcnt vmcnt(0)" ::: "memory");
        } else {
            XB_SPIN(xb_ld(&bar[XB_XGEN(b.x)]) == gen, bar);
            __builtin_amdgcn_fence(__ATOMIC_ACQUIRE, "agent");
            asm volatile("s_waitcnt vmcnt(0)" ::: "memory");
        }
    }
    __syncthreads();
}

__global__ void __launch_bounds__(NT) trunk_kernel(KP p) {
    __shared__ __attribute__((aligned(16))) unsigned char lds[131072 + 16];
    cg::grid_group grid = cg::this_grid();
    volatile LAS3 unsigned* st = (volatile LAS3 unsigned*)(lds + 131072);
    if (threadIdx.x == 0) { st[0] = 0u; st[1] = 0u; st[2] = 0u; st[3] = 0u; }
    __syncthreads();
    XcdBarrier xb = xcd_barrier_post((unsigned*)(p.ws + W_BAR), st);
    int rep = 0;
    for (int ph = p.ph_lo; ph < p.ph_hi; ph++) {
        KP q = p;
        q.tid = threadIdx.x;
        q.pad = rep;
        asm volatile("" : "+v"(q.tid));
        asm volatile("" : "+s"(q.ws), "+s"(q.out));
        run_phase(q, ph, blockIdx.x, gridDim.x, lds);
        if (ph + 1 < p.ph_hi) {
            if (ph == p.ph_lo && !rep) grid.sync();
            else xcd_barrier(xb);
        }
#ifdef PROBE_REPEAT
        if (PROBE_REPEAT(ph) && !rep) { rep = 1; ph--; } else rep = 0;
#endif
    }
}

extern "C" void kernel_launch(void* const* d_in, const int* in_sizes, int n_in, void* d_out, int out_size, void* d_ws, size_t ws_size, hipStream_t stream) {
    static int grid_blocks = 0;
    if (!grid_blocks) {
        int dev = 0, cus = 0, per_cu = 0;
        hipGetDevice(&dev);
        hipDeviceGetAttribute(&cus, hipDeviceAttributeMultiprocessorCount, dev);
        hipOccupancyMaxActiveBlocksPerMultiprocessor(&per_cu, trunk_kernel, NT, 0);
        if (per_cu < 1) per_cu = 1;
        if (per_cu > 1) per_cu = 1;
        grid_blocks = cus * per_cu;
    }
    KP p{};
    for (int i = 0; i < N_IN; i++) p.in[i] = (const float*)d_in[i];
    p.out = (float*)d_out;
    p.ws = (unsigned char*)d_ws;
    p.ph_lo = 0; p.ph_hi = NPH;
    (void)hipMemsetAsync((unsigned char*)d_ws + W_BAR, 0, 16384, stream);
    void* args[] = {&p};
    hipError_t e = hipLaunchCooperativeKernel((void*)trunk_kernel, dim3(grid_blocks), dim3(NT), args, 0, stream);
    if (e != hipSuccess) fprintf(stderr, "cooperative launch failed: %s (grid %d)\n", hipGetErrorString(e), grid_blocks);
}
```

```cpp
#include <hip/hip_runtime.h>
#include <hip/hip_cooperative_groups.h>
#include <cstdio>
#include <cstdint>
namespace cg = cooperative_groups;

typedef unsigned short bf16_t;
typedef short bf16x8 __attribute__((ext_vector_type(8)));
typedef float f32x4 __attribute__((ext_vector_type(4)));

#define NT 512
#define EPSV 1e-6f

constexpr int D = 1024, TC = 4096, TL = 8192, T = TC + TL, INC = 2864, INCP = 3072, DFF = 4096;
enum { I_XP = 0, I_XS, I_CCKV, I_CKPE, I_CSK, I_CSV, I_STATE, I_C, I_CCTX, I_WADA, I_BADA, I_GPREMIX, I_GPOSTMIX, I_GPREMLP, I_GPOSTMLP,
       I_WIN, I_WOUT, I_KVNORM, I_WUKV, I_SINK, I_GCONV, I_GALOG, I_GDT, I_GNORM, I_HCONV, I_HW1, I_HB1, I_HW2, I_HB2, I_HW3, I_HFREQ,
       I_HDECAY, I_HBIAS, I_W1, I_W2, N_IN };
constexpr int C_MQ = 0, C_CKV = 384, C_KPE = 512, C_SQ = 544, C_SK = 800, C_SV = 928, C_GQKV = 1056, C_GZ = 1824, C_GA = 2080, C_GB = 2088, C_HU = 2096;
constexpr size_t O_YP = 0, O_YS = (size_t)TC * D, O_CKV = (size_t)T * D, O_KPE = O_CKV + 16 * 2 * 256 * 128, O_SK = O_KPE + 16 * 2 * 256 * 32,
                 O_SV = O_SK + 16 * 2 * 256 * 128, O_ST = O_SV + 16 * 2 * 256 * 128;

constexpr size_t al(size_t x) { return (x + 255) & ~(size_t)255; }
constexpr size_t W_WIN = 0;
constexpr size_t W_WOUT = W_WIN + al((size_t)2 * INCP * D * 2);
constexpr size_t W_W1 = W_WOUT + al((size_t)2 * D * D * 2);
constexpr size_t W_W2 = W_W1 + al((size_t)2 * DFF * D * 2);
constexpr size_t W_WUKV = W_W2 + al((size_t)2 * DFF * D * 2);
constexpr size_t W_CKVC = W_WUKV + al((size_t)2 * 512 * 128 * 2);
constexpr size_t W_KVC = W_CKVC + al((size_t)2 * 2048 * 128 * 2);
constexpr size_t W_KPEC = W_KVC + al((size_t)2 * 2048 * 512 * 2);
constexpr size_t W_KSWC = W_KPEC + al((size_t)2 * 2048 * 32 * 2);
constexpr size_t W_VSWC = W_KSWC + al((size_t)2 * 2048 * 128 * 2);
constexpr size_t W_MODP = W_VSWC + al((size_t)2 * 2048 * 128 * 2);
constexpr size_t W_MOD = W_MODP + al((size_t)16 * 2 * 5 * 6144 * 4);
constexpr size_t W_FILT = W_MOD + al((size_t)2 * 5 * 6144 * 4);
constexpr size_t W_ROPEA = W_FILT + al((size_t)2 * 2304 * 512 * 4);
constexpr size_t W_ROPEB = W_ROPEA + al((size_t)2048 * 16 * 2 * 4);
constexpr size_t W_BAR = W_ROPEB + al((size_t)2048 * 32 * 2 * 4);
constexpr size_t W_H = W_BAR + al(16384);
constexpr size_t W_BIG = W_H + al((size_t)T * D * 2);
constexpr size_t W_PROJ = W_BIG;
constexpr size_t W_CKVN = W_PROJ + al((size_t)T * INC * 2);
constexpr size_t W_KPE = W_CKVN + al((size_t)T * 128 * 2);
constexpr size_t W_QMLA = W_KPE + al((size_t)T * 32 * 2);
constexpr size_t W_QSWA = W_QMLA + al((size_t)T * 384 * 2);
constexpr size_t W_KSWA = W_QSWA + al((size_t)T * 256 * 2);
constexpr size_t W_VSWA = W_KSWA + al((size_t)T * 128 * 2);
constexpr size_t W_GQ = W_VSWA + al((size_t)T * 128 * 2);
constexpr size_t W_GK = W_GQ + al((size_t)T * 256 * 2);
constexpr size_t W_GV = W_GK + al((size_t)T * 256 * 2);
constexpr size_t W_GZ = W_GV + al((size_t)T * 256 * 2);
constexpr size_t W_GG = W_GZ + al((size_t)T * 256 * 2);
constexpr size_t W_GBETA = W_GG + al((size_t)T * 8 * 4);
constexpr size_t W_HV = W_GBETA + al((size_t)T * 8 * 4);
constexpr size_t W_HX1 = W_HV + al((size_t)T * 256 * 2);
constexpr size_t W_HX2 = W_HX1 + al((size_t)T * 256 * 2);
constexpr size_t W_GAQK = W_HX2 + al((size_t)T * 256 * 2);
constexpr size_t W_GKTT = W_GAQK + al((size_t)1536 * 4096 * 2);
constexpr size_t W_GEDEC = W_GKTT + al((size_t)1536 * 4096 * 2);
constexpr size_t W_GTAIL = W_GEDEC + al((size_t)1536 * 64 * 4);
constexpr size_t W_MIX_END = W_GTAIL + al((size_t)1536 * 4);
constexpr size_t W_KVX = W_PROJ;
constexpr size_t W_OF = W_KVX + al((size_t)T * 512 * 2);
constexpr size_t W_OB = W_OF + al((size_t)T * 256 * 2);
constexpr size_t W_YT = W_OB + al((size_t)T * 256 * 2);
constexpr size_t W_GUV = W_YT + al((size_t)T * 256 * 2);
constexpr size_t W_GW = W_GUV + al((size_t)1536 * 4096 * 2);
constexpr size_t W_OVL_END = W_GW + al((size_t)1536 * 4096 * 2);
static_assert(W_OVL_END <= W_CKVN, "overlay overflow");
constexpr size_t W_OP = W_PROJ;
static_assert(W_OP + (size_t)T * D * 4 <= W_CKVN, "OP overflow");
constexpr size_t W_HID = W_BIG;
constexpr size_t W_M = W_HID + al((size_t)T * DFF * 2);
constexpr size_t W_END = (W_M + (size_t)T * D * 4) > W_MIX_END ? (W_M + (size_t)T * D * 4) : W_MIX_END;
static_assert(W_END <= (size_t)256 * 1024 * 1024, "workspace overflow");

struct KP {
    const float* in[N_IN];
    float* out;
    unsigned char* ws;
    int ph_lo, ph_hi;
    int tid, pad;
    int zoff, pad2;
};

__device__ __forceinline__ const float* pin(const KP& p, int i) {
    const char* kp = (const char*)__builtin_amdgcn_kernarg_segment_ptr();
    return *(const float* const*)(kp + i * 8 + p.zoff);
}
__device__ __forceinline__ float bf2f(bf16_t v) { return __uint_as_float(((unsigned)v) << 16); }
__device__ __forceinline__ bf16_t f2bf(float f) {
    unsigned u = __float_as_uint(f);
    u += 0x7fffu + ((u >> 16) & 1u);
    return (bf16_t)(u >> 16);
}
__device__ __forceinline__ float wave_sum(float v) {
#pragma unroll
    for (int o = 32; o > 0; o >>= 1) v += __shfl_xor(v, o);
    return v;
}
__device__ __forceinline__ float siluf(float x) { return x / (1.f + __expf(-x)); }
__device__ __forceinline__ void unpack8(uint4 w, float* o) {
    o[0] = __uint_as_float(w.x << 16); o[1] = __uint_as_float(w.x & 0xffff0000u);
    o[2] = __uint_as_float(w.y << 16); o[3] = __uint_as_float(w.y & 0xffff0000u);
    o[4] = __uint_as_float(w.z << 16); o[5] = __uint_as_float(w.z & 0xffff0000u);
    o[6] = __uint_as_float(w.w << 16); o[7] = __uint_as_float(w.w & 0xffff0000u);
}
__device__ __forceinline__ int cond_row(int tok) { return tok < TC ? 0 : 1 + ((tok - TC) >> 11); }

template <class TT> __device__ __forceinline__ TT* wsp(const KP& p, size_t off) { return (TT*)(p.ws + off); }

__device__ __forceinline__ void tr_unit(const float* __restrict__ src, bf16_t* __restrict__ dst, int K, int N, int Npad, int kt, int nt, float* lds, int tid_) {
    const int tid = tid_;
#pragma unroll
    for (int i = 0; i < 2; i++) {
        const int c = tid + i * 512, k = c >> 4, n4 = (c & 15) * 4, n = nt * 64 + n4;
        f32x4 v = (f32x4){0.f, 0.f, 0.f, 0.f};
        if (n < N) v = *(const f32x4*)(src + (size_t)(kt * 64 + k) * N + n);
        lds[k * 65 + n4] = v[0]; lds[k * 65 + n4 + 1] = v[1]; lds[k * 65 + n4 + 2] = v[2]; lds[k * 65 + n4 + 3] = v[3];
    }
    __syncthreads();
    {
        const int n = tid >> 3, k8 = (tid & 7) * 8, gn = nt * 64 + n;
        float f[8];
#pragma unroll
        for (int e = 0; e < 8; e++) f[e] = lds[(k8 + e) * 65 + n];
        uint4 w;
        w.x = (unsigned)f2bf(f[0]) | ((unsigned)f2bf(f[1]) << 16); w.y = (unsigned)f2bf(f[2]) | ((unsigned)f2bf(f[3]) << 16);
        w.z = (unsigned)f2bf(f[4]) | ((unsigned)f2bf(f[5]) << 16); w.w = (unsigned)f2bf(f[6]) | ((unsigned)f2bf(f[7]) << 16);
        if (gn < Npad) *(uint4*)(dst + (size_t)gn * K + kt * 64 + k8) = w;
    }
    __syncthreads();
}

__device__ __forceinline__ void ada_unit(const KP& p, int u  , float* lds) {
    const int l = u / 96, e0 = (u % 96) * 64, tid = p.tid, col = tid & 63, ds = tid >> 6;
    float* sc = lds;
    float* red = lds + 5120;
    __syncthreads();
    for (int i = tid; i < 5120; i += NT) {
        const int r = i >> 10, d = i & 1023;
        const float x = (r == 0) ? pin(p, I_CCTX)[d] : pin(p, I_C)[(r - 1) * 1024 + d];
        sc[i] = x / (1.f + __expf(-x));
    }
    __syncthreads();
    float a0 = 0, a1 = 0, a2 = 0, a3 = 0, a4 = 0;
    const float* w = pin(p, I_WADA) + ((size_t)l * 1024 + ds * 128) * 6144 + e0 + col;
    const float* s = sc + ds * 128;
#pragma unroll 16
    for (int d = 0; d < 128; d++) {
        const float wv = w[(size_t)d * 6144];
        a0 += s[d] * wv; a1 += s[1024 + d] * wv; a2 += s[2048 + d] * wv; a3 += s[3072 + d] * wv; a4 += s[4096 + d] * wv;
    }
    red[(ds * 5 + 0) * 64 + col] = a0; red[(ds * 5 + 1) * 64 + col] = a1; red[(ds * 5 + 2) * 64 + col] = a2; red[(ds * 5 + 3) * 64 + col] = a3; red[(ds * 5 + 4) * 64 + col] = a4;
    __syncthreads();
    if (tid < 320) {
        const int r = tid >> 6;
        float t = pin(p, I_BADA)[l * 6144 + e0 + col];
#pragma unroll
        for (int k = 0; k < 8; k++) t += red[(k * 5 + r) * 64 + col];
        wsp<float>(p, W_MOD)[(size_t)(l * 5 + r) * 6144 + e0 + col] = t;
    }
    __syncthreads();
}

__device__ __forceinline__ void filt_unit(const KP& p, int u, float* lds) {
    const int l = u / 288, tg = u % 288, wid = p.tid >> 6, lane = p.tid & 63;
    const int tglob = tg * 8 + wid;
    int L, j;
    if (tglob < 256) { L = 256; j = tglob; } else { L = 2048; j = tglob - 256; }
    float* h1 = lds + wid * 128;
    float* h2 = h1 + 64;
    const float tj = (float)j;
    const float t01 = tj / (float)(L - 1);
    const float w = 6.283185307179586f * tj / (float)L;
    const float* w1 = pin(p, I_HW1) + (size_t)l * 17 * 64;
    float s = t01 * w1[lane];
#pragma unroll
    for (int b = 0; b < 8; b++) {
        float band = 1e-4f + (float)b * ((7.0f - 1e-4f) / 7.0f);
        float a = w * band;
        s += __cosf(a) * w1[(1 + b) * 64 + lane];
        s += -__sinf(a) * w1[(9 + b) * 64 + lane];
    }
    s += pin(p, I_HB1)[l * 64 + lane];
    h1[lane] = __sinf(pin(p, I_HFREQ)[(l * 2 + 0) * 64 + lane] * s);
    __syncthreads();
    const float* w2 = pin(p, I_HW2) + (size_t)l * 64 * 64;
    float s2 = 0;
#pragma unroll 8
    for (int i = 0; i < 64; i++) s2 += h1[i] * w2[i * 64 + lane];
    s2 += pin(p, I_HB2)[l * 64 + lane];
    h2[lane] = __sinf(pin(p, I_HFREQ)[(l * 2 + 1) * 64 + lane] * s2);
    __syncthreads();
    const float* w3 = pin(p, I_HW3) + (size_t)l * 64 * 512;
    const float dist = fabsf(tj - (float)(L / 2)) / (float)(L / 2);
    float* stage = lds + 1024 + wid * 512;
#pragma unroll
    for (int m = 0; m < 8; m++) {
        int col = lane + 64 * m;
        float a = 0;
#pragma unroll 8
        for (int i = 0; i < 64; i++) a += h2[i] * w3[i * 512 + col];
        stage[col] = a * __expf(-dist * fabsf(pin(p, I_HDECAY)[l * 512 + col]));
    }
    __syncthreads();
    {
        const int col = p.tid;
        const int j0 = (tg < 32) ? tg * 8 : tg * 8 - 256;
        const int Lt = (tg < 32) ? 256 : 2048;
        bf16_t* ft = wsp<bf16_t>(p, W_FILT) + (size_t)l * 1179648 + (tg < 32 ? 0 : 131072) + (size_t)col * Lt + j0;
        unsigned w[4];
#pragma unroll
        for (int e = 0; e < 8; e += 2) w[e >> 1] = (unsigned)f2bf(lds[1024 + e * 512 + col]) | ((unsigned)f2bf(lds[1024 + (e + 1) * 512 + col]) << 16);
        *(uint4*)ft = make_uint4(w[0], w[1], w[2], w[3]);
    }
    __syncthreads();
}

__device__ __forceinline__ void cachecvt_unit(const KP& p, int u) {
    const float* src; bf16_t* dst; int Wd; int uu = u;
    if (uu < 128) { src = pin(p, I_CCKV); dst = wsp<bf16_t>(p, W_CKVC); Wd = 128; }
    else if (uu < 160) { uu -= 128; src = pin(p, I_CKPE); dst = wsp<bf16_t>(p, W_KPEC); Wd = 32; }
    else if (uu < 288) { uu -= 160; src = pin(p, I_CSK); dst = wsp<bf16_t>(p, W_KSWC); Wd = 128; }
    else { uu -= 288; src = pin(p, I_CSV); dst = wsp<bf16_t>(p, W_VSWC); Wd = 128; }
#pragma unroll
    for (int i = 0; i < 8; i++) {
        int idx = uu * 4096 + i * 512 + p.tid;
        int per_l = 2048 * Wd;
        int l = idx / per_l, r = idx % per_l, bs = r / Wd, d = r % Wd, b = bs >> 9, s = bs & 511;
        dst[idx] = f2bf(src[((size_t)(b * 2 + l) * 512 + s) * Wd + d]);
    }
}

__device__ __forceinline__ void rope_unit(const KP& p, int u) {
    int idx = u * 512 + p.tid;
    float* ra = wsp<float>(p, W_ROPEA);
    float* rb = wsp<float>(p, W_ROPEB);
    if (idx < 2048 * 16) {
        int t = idx >> 4, pp = idx & 15, row = t >> 6, col = t & 63;
        float inv = __builtin_amdgcn_exp2f(-(float)(pp & 7) * (13.287712379549449f / 8.f));
        float ang = (float)(pp < 8 ? row : col) * inv;
        ra[idx * 2] = __cosf(ang); ra[idx * 2 + 1] = __sinf(ang);
    } else {
        int i2 = idx - 2048 * 16;
        int t = i2 >> 5, pp = i2 & 31, row = t >> 6, col = t & 63;
        float inv = __builtin_amdgcn_exp2f(-(float)(pp & 15) * (13.287712379549449f / 16.f));
        float ang = (float)(pp < 16 ? row : col) * inv;
        rb[i2 * 2] = __cosf(ang); rb[i2 * 2 + 1] = __sinf(ang);
    }
}

enum { EPI_BF16 = 0, EPI_F32 = 1, EPI_RELU2 = 2 };
template <int EPI>
__device__ __forceinline__ void gemm_tile(const bf16_t* __restrict__ A, int lda, const bf16_t* __restrict__ Bt, int ldb, int K, int m0, int n0, int N,
                          void* Cout, int ldc, unsigned char* lds, int tid_) {
    const int tid = tid_, wid = tid >> 6, lane = tid & 63, wr = wid >> 1, wc = wid & 1, fr = lane & 15, fq = lane >> 4;
    unsigned char* As = lds;
    unsigned char* Bs = lds + 256 * 144;
    f32x4 acc[4][4];
#pragma unroll
    for (int m = 0; m < 4; m++)
#pragma unroll
        for (int n = 0; n < 4; n++) acc[m][n] = (f32x4){0.f, 0.f, 0.f, 0.f};
    const int nk = K / 64;
    const int lr = tid >> 3, lkc = tid & 7;
    const bf16_t* ga = A + (size_t)(m0 + lr) * lda + lkc * 8;
    const bf16_t* gb = Bt + (size_t)(n0 + lr) * ldb + lkc * 8;
    uint4 ra0, ra1, ra2, ra3, rb0, rb1;
#define GLOAD(kt_) do { \
    ra0 = *(const uint4*)(ga + (kt_) * 64); ra1 = *(const uint4*)(ga + (size_t)64 * lda + (kt_) * 64); \
    ra2 = *(const uint4*)(ga + (size_t)128 * lda + (kt_) * 64); ra3 = *(const uint4*)(ga + (size_t)192 * lda + (kt_) * 64); \
    rb0 = *(const uint4*)(gb + (kt_) * 64); rb1 = *(const uint4*)(gb + (size_t)64 * ldb + (kt_) * 64); } while (0)
    GLOAD(0);
    for (int kt = 0; kt < nk; kt++) {
        __syncthreads();
        *(uint4*)(As + lr * 144 + lkc * 16) = ra0; *(uint4*)(As + (lr + 64) * 144 + lkc * 16) = ra1;
        *(uint4*)(As + (lr + 128) * 144 + lkc * 16) = ra2; *(uint4*)(As + (lr + 192) * 144 + lkc * 16) = ra3;
        *(uint4*)(Bs + lr * 144 + lkc * 16) = rb0; *(uint4*)(Bs + (lr + 64) * 144 + lkc * 16) = rb1;
        __syncthreads();
        if (kt + 1 < nk) GLOAD(kt + 1);
#pragma unroll
        for (int ks = 0; ks < 2; ks++) {
            bf16x8 a[4], b[4];
#pragma unroll
            for (int m = 0; m < 4; m++) a[m] = *(const bf16x8*)(As + (wr * 64 + m * 16 + fr) * 144 + ks * 64 + fq * 16);
#pragma unroll
            for (int n = 0; n < 4; n++) b[n] = *(const bf16x8*)(Bs + (wc * 64 + n * 16 + fr) * 144 + ks * 64 + fq * 16);
#pragma unroll
            for (int m = 0; m < 4; m++)
#pragma unroll
                for (int n = 0; n < 4; n++) acc[m][n] = __builtin_amdgcn_mfma_f32_16x16x32_bf16(b[n], a[m], acc[m][n], 0, 0, 0);
        }
    }
#pragma unroll
    for (int m = 0; m < 4; m++) {
        const int row = m0 + wr * 64 + m * 16 + fr;
#pragma unroll
        for (int n = 0; n < 4; n++) {
            const int col = n0 + wc * 64 + n * 16 + fq * 4;
            if (col < N) {
                f32x4 v = acc[m][n];
                if (EPI == EPI_F32) {
                    *(f32x4*)((float*)Cout + (size_t)row * ldc + col) = v;
                } else {
                    if (EPI == EPI_RELU2) {
#pragma unroll
                        for (int j = 0; j < 4; j++) { float r = fmaxf(v[j], 0.f); v[j] = r * r; }
                    }
                    uint2 w;
                    w.x = (unsigned)f2bf(v[0]) | ((unsigned)f2bf(v[1]) << 16);
                    w.y = (unsigned)f2bf(v[2]) | ((unsigned)f2bf(v[3]) << 16);
                    *(uint2*)((bf16_t*)Cout + (size_t)row * ldc + col) = w;
                }
            }
        }
    }
    __syncthreads();
}

template <int EPI>
__device__ __forceinline__ void gemm_phase(const bf16_t* A, int lda, const bf16_t* Bt, int ldb, int K, int M, int N, void* C, int ldc, unsigned char* lds, int vb, int nvb, int tid_) {
    const int tm = M / 256, tn = (N + 127) / 128;
    for (int u = vb; u < tm * tn; u += nvb) {
        int pm = u % tm, pn = u / tm;
        gemm_tile<EPI>(A, lda, Bt, ldb, K, pm * 256, pn * 128, N, C, ldc, lds, tid_);
    }
}


namespace pg8 {
#define PG8_LAS __attribute__((address_space(3)))
typedef unsigned u32x4 __attribute__((ext_vector_type(4)));
constexpr int BM = 256, BK = 64, HALF = 128, HTB = HALF * BK * 2, STAGE_BYTES = 8 * HTB, NXCD = 8, WGM = 8;
__device__ __forceinline__ int lds_byte(int r, int c) { const int st = (r >> 4) * 2 + (c >> 5), rr = r & 15, cc = c & 31, ob = rr * 64 + cc * 2; return st * 1024 + (ob ^ (((ob >> 9) & 1) << 5)); }
__device__ __forceinline__ void stage_rc(int b, int& R, int& C) { const int st = b / 1024, sb = b % 1024, swz = sb ^ (((sb >> 9) & 1) << 5); R = (st >> 1) * 16 + swz / 64; C = (st & 1) * 32 + (swz % 64) / 2; }
__device__ __forceinline__ int perm32(int rho) { const int n = rho >> 4, i = rho & 15; return 8 * (i >> 2) + 4 * n + (i & 3); }
struct Unit { int pm, pn; };
struct Gemm { const bf16_t* A; const bf16_t* Bt; int M, N, K; };
struct StaticOrder {
    int nM, nN, nwg, G, c;
    __device__ void init(int M, int N, int G_, int c_) { nM = M / BM; nN = N / BM; nwg = nM * nN; G = G_; c = c_; }
    __device__ bool next(int i, Unit& u) const {
        const long L = (long)i * G + c; if (L >= nwg) return false;
        int wgid = (int)L; { const int q = nwg / NXCD, r = nwg % NXCD, xcd = wgid % NXCD, off = wgid / NXCD; wgid = (xcd < r ? xcd * (q + 1) : r * (q + 1) + (xcd - r) * q) + off; }
        const int nig = WGM * nN, gid = wgid / nig, fm = gid * WGM, gsz = (nM - fm) < WGM ? (nM - fm) : WGM;
        u.pm = fm + ((wgid % nig) % gsz); u.pn = (wgid % nig) / gsz; return true;
    }
};
__device__ __forceinline__ unsigned cvt_pk_bf16(float lo, float hi) { unsigned r; asm volatile("v_cvt_pk_bf16_f32 %0, %1, %2" : "=v"(r) : "v"(lo), "v"(hi)); return r; }
struct EpiF32 {
    static constexpr bool PERM = false;
    float* C; int ldc;
    __device__ __forceinline__ void operator()(const f32x4 (&acc)[2][2][4][2], const Unit& u, int wr, int wc, int fr, int fq) const {
        const int row0 = u.pm * BM + wr * 64 + fr, col0 = u.pn * BM + wc * 32 + 4 * fq;
#pragma unroll
        for (int ai = 0; ai < 2; ++ai)
#pragma unroll
            for (int m = 0; m < 4; ++m) { float* rowp = C + (size_t)(row0 + ai * HALF + m * 16) * ldc + col0;
#pragma unroll
                for (int bj = 0; bj < 2; ++bj)
#pragma unroll
                    for (int n = 0; n < 2; ++n) *(f32x4*)(rowp + bj * HALF + n * 16) = acc[ai][bj][m][n]; }
    }
};
template <int ACT  > struct EpiBf16 {
    static constexpr bool PERM = true;
    bf16_t* O; int ldc; int ncols;
    __device__ __forceinline__ void operator()(const f32x4 (&acc)[2][2][4][2], const Unit& u, int wr, int wc, int fr, int fq) const {
        const int row0 = u.pm * BM + wr * 64 + fr, col0 = u.pn * BM + wc * 32 + 8 * fq;
#pragma unroll
        for (int ai = 0; ai < 2; ++ai)
#pragma unroll
            for (int m = 0; m < 4; ++m) { bf16_t* rowp = O + (size_t)(row0 + ai * HALF + m * 16) * ldc + col0;
#pragma unroll
                for (int bj = 0; bj < 2; ++bj) { f32x4 v0 = acc[ai][bj][m][0], v1 = acc[ai][bj][m][1];
                    if (ACT == 1) {
#pragma unroll
                        for (int j = 0; j < 4; ++j) { const float a = fmaxf(v0[j], 0.f), b = fmaxf(v1[j], 0.f); v0[j] = a * a; v1[j] = b * b; } }
                    u32x4 w; w.x = cvt_pk_bf16(v0[0], v0[1]); w.y = cvt_pk_bf16(v0[2], v0[3]); w.z = cvt_pk_bf16(v1[0], v1[1]); w.w = cvt_pk_bf16(v1[2], v1[3]);
                    if (col0 + bj * HALF < ncols) *(u32x4*)(rowp + bj * HALF) = w; } }
    }
};

template <class Epi>
__device__ __forceinline__ void gemm_phase(PG8_LAS unsigned char* lds, const Gemm g, const StaticOrder& S, const Epi& E, const int tid) {
    const int wid = __builtin_amdgcn_readfirstlane(tid >> 6), lane = tid & 63, wr = wid >> 2, wc = wid & 3, fr = lane & 15, fq = lane >> 4;
    const int K = g.K, nt = K / BK;
    unsigned voffA[2], voffB[2];
#pragma unroll
    for (int i = 0; i < 2; ++i) { int R, C; stage_rc(tid * 16 + i * 8192, R, C); const int Rb = Epi::PERM ? ((R & ~31) + perm32(R & 31)) : R;
        voffA[i] = (unsigned)(R * K + C) * 2u; voffB[i] = (unsigned)(Rb * K + C) * 2u; }
    const size_t kstep = (size_t)(BK * 2);
    const size_t hstep = (size_t)HALF * K * 2;
    const size_t tstep = 2 * hstep;
    const unsigned ldsw = (unsigned)wid * 1024u;
    const int aoff = lds_byte(wr * 64 + fr, fq * 8), boff = lds_byte(wc * 32 + fr, fq * 8);
#define PG8_SA(b, h) (((b) * 2 + (h)) * HTB)
#define PG8_SB(b, h) ((4 + (b) * 2 + (h)) * HTB)
#define PG8_STAGE(bufoff, gbase, voff) do { _Pragma("unroll") for (int _i = 0; _i < 2; ++_i) \
        __builtin_amdgcn_global_load_lds((const unsigned*)((const char*)(gbase) + (voff)[_i]), (PG8_LAS unsigned*)(lds + (bufoff) + ldsw + _i * 8192), 16, 0, 0); } while (0)
#define PG8_LDA(dst, b, h) do { _Pragma("unroll") for (int m = 0; m < 4; ++m) _Pragma("unroll") for (int k = 0; k < 2; ++k) dst[m][k] = *(const PG8_LAS bf16x8*)(lds + PG8_SA(b, h) + aoff + m * 2048 + k * 1024); } while (0)
#define PG8_LDB(dst, b, h) do { _Pragma("unroll") for (int n = 0; n < 2; ++n) _Pragma("unroll") for (int k = 0; k < 2; ++k) dst[n][k] = *(const PG8_LAS bf16x8*)(lds + PG8_SB(b, h) + boff + n * 2048 + k * 1024); } while (0)
#define PG8_MMA(ai, bj, At, Bt) do { __builtin_amdgcn_s_setprio(1); _Pragma("unroll") for (int m = 0; m < 4; ++m) _Pragma("unroll") for (int n = 0; n < 2; ++n) _Pragma("unroll") for (int k = 0; k < 2; ++k) \
        acc[ai][bj][m][n] = __builtin_amdgcn_mfma_f32_16x16x32_bf16(Bt[n][k], At[m][k], acc[ai][bj][m][n], 0, 0, 0); __builtin_amdgcn_s_setprio(0); } while (0)
#define PG8_WAIT_V(n) asm volatile("s_waitcnt vmcnt(" #n ")" ::: "memory")
#define PG8_WAIT_L(n) asm volatile("s_waitcnt lgkmcnt(" #n ")" ::: "memory")
#define PG8_BAR __builtin_amdgcn_s_barrier()
#define PG8_SCHED __builtin_amdgcn_sched_barrier(0)
    Unit cur, nxt; int ui = 0;
    if (!S.next(0, cur)) return;
    f32x4 acc[2][2][4][2];
#pragma unroll
    for (int a = 0; a < 2; ++a)
#pragma unroll
        for (int b = 0; b < 2; ++b)
#pragma unroll
            for (int m = 0; m < 4; ++m)
#pragma unroll
                for (int n = 0; n < 2; ++n) acc[a][b][m][n] = (f32x4){0.f, 0.f, 0.f, 0.f};
    bf16x8 At[4][2], B0[2][2], B1[2][2];
    const char* cA = (const char*)g.A + (size_t)cur.pm * tstep; const char* cB = (const char*)g.Bt + (size_t)cur.pn * tstep;
    PG8_STAGE(PG8_SB(0, 0), cB, voffB); PG8_STAGE(PG8_SA(0, 0), cA, voffA); PG8_STAGE(PG8_SB(0, 1), cB + hstep, voffB); PG8_STAGE(PG8_SA(0, 1), cA + hstep, voffA);
    if (wr == 1) PG8_BAR;
    PG8_WAIT_V(4); PG8_BAR;
    PG8_STAGE(PG8_SB(1, 0), cB + kstep, voffB); PG8_STAGE(PG8_SA(1, 0), cA + kstep, voffA); PG8_STAGE(PG8_SB(1, 1), cB + hstep + kstep, voffB);
    PG8_WAIT_V(6); PG8_BAR;
    for (;;) {
        const bool has_next = S.next(ui + 1, nxt);
        const char* nA = has_next ? (const char*)g.A + (size_t)nxt.pm * tstep : cA; const char* nB = has_next ? (const char*)g.Bt + (size_t)nxt.pn * tstep : cB;
        for (int t = 0; t < nt; t += 2) {
            const bool last = (t == nt - 2);
            const char* a1 = cA + (size_t)(t + 1) * kstep;
            const char* a2 = last ? nA : cA + (size_t)(t + 2) * kstep; const char* b2 = last ? nB : cB + (size_t)(t + 2) * kstep;
            const char* a3 = a2 + kstep; const char* b3 = b2 + kstep;
            PG8_LDB(B0, 0, 0); PG8_SCHED; PG8_LDA(At, 0, 0); PG8_STAGE(PG8_SA(1, 1), a1 + hstep, voffA);
            PG8_WAIT_L(8); PG8_BAR; PG8_WAIT_L(0); PG8_MMA(0, 0, At, B0); PG8_BAR; PG8_SCHED;
            PG8_LDB(B1, 0, 1); PG8_STAGE(PG8_SB(0, 0), b2, voffB);
            PG8_BAR; PG8_WAIT_L(0); PG8_MMA(0, 1, At, B1); PG8_BAR;
            PG8_LDA(At, 0, 1); PG8_STAGE(PG8_SA(0, 0), a2, voffA);
            PG8_BAR; PG8_WAIT_L(0); PG8_MMA(1, 0, At, B0); PG8_BAR; PG8_SCHED;
            PG8_STAGE(PG8_SB(0, 1), b2 + hstep, voffB);
            PG8_WAIT_V(6); PG8_BAR; PG8_MMA(1, 1, At, B1); PG8_BAR;
            PG8_LDB(B0, 1, 0); PG8_SCHED; PG8_LDA(At, 1, 0); PG8_STAGE(PG8_SA(0, 1), a2 + hstep, voffA);
            PG8_WAIT_L(8); PG8_BAR; PG8_WAIT_L(0); PG8_MMA(0, 0, At, B0); PG8_BAR; PG8_SCHED;
            PG8_LDB(B1, 1, 1); PG8_STAGE(PG8_SB(1, 0), b3, voffB);
            PG8_BAR; PG8_WAIT_L(0); PG8_MMA(0, 1, At, B1); PG8_BAR;
            PG8_LDA(At, 1, 1); PG8_STAGE(PG8_SA(1, 0), a3, voffA);
            PG8_BAR; PG8_WAIT_L(0); PG8_MMA(1, 0, At, B0); PG8_BAR; PG8_SCHED;
            PG8_STAGE(PG8_SB(1, 1), b3 + hstep, voffB);
            PG8_WAIT_V(6); PG8_BAR; PG8_MMA(1, 1, At, B1); PG8_BAR;
        }
        E(acc, cur, wr, wc, fr, fq);
        if (!has_next) break;
#pragma unroll
        for (int a = 0; a < 2; ++a)
#pragma unroll
            for (int b = 0; b < 2; ++b)
#pragma unroll
                for (int m = 0; m < 4; ++m)
#pragma unroll
                    for (int n = 0; n < 2; ++n) acc[a][b][m][n] = (f32x4){0.f, 0.f, 0.f, 0.f};
        cur = nxt; cA = nA; cB = nB; ++ui;
    }
    PG8_WAIT_V(0);
    if (wr == 0) PG8_BAR;
    PG8_BAR;
#undef PG8_SA
#undef PG8_SB
#undef PG8_STAGE
#undef PG8_LDA
#undef PG8_LDB
#undef PG8_MMA
#undef PG8_WAIT_V
#undef PG8_WAIT_L
#undef PG8_BAR
#undef PG8_SCHED
}
}

template <class Epi>
__device__ __forceinline__ void gemm8_phase(const bf16_t* A, const bf16_t* Bt, int M, int N, int K, const Epi& E, unsigned char* lds, int vb, int nvb, int tid) {
    pg8::Gemm g{A, Bt, M, N, K};
    pg8::StaticOrder S; S.init(M, N, nvb, vb);
    __syncthreads();
    pg8::gemm_phase<Epi>((PG8_LAS unsigned char*)lds, g, S, E, tid);
    __syncthreads();
}

__device__ __forceinline__ void resnorm_phase(const KP& p, const float* xprompt, const float* xsample, const bf16_t* y, const float* g_post, int gate_off, int ly,
                              const float* g_pre, int sc_off, int sh_off, int lh, int vb, int nvb) {
    const int wid = p.tid >> 6, lane = p.tid & 63;
    float* X = p.out;
    bf16_t* H = wsp<bf16_t>(p, W_H);
    const float* MOD = wsp<float>(p, W_MOD);
    for (int u = vb; u < T / 32; u += nvb) {
        const int tok0 = u * 32 + wid * 4;
        const int cr = cond_row(tok0);
        f32x4 xv[4][4];
        uint4 yw[4][2];
#pragma unroll
        for (int r = 0; r < 4; r++) {
            const int tok = tok0 + r;
            const float* xs = xprompt ? (tok < TC ? xprompt + (size_t)tok * D : xsample + (size_t)(tok - TC) * D) : X + (size_t)tok * D;
#pragma unroll
            for (int i = 0; i < 2; i++) {
                xv[r][2 * i] = *(const f32x4*)(xs + i * 512 + lane * 8);
                xv[r][2 * i + 1] = *(const f32x4*)(xs + i * 512 + lane * 8 + 4);
                if (y) yw[r][i] = *(const uint4*)(y + (size_t)tok * D + i * 512 + lane * 8);
            }
        }
        if (y) {
            const float* gate = MOD + (size_t)(ly * 5 + cr) * 6144 + gate_off;
            f32x4 gg[4];
#pragma unroll
            for (int i = 0; i < 2; i++)
#pragma unroll
                for (int hh = 0; hh < 2; hh++) {
                    const f32x4 gp = *(const f32x4*)(g_post + i * 512 + lane * 8 + hh * 4);
                    const f32x4 gt = *(const f32x4*)(gate + i * 512 + lane * 8 + hh * 4);
                    gg[2 * i + hh] = gp * gt;
                }
#pragma unroll
            for (int r = 0; r < 4; r++) {
                float yf[16];
                unpack8(yw[r][0], yf); unpack8(yw[r][1], yf + 8);
                float ss = 0.f;
#pragma unroll
                for (int e = 0; e < 16; e++) ss += yf[e] * yf[e];
                ss = wave_sum(ss);
                const float rs = rsqrtf(ss * (1.f / 1024.f) + EPSV);
#pragma unroll
                for (int q4 = 0; q4 < 4; q4++)
#pragma unroll
                    for (int j = 0; j < 4; j++) xv[r][q4][j] += gg[q4][j] * (yf[q4 * 4 + j] * rs);
            }
        }
        if (y || xprompt) {
#pragma unroll
            for (int r = 0; r < 4; r++)
#pragma unroll
                for (int i = 0; i < 2; i++) {
                    *(f32x4*)(X + (size_t)(tok0 + r) * D + i * 512 + lane * 8) = xv[r][2 * i];
                    *(f32x4*)(X + (size_t)(tok0 + r) * D + i * 512 + lane * 8 + 4) = xv[r][2 * i + 1];
                }
        }
        if (g_pre) {
            const float* sc = MOD + (size_t)(lh * 5 + cr) * 6144 + sc_off;
            const float* sh = MOD + (size_t)(lh * 5 + cr) * 6144 + sh_off;
            f32x4 mm[4], aa[4];
#pragma unroll
            for (int q4 = 0; q4 < 4; q4++) {
                const int co = (q4 >> 1) * 512 + lane * 8 + (q4 & 1) * 4;
                const f32x4 gp = *(const f32x4*)(g_pre + co);
                const f32x4 s1 = *(const f32x4*)(sc + co);
                aa[q4] = *(const f32x4*)(sh + co);
                mm[q4] = gp * (s1 + 1.f);
            }
#pragma unroll
            for (int r = 0; r < 4; r++) {
                float ss = 0.f;
#pragma unroll
                for (int q4 = 0; q4 < 4; q4++) ss += xv[r][q4][0] * xv[r][q4][0] + xv[r][q4][1] * xv[r][q4][1] + xv[r][q4][2] * xv[r][q4][2] + xv[r][q4][3] * xv[r][q4][3];
                ss = wave_sum(ss);
                const float rs = rsqrtf(ss * (1.f / 1024.f) + EPSV);
#pragma unroll
                for (int i = 0; i < 2; i++) {
                    float hv[8];
#pragma unroll
                    for (int j = 0; j < 4; j++) { hv[j] = xv[r][2 * i][j] * rs * mm[2 * i][j] + aa[2 * i][j]; hv[4 + j] = xv[r][2 * i + 1][j] * rs * mm[2 * i + 1][j] + aa[2 * i + 1][j]; }
                    uint4 w;
                    w.x = pg8::cvt_pk_bf16(hv[0], hv[1]); w.y = pg8::cvt_pk_bf16(hv[2], hv[3]); w.z = pg8::cvt_pk_bf16(hv[4], hv[5]); w.w = pg8::cvt_pk_bf16(hv[6], hv[7]);
                    *(uint4*)(H + (size_t)(tok0 + r) * D + i * 512 + lane * 8) = w;
                }
            }
        }
    }
}

__device__ __forceinline__ void tok_decode(int tok, bool& lat, int& b, int& t, int& L) {
    lat = tok >= TC;
    if (!lat) { b = tok >> 8; t = tok & 255; L = 256; } else { const int q = tok - TC; b = q >> 11; t = q & 2047; L = 2048; }
}
__device__ __forceinline__ uint4 pack8(const float* f) {
    uint4 w;
    w.x = pg8::cvt_pk_bf16(f[0], f[1]); w.y = pg8::cvt_pk_bf16(f[2], f[3]); w.z = pg8::cvt_pk_bf16(f[4], f[5]); w.w = pg8::cvt_pk_bf16(f[6], f[7]);
    return w;
}
template <int U, class LD, class CP>
__device__ __forceinline__ void run_task(int nbi, int vb, int nvb, int tid, LD load, CP comp) {
    for (int u0 = vb; u0 < nbi; u0 += nvb * U) {
        if constexpr (U == 1) { auto d0 = load(u0 * NT + tid); comp(u0 * NT + tid, d0); }
        if constexpr (U == 2) {
            const int i0 = u0 * NT + tid, i1 = ((u0 + nvb < nbi) ? u0 + nvb : u0) * NT + tid;
            auto d0 = load(i0); auto d1 = load(i1);
            comp(i0, d0); comp(i1, d1);
        }
        if constexpr (U == 4) {
            const int i0 = u0 * NT + tid, i1 = ((u0 + nvb < nbi) ? u0 + nvb : u0) * NT + tid, i2 = ((u0 + 2 * nvb < nbi) ? u0 + 2 * nvb : u0) * NT + tid,
                      i3 = ((u0 + 3 * nvb < nbi) ? u0 + 3 * nvb : u0) * NT + tid;
            auto d0 = load(i0); auto d1 = load(i1); auto d2 = load(i2); auto d3 = load(i3);
            comp(i0, d0); comp(i1, d1); comp(i2, d2); comp(i3, d3);
        }
    }
}
struct Ld1 { uint4 a; };
struct Ld2 { uint4 a, b; };
struct Ld3 { uint4 a, b, c; };
__device__ __forceinline__ void prep_phase(const KP& p, int l, int vb, int nvb) {
    const int tid = p.tid;
    const bf16_t* PROJ = wsp<bf16_t>(p, W_PROJ);
    const float* RA = wsp<float>(p, W_ROPEA); const float* RB = wsp<float>(p, W_ROPEB);
    {
        const float* cw = pin(p, I_GCONV) + (size_t)l * 3 * 768;
        bf16_t* GQ = wsp<bf16_t>(p, W_GQ);
        static_assert(W_GK == W_GQ + (size_t)T * 256 * 2 && W_GV == W_GK + (size_t)T * 256 * 2, "GQ/GK/GV must be contiguous");
        run_task<2>(T * 96 / NT, vb, nvb, tid,
            [&](int idx) __attribute__((always_inline)) { const int tok = idx / 96, grp = idx - tok * 96; bool lat; int b, t, L; tok_decode(tok, lat, b, t, L);
                const bf16_t* s = PROJ + (size_t)tok * INC + C_GQKV + grp * 8; Ld3 d;
                d.b = *(const uint4*)s;
                d.a = (t > 0) ? *(const uint4*)(s - INC) : make_uint4(0u, 0u, 0u, 0u);
                d.c = (t < L - 1) ? *(const uint4*)(s + INC) : make_uint4(0u, 0u, 0u, 0u);
                return d; },
            [&](int idx, const Ld3& d) __attribute__((always_inline)) { const int tok = idx / 96, grp = idx - tok * 96;
                float xp[8], xc[8], xn[8], y[8]; unpack8(d.a, xp); unpack8(d.b, xc); unpack8(d.c, xn);
                float ss = 0.f;
#pragma unroll
                for (int e = 0; e < 8; e++) {
                    const int ch = grp * 8 + e;
                    float v = xp[e] * cw[ch] + xc[e] * cw[768 + ch] + xn[e] * cw[1536 + ch];
                    v = v / (1.f + __expf(-v));
                    y[e] = v; ss += v * v;
                }
                ss += __shfl_xor(ss, 1); ss += __shfl_xor(ss, 2); ss += __shfl_xor(ss, 4);
                if (grp < 64) { const float sc = rsqrtf(ss + EPSV) * (grp < 32 ? 0.125f : 1.f);
#pragma unroll
                    for (int e = 0; e < 8; e++) y[e] *= sc; }
                bf16_t* dst = GQ + (size_t)(grp >> 5) * ((size_t)T * 256) + (size_t)tok * 256 + (grp & 31) * 8;
                *(uint4*)dst = pack8(y); });
    }
    {
        bf16_t* CKVN = wsp<bf16_t>(p, W_CKVN);
        run_task<4>(T * 16 / NT, vb, nvb, tid,
            [&](int idx) __attribute__((always_inline)) { const int tok = idx >> 4, grp = idx & 15; Ld1 d; d.a = *(const uint4*)(PROJ + (size_t)tok * INC + C_CKV + grp * 8); return d; },
            [&](int idx, const Ld1& d) __attribute__((always_inline)) { const int tok = idx >> 4, grp = idx & 15; bool lat; int b, t, L; tok_decode(tok, lat, b, t, L);
                float x[8]; unpack8(d.a, x);
                float ss = 0.f;
#pragma unroll
                for (int e = 0; e < 8; e++) ss += x[e] * x[e];
                ss += __shfl_xor(ss, 1); ss += __shfl_xor(ss, 2); ss += __shfl_xor(ss, 4); ss += __shfl_xor(ss, 8);
                const float rs = rsqrtf(ss * (1.f / 128.f) + EPSV);
                const float* gw = pin(p, I_KVNORM) + l * 128 + grp * 8;
#pragma unroll
                for (int e = 0; e < 8; e++) x[e] = x[e] * rs * gw[e];
                *(uint4*)(CKVN + (size_t)tok * 128 + grp * 8) = pack8(x);
                if (!lat) { float* o = p.out + O_CKV + ((size_t)(b * 2 + l) * 256 + t) * 128 + grp * 8;
                    *(f32x4*)o = (f32x4){x[0], x[1], x[2], x[3]}; *(f32x4*)(o + 4) = (f32x4){x[4], x[5], x[6], x[7]}; } });
    }
    {
        run_task<4>(T * 148 / NT, vb, nvb, tid,
            [&](int idx) __attribute__((always_inline)) { const int tok = idx / 148, sg = idx - tok * 148; int col;
                if (sg < 4) col = C_KPE + sg * 8; else if (sg < 52) col = C_MQ + (sg - 4) * 8; else if (sg < 84) col = C_SQ + (sg - 52) * 8;
                else if (sg < 100) col = C_SK + (sg - 84) * 8; else if (sg < 116) col = C_SV + (sg - 100) * 8; else col = C_GZ + (sg - 116) * 8;
                Ld1 d; d.a = *(const uint4*)(PROJ + (size_t)tok * INC + col); return d; },
            [&](int idx, const Ld1& d) __attribute__((always_inline)) { const int tok = idx / 148, sg = idx - tok * 148; bool lat; int b, t, L; tok_decode(tok, lat, b, t, L);
                bf16_t* dst; const float* rope = nullptr; float* cout = nullptr; const size_t ob = (size_t)(b * 2 + l) * 256 + t;
                if (sg < 4) { dst = wsp<bf16_t>(p, W_KPE) + (size_t)tok * 32 + sg * 8; rope = RA + (t * 16 + sg * 4) * 2; cout = p.out + O_KPE + ob * 32 + sg * 8; }
                else if (sg < 52) { const int g2 = sg - 4, part = g2 % 12; dst = wsp<bf16_t>(p, W_QMLA) + (size_t)tok * 384 + g2 * 8; if (part >= 8) rope = RA + (t * 16 + (part - 8) * 4) * 2; }
                else if (sg < 84) { const int g2 = sg - 52; dst = wsp<bf16_t>(p, W_QSWA) + (size_t)tok * 256 + g2 * 8; rope = RB + (t * 32 + (g2 & 7) * 4) * 2; }
                else if (sg < 100) { const int g2 = sg - 84; dst = wsp<bf16_t>(p, W_KSWA) + (size_t)tok * 128 + g2 * 8; rope = RB + (t * 32 + (g2 & 7) * 4) * 2; cout = p.out + O_SK + ob * 128 + g2 * 8; }
                else if (sg < 116) { const int g2 = sg - 100; dst = wsp<bf16_t>(p, W_VSWA) + (size_t)tok * 128 + g2 * 8; cout = p.out + O_SV + ob * 128 + g2 * 8; }
                else { const int g2 = sg - 116; dst = wsp<bf16_t>(p, W_GZ) + (size_t)tok * 256 + g2 * 8; }
                uint4 w = d.a;
                if (lat) {
                    if (rope) {
                        float x[8]; unpack8(d.a, x);
                        const f32x4 c0 = *(const f32x4*)rope, c1 = *(const f32x4*)(rope + 4);
                        float y[8];
                        y[0] = x[0] * c0[0] - x[1] * c0[1]; y[1] = x[0] * c0[1] + x[1] * c0[0];
                        y[2] = x[2] * c0[2] - x[3] * c0[3]; y[3] = x[2] * c0[3] + x[3] * c0[2];
                        y[4] = x[4] * c1[0] - x[5] * c1[1]; y[5] = x[4] * c1[1] + x[5] * c1[0];
                        y[6] = x[6] * c1[2] - x[7] * c1[3]; y[7] = x[6] * c1[3] + x[7] * c1[2];
                        w = pack8(y);
                    }
                } else if (cout) {
                    float x[8]; unpack8(d.a, x);
                    *(f32x4*)cout = (f32x4){x[0], x[1], x[2], x[3]}; *(f32x4*)(cout + 4) = (f32x4){x[4], x[5], x[6], x[7]};
                }
                *(uint4*)dst = w; });
    }
    {
        float* GG = wsp<float>(p, W_GG); float* GBETA = wsp<float>(p, W_GBETA);
        run_task<2>(T / NT, vb, nvb, tid,
            [&](int idx) __attribute__((always_inline)) { Ld2 d; d.a = *(const uint4*)(PROJ + (size_t)idx * INC + C_GA); d.b = *(const uint4*)(PROJ + (size_t)idx * INC + C_GB); return d; },
            [&](int idx, const Ld2& d) __attribute__((always_inline)) { float a[8], bb[8], go[8], bo[8]; unpack8(d.a, a); unpack8(d.b, bb);
#pragma unroll
                for (int e = 0; e < 8; e++) {
                    const float xx = a[e] + pin(p, I_GDT)[l * 8 + e];
                    const float sp = xx > 20.f ? xx : __logf(1.f + __expf(xx));
                    go[e] = -__expf(pin(p, I_GALOG)[l * 8 + e]) * sp;
                    bo[e] = 1.f / (1.f + __expf(-bb[e]));
                }
                *(f32x4*)(GG + (size_t)idx * 8) = (f32x4){go[0], go[1], go[2], go[3]}; *(f32x4*)(GG + (size_t)idx * 8 + 4) = (f32x4){go[4], go[5], go[6], go[7]};
                *(f32x4*)(GBETA + (size_t)idx * 8) = (f32x4){bo[0], bo[1], bo[2], bo[3]}; *(f32x4*)(GBETA + (size_t)idx * 8 + 4) = (f32x4){bo[4], bo[5], bo[6], bo[7]}; });
    }
}

template <int D2, bool MASK>
__device__ __forceinline__ void attn_seg(const float* q, float* acc, float& m, float& lsum, const bf16_t* k1, int s1, const bf16_t* k2, int s2,
                                         const bf16_t* v, int sv, int j0, int j1, int tq) {
#pragma unroll 1
    for (int j = j0; j < j1; j += 2) {
        float sa = 0.f, sb = 0.f;
        const bf16_t* kpa = k1 + (size_t)j * s1;
        const bf16_t* kpb = kpa + s1;
#pragma unroll
        for (int c = 0; c < 8; c++) {
            float ka[8], kb[8]; unpack8(*(const uint4*)(kpa + c * 8), ka); unpack8(*(const uint4*)(kpb + c * 8), kb);
#pragma unroll
            for (int e = 0; e < 8; e++) { sa += q[c * 8 + e] * ka[e]; sb += q[c * 8 + e] * kb[e]; }
        }
        if (D2 > 0) {
            const bf16_t* k2a = k2 + (size_t)j * s2;
            const bf16_t* k2b = k2a + s2;
#pragma unroll
            for (int c = 0; c < D2 / 8; c++) {
                float ka[8], kb[8]; unpack8(*(const uint4*)(k2a + c * 8), ka); unpack8(*(const uint4*)(k2b + c * 8), kb);
#pragma unroll
                for (int e = 0; e < 8; e++) { sa += q[64 + c * 8 + e] * ka[e]; sb += q[64 + c * 8 + e] * kb[e]; }
            }
        }
        if (MASK) {
            int dlt = tq - j; if (dlt > 128 || dlt < -128) sa = -1e30f;
            dlt -= 1; if (dlt > 128 || dlt < -128) sb = -1e30f;
        }
        const float mn = fmaxf(m, fmaxf(sa, sb));
        const float alpha = __expf(m - mn);
        const float pa = __expf(sa - mn), pb = __expf(sb - mn);
        lsum = lsum * alpha + pa + pb;
        m = mn;
        const bf16_t* va = v + (size_t)j * sv;
        const bf16_t* vb = va + sv;
#pragma unroll
        for (int c = 0; c < 8; c++) {
            float xa[8], xb[8]; unpack8(*(const uint4*)(va + c * 8), xa); unpack8(*(const uint4*)(vb + c * 8), xb);
#pragma unroll
            for (int e = 0; e < 8; e++) acc[c * 8 + e] = acc[c * 8 + e] * alpha + pa * xa[e] + pb * xb[e];
        }
    }
}

__device__ __forceinline__ void mla_wave(const KP& p, int l, bool lat, int b, int h, int qblk, int lane) {
    const int L = lat ? 2048 : 256, seq0 = lat ? TC + b * 2048 : b * 256;
    const int tq = seq0 + qblk * 64 + lane;
    const bf16_t* QMLA = wsp<bf16_t>(p, W_QMLA);
    const bf16_t* KVX = wsp<bf16_t>(p, W_KVX);
    const bf16_t* KPE = wsp<bf16_t>(p, W_KPE);
    float q[96], acc[64];
    const float scale = 0.10206207261596577f;
#pragma unroll
    for (int c = 0; c < 12; c++) {
        float t8[8]; unpack8(*(const uint4*)(QMLA + (size_t)tq * 384 + h * 96 + c * 8), t8);
#pragma unroll
        for (int e = 0; e < 8; e++) q[c * 8 + e] = t8[e] * scale;
    }
#pragma unroll
    for (int d = 0; d < 64; d++) acc[d] = 0.f;
    float m = -1e30f, lsum = 0.f;
    attn_seg<32, false>(q, acc, m, lsum, KVX + (size_t)seq0 * 512 + h * 128, 512, KPE + (size_t)seq0 * 32, 32, KVX + (size_t)seq0 * 512 + h * 128 + 64, 512, 0, L, 0);
    if (lat) {
        const bf16_t* KVC = wsp<bf16_t>(p, W_KVC) + ((size_t)l * 2048 + b * 512) * 512;
        const bf16_t* KPEC = wsp<bf16_t>(p, W_KPEC) + ((size_t)l * 2048 + b * 512) * 32;
        attn_seg<32, false>(q, acc, m, lsum, KVC + h * 128, 512, KPEC, 32, KVC + h * 128 + 64, 512, 0, 512, 0);
    }
    const float inv = 1.f / lsum;
    bf16_t* O = wsp<bf16_t>(p, W_H) + (size_t)tq * 1024 + h * 64;
#pragma unroll
    for (int c = 0; c < 8; c++) {
        uint4 w;
        w.x = (unsigned)f2bf(acc[c * 8 + 0] * inv) | ((unsigned)f2bf(acc[c * 8 + 1] * inv) << 16);
        w.y = (unsigned)f2bf(acc[c * 8 + 2] * inv) | ((unsigned)f2bf(acc[c * 8 + 3] * inv) << 16);
        w.z = (unsigned)f2bf(acc[c * 8 + 4] * inv) | ((unsigned)f2bf(acc[c * 8 + 5] * inv) << 16);
        w.w = (unsigned)f2bf(acc[c * 8 + 6] * inv) | ((unsigned)f2bf(acc[c * 8 + 7] * inv) << 16);
        *(uint4*)(O + c * 8) = w;
    }
}

__device__ __forceinline__ void swa_wave(const KP& p, int l, bool lat, int b, int h, int qblk, int lane) {
    const int L = lat ? 2048 : 256, seq0 = lat ? TC + b * 2048 : b * 256;
    const int tql = qblk * 64 + lane, tq = seq0 + tql, hk = h >> 1;
    const bf16_t* QSWA = wsp<bf16_t>(p, W_QSWA);
    const bf16_t* KSWA = wsp<bf16_t>(p, W_KSWA);
    const bf16_t* VSWA = wsp<bf16_t>(p, W_VSWA);
    float q[64], acc[64];
#pragma unroll
    for (int c = 0; c < 8; c++) {
        float t8[8]; unpack8(*(const uint4*)(QSWA + (size_t)tq * 256 + h * 64 + c * 8), t8);
#pragma unroll
        for (int e = 0; e < 8; e++) q[c * 8 + e] = t8[e] * 0.125f;
    }
#pragma unroll
    for (int d = 0; d < 64; d++) acc[d] = 0.f;
    float m = pin(p, I_SINK)[l * 4 + h], lsum = 1.f;
    if (lat) {
        int jlo = qblk * 64 - 128; if (jlo < 0) jlo = 0;
        int jhi = qblk * 64 + 64 + 128; if (jhi > L) jhi = L;
        attn_seg<0, true>(q, acc, m, lsum, KSWA + (size_t)seq0 * 128 + hk * 64, 128, nullptr, 0, VSWA + (size_t)seq0 * 128 + hk * 64, 128, jlo, jhi, tql);
        const bf16_t* KC = wsp<bf16_t>(p, W_KSWC) + ((size_t)l * 2048 + b * 512) * 128 + hk * 64;
        const bf16_t* VC = wsp<bf16_t>(p, W_VSWC) + ((size_t)l * 2048 + b * 512) * 128 + hk * 64;
        attn_seg<0, false>(q, acc, m, lsum, KC, 128, nullptr, 0, VC, 128, 0, 512, 0);
    } else {
        attn_seg<0, false>(q, acc, m, lsum, KSWA + (size_t)seq0 * 128 + hk * 64, 128, nullptr, 0, VSWA + (size_t)seq0 * 128 + hk * 64, 128, 0, L, 0);
    }
    const float inv = 1.f / lsum;
    bf16_t* O = wsp<bf16_t>(p, W_H) + (size_t)tq * 1024 + 256 + h * 64;
#pragma unroll
    for (int c = 0; c < 8; c++) {
        uint4 w;
        w.x = (unsigned)f2bf(acc[c * 8 + 0] * inv) | ((unsigned)f2bf(acc[c * 8 + 1] * inv) << 16);
        w.y = (unsigned)f2bf(acc[c * 8 + 2] * inv) | ((unsigned)f2bf(acc[c * 8 + 3] * inv) << 16);
        w.z = (unsigned)f2bf(acc[c * 8 + 4] * inv) | ((unsigned)f2bf(acc[c * 8 + 5] * inv) << 16);
        w.w = (unsigned)f2bf(acc[c * 8 + 6] * inv) | ((unsigned)f2bf(acc[c * 8 + 7] * inv) << 16);
        *(uint4*)(O + c * 8) = w;
    }
}


__device__ __forceinline__ float xmax16(float v) { auto r = __builtin_amdgcn_permlane16_swap(__float_as_uint(v), __float_as_uint(v), false, false); return fmaxf(__uint_as_float(r[0]), __uint_as_float(r[1])); }
__device__ __forceinline__ float xmax32(float v) { auto r = __builtin_amdgcn_permlane32_swap(__float_as_uint(v), __float_as_uint(v), false, false); return fmaxf(__uint_as_float(r[0]), __uint_as_float(r[1])); }
__device__ __forceinline__ float xsum16(float v) { auto r = __builtin_amdgcn_permlane16_swap(__float_as_uint(v), __float_as_uint(v), false, false); return __uint_as_float(r[0]) + __uint_as_float(r[1]); }
__device__ __forceinline__ float xsum32(float v) { auto r = __builtin_amdgcn_permlane32_swap(__float_as_uint(v), __float_as_uint(v), false, false); return __uint_as_float(r[0]) + __uint_as_float(r[1]); }
typedef short s16x4 __attribute__((ext_vector_type(4)));
#define LDS_AS __attribute__((address_space(3)))
template <int TYPE  >
__device__ __forceinline__ void attn_unit(const KP& p, int l, bool lat, int b, int h, int qb, unsigned char* lds) {
    constexpr int NKS = TYPE == 0 ? 3 : 2;
    constexpr int KSTR = TYPE == 0 ? 208 : 144;
    constexpr int VSTR = 160;
    constexpr int KT = 128, MT = KT / 16;
    constexpr int KBUF = KT * KSTR, VBUF = KT * VSTR;
    const int tid = p.tid, wid = tid >> 6, lane = tid & 63, fr = lane & 15, g = lane >> 4;
    const int L = lat ? 2048 : 256, seq0 = lat ? TC + b * 2048 : b * 256;
    const int q0 = qb * 128;
    const int tql = q0 + wid * 16 + fr;
    const int hk = h >> 1;
    bf16x8 qf[NKS];
    {
        const bf16_t* qp = TYPE == 0 ? wsp<bf16_t>(p, W_QMLA) + (size_t)(seq0 + tql) * 384 + h * 96 : wsp<bf16_t>(p, W_QSWA) + (size_t)(seq0 + tql) * 256 + h * 64;
#pragma unroll
        for (int ks = 0; ks < NKS; ks++) qf[ks] = *(const bf16x8*)(qp + ks * 32 + g * 8);
    }
    const float sc2 = (TYPE == 0 ? 0.10206207261596577f : 0.125f) * 1.4426950408889634f;
    float m2 = TYPE == 0 ? -1e30f : pin(p, I_SINK)[l * 4 + h] * 1.4426950408889634f;
    float lsum = (TYPE == 1 && g == 0) ? 1.f : 0.f;
    f32x4 oacc[4];
#pragma unroll
    for (int i = 0; i < 4; i++) oacc[i] = (f32x4){0.f, 0.f, 0.f, 0.f};
    int j0 = 0, j1 = L;
    if (TYPE == 1 && lat) { j0 = q0 - 128; if (j0 < 0) j0 = 0; j1 = q0 + 256; if (j1 > L) j1 = L; }
    const int nt0 = (j1 - j0) / KT, nt = nt0 + (lat ? 512 / KT : 0);
    uint4 ra0, ra1, ra2, ra3, ra4, rb0, rb1, rb2, rb3, rb4;
    auto tile_ptrs = [&](int it, const bf16_t*& kb, int& kstr, const bf16_t*& pb, const bf16_t*& vb, int& vstr) __attribute__((always_inline)) {
        if (it < nt0) {
            const size_t t0 = (size_t)seq0 + j0 + it * KT;
            if (TYPE == 0) { kb = wsp<bf16_t>(p, W_KVX) + t0 * 512 + h * 128; kstr = 512; pb = wsp<bf16_t>(p, W_KPE) + t0 * 32; vb = kb + 64; vstr = 512; }
            else { kb = wsp<bf16_t>(p, W_KSWA) + t0 * 128 + hk * 64; kstr = 128; pb = nullptr; vb = wsp<bf16_t>(p, W_VSWA) + t0 * 128 + hk * 64; vstr = 128; }
        } else {
            const size_t t0 = (size_t)l * 2048 + b * 512 + (it - nt0) * KT;
            if (TYPE == 0) { kb = wsp<bf16_t>(p, W_KVC) + t0 * 512 + h * 128; kstr = 512; pb = wsp<bf16_t>(p, W_KPEC) + t0 * 32; vb = kb + 64; vstr = 512; }
            else { kb = wsp<bf16_t>(p, W_KSWC) + t0 * 128 + hk * 64; kstr = 128; pb = nullptr; vb = wsp<bf16_t>(p, W_VSWC) + t0 * 128 + hk * 64; vstr = 128; }
        }
    };
#define ATT_GLOAD(R0, R1, R2, R3, R4, it_) do { const bf16_t* kb_; const bf16_t* pb_; const bf16_t* vb_; int ks_, vs_; tile_ptrs((it_), kb_, ks_, pb_, vb_, vs_); \
        R0 = *(const uint4*)(kb_ + (size_t)(tid >> 3) * ks_ + (tid & 7) * 8); R1 = *(const uint4*)(kb_ + (size_t)(64 + (tid >> 3)) * ks_ + (tid & 7) * 8); \
        R2 = *(const uint4*)(vb_ + (size_t)(tid >> 3) * vs_ + (tid & 7) * 8); R3 = *(const uint4*)(vb_ + (size_t)(64 + (tid >> 3)) * vs_ + (tid & 7) * 8); \
        if (TYPE == 0) R4 = *(const uint4*)(pb_ + (size_t)(tid >> 2) * 32 + (tid & 3) * 8); } while (0)
#define ATT_LSTORE(R0, R1, R2, R3, R4, buf_) do { unsigned char* kd_ = lds + (buf_) * (KBUF + VBUF); unsigned char* vd_ = kd_ + KBUF; \
        *(uint4*)(kd_ + (tid >> 3) * KSTR + (tid & 7) * 16) = R0; *(uint4*)(kd_ + (64 + (tid >> 3)) * KSTR + (tid & 7) * 16) = R1; \
        *(uint4*)(vd_ + (tid >> 3) * VSTR + (tid & 7) * 16) = R2; *(uint4*)(vd_ + (64 + (tid >> 3)) * VSTR + (tid & 7) * 16) = R3; \
        if (TYPE == 0) *(uint4*)(kd_ + (tid >> 2) * KSTR + 128 + (tid & 3) * 16) = R4; } while (0)
    auto compute_tile = [&](int it) __attribute__((always_inline)) {
        const unsigned char* kd = lds + (it & 1) * (KBUF + VBUF);
        const unsigned char* vd = kd + KBUF;
        f32x4 sacc[MT];
#pragma unroll
        for (int mt = 0; mt < MT; mt++) sacc[mt] = (f32x4){0.f, 0.f, 0.f, 0.f};
#pragma unroll
        for (int ks = 0; ks < NKS; ks++)
#pragma unroll
            for (int mt = 0; mt < MT; mt++) {
                bf16x8 a = *(const bf16x8*)(kd + (mt * 16 + fr) * KSTR + ks * 64 + g * 16);
                sacc[mt] = __builtin_amdgcn_mfma_f32_16x16x32_bf16(a, qf[ks], sacc[mt], 0, 0, 0);
            }
        float mx = -3e38f;
        const bool domask = (TYPE == 1) && lat && (it < nt0);
        const int jbase = j0 + it * KT + 4 * g;
#pragma unroll
        for (int mt = 0; mt < MT; mt++)
#pragma unroll
            for (int r = 0; r < 4; r++) {
                float s = sacc[mt][r] * sc2;
                if (domask) { int dlt = tql - (jbase + mt * 16 + r); if (dlt > 128 || dlt < -128) s = -1e30f; }
                sacc[mt][r] = s;
                mx = fmaxf(mx, s);
            }
        mx = xmax16(mx);
        mx = xmax32(mx);
        const float mn = fmaxf(m2, mx);
        const float alpha = __builtin_amdgcn_exp2f(m2 - mn);
        m2 = mn;
        float ps = 0.f;
#pragma unroll
        for (int mt = 0; mt < MT; mt++)
#pragma unroll
            for (int r = 0; r < 4; r++) { float pv = __builtin_amdgcn_exp2f(sacc[mt][r] - mn); sacc[mt][r] = pv; ps += pv; }
        lsum = lsum * alpha + ps;
#pragma unroll
        for (int i = 0; i < 4; i++) oacc[i] *= alpha;
        bf16x8 pf[MT / 2];
#pragma unroll
        for (int s = 0; s < MT / 2; s++) {
            union { unsigned u[4]; bf16x8 v; } cv;
            cv.u[0] = pg8::cvt_pk_bf16(sacc[2 * s][0], sacc[2 * s][1]); cv.u[1] = pg8::cvt_pk_bf16(sacc[2 * s][2], sacc[2 * s][3]);
            cv.u[2] = pg8::cvt_pk_bf16(sacc[2 * s + 1][0], sacc[2 * s + 1][1]); cv.u[3] = pg8::cvt_pk_bf16(sacc[2 * s + 1][2], sacc[2 * s + 1][3]);
            pf[s] = cv.v;
        }
#pragma unroll
        for (int md = 0; md < 4; md++)
#pragma unroll
            for (int s = 0; s < MT / 2; s++) {
                const unsigned char* va = vd + (32 * s + 4 * g + (fr >> 2)) * VSTR + (md * 16 + (fr & 3) * 4) * 2;
                s16x4 lo = __builtin_amdgcn_ds_read_tr16_b64_v4i16((LDS_AS s16x4*)(va));
                s16x4 hi = __builtin_amdgcn_ds_read_tr16_b64_v4i16((LDS_AS s16x4*)(va + 16 * VSTR));
                bf16x8 a;
                a[0] = lo[0]; a[1] = lo[1]; a[2] = lo[2]; a[3] = lo[3]; a[4] = hi[0]; a[5] = hi[1]; a[6] = hi[2]; a[7] = hi[3];
                oacc[md] = __builtin_amdgcn_mfma_f32_16x16x32_bf16(a, pf[s], oacc[md], 0, 0, 0);
            }
    };
    __syncthreads();
    ATT_GLOAD(ra0, ra1, ra2, ra3, ra4, 0);
    ATT_LSTORE(ra0, ra1, ra2, ra3, ra4, 0);
    if (nt > 1) ATT_GLOAD(rb0, rb1, rb2, rb3, rb4, 1);
    __syncthreads();
#pragma unroll 1
    for (int it = 0; it < nt; it += 2) {
        if (it + 2 < nt) ATT_GLOAD(ra0, ra1, ra2, ra3, ra4, it + 2);
        compute_tile(it);
        if (it + 1 < nt) ATT_LSTORE(rb0, rb1, rb2, rb3, rb4, 1);
        __syncthreads();
        if (it + 1 < nt) {
            if (it + 3 < nt) ATT_GLOAD(rb0, rb1, rb2, rb3, rb4, it + 3);
            compute_tile(it + 1);
            if (it + 2 < nt) ATT_LSTORE(ra0, ra1, ra2, ra3, ra4, 0);
            __syncthreads();
        }
    }
    lsum = xsum16(lsum);
    lsum = xsum32(lsum);
    const float inv = 1.f / lsum;
    bf16_t* O = wsp<bf16_t>(p, W_H) + (size_t)(seq0 + tql) * 1024 + (TYPE == 0 ? 0 : 256) + h * 64;
#pragma unroll
    for (int md = 0; md < 4; md++) {
        uint2 w;
        w.x = (unsigned)f2bf(oacc[md][0] * inv) | ((unsigned)f2bf(oacc[md][1] * inv) << 16);
        w.y = (unsigned)f2bf(oacc[md][2] * inv) | ((unsigned)f2bf(oacc[md][3] * inv) << 16);
        *(uint2*)(O + md * 16 + 4 * g) = w;
    }
}

struct GdnCombo { bool lat; int b, dir, h, L, seq0, nch, ubase; };
__device__ __forceinline__ GdnCombo gdn_combo(int cid  ) {
    GdnCombo c;
    c.lat = cid >= 128;
    const int x = c.lat ? cid - 128 : cid;
    c.b = x >> 3; c.dir = (x >> 2) & 1; c.h = x & 3;
    c.L = c.lat ? 2048 : 256; c.seq0 = c.lat ? TC + c.b * 2048 : c.b * 256; c.nch = c.lat ? 32 : 4;
    c.ubase = c.lat ? 512 + x * 32 : x * 4;
    return c;
}
constexpr int G1_SLOT = 64 * 68 * 4 + 512 + 4096;
__device__ __forceinline__ void gdn_g1_unit(const KP& p, int l, int bu  , unsigned char* lds) {
    const int tid = p.tid, wid = tid >> 6, lane = tid & 63, fr = lane & 15, g = lane >> 4;
    const int slot = wid >> 1, half = wid & 1, tl = half * 64 + lane;
    int cid, n0;
    if (bu < 128) { cid = bu; n0 = 0; } else { cid = 128 + ((bu - 128) >> 3); n0 = ((bu - 128) & 7) * 4; }
    const GdnCombo cb = gdn_combo(cid);
    const int n = n0 + slot, nu = cb.ubase + n;
    float* As = (float*)(lds + slot * G1_SLOT);
    float* decs = As + 64 * 68;
    float* betas = decs + 64;
    const bf16_t* GQ = wsp<bf16_t>(p, W_GQ); const bf16_t* GK = wsp<bf16_t>(p, W_GK); const bf16_t* GV = wsp<bf16_t>(p, W_GV);
    const float* GG = wsp<float>(p, W_GG); const float* GBETA = wsp<float>(p, W_GBETA);
    auto tok_of = [&](int c) __attribute__((always_inline)) -> size_t { int pos = n * 64 + c; return (size_t)cb.seq0 + (cb.dir ? cb.L - 1 - pos : pos); };
    __syncthreads();
    if (half == 0) {
        const size_t tk = tok_of(lane);
        float gv = GG[tk * 8 + cb.dir * 4 + cb.h];
#pragma unroll
        for (int o = 1; o < 64; o <<= 1) { float t = __shfl_up(gv, o); if (lane >= o) gv += t; }
        decs[lane] = gv;
        betas[lane] = GBETA[tk * 8 + cb.dir * 4 + cb.h];
    }
    __syncthreads();
    {
        bf16x8 kf[4][2], qf[4][2];
#pragma unroll
        for (int x = 0; x < 4; x++) {
            const size_t tk = tok_of(16 * x + fr);
#pragma unroll
            for (int ks = 0; ks < 2; ks++) {
                kf[x][ks] = *(const bf16x8*)(GK + tk * 256 + cb.h * 64 + ks * 32 + g * 8);
                if (half == 1) qf[x][ks] = *(const bf16x8*)(GQ + tk * 256 + cb.h * 64 + ks * 32 + g * 8);
                else qf[x][ks] = kf[x][ks];
            }
        }
#pragma unroll
        for (int nt = 0; nt < 4; nt++) {
            const int c = 16 * nt + fr;
            const float dc = decs[c], bc = betas[c];
#pragma unroll
            for (int mt = 0; mt < 4; mt++) {
                f32x4 acc = (f32x4){0.f, 0.f, 0.f, 0.f};
#pragma unroll
                for (int ks = 0; ks < 2; ks++) acc = __builtin_amdgcn_mfma_f32_16x16x32_bf16(kf[mt][ks], qf[nt][ks], acc, 0, 0, 0);
                const int s0 = 16 * mt + 4 * g;
                f32x4 ds = *(const f32x4*)(decs + s0);
                f32x4 o;
#pragma unroll
                for (int r = 0; r < 4; r++) {
                    const int s = s0 + r;
                    const float gm = __expf(dc - ds[r]);
                    if (half == 0) o[r] = (s < c) ? bc * acc[r] * gm : 0.f;
                    else o[r] = (s <= c) ? acc[r] * gm : 0.f;
                }
                if (half == 0) *(f32x4*)(As + c * 68 + s0) = o;
                else {
                    uint2 w;
                    w.x = (unsigned)f2bf(o[0]) | ((unsigned)f2bf(o[1]) << 16);
                    w.y = (unsigned)f2bf(o[2]) | ((unsigned)f2bf(o[3]) << 16);
                    *(uint2*)(wsp<bf16_t>(p, W_GAQK) + (size_t)nu * 4096 + c * 64 + 32 * (mt >> 1) + 8 * g + 4 * (mt & 1)) = w;
                }
            }
        }
    }
    __syncthreads();
    float* Tl = betas + 64;
    if (half == 0) {
        const int bi = lane >> 4, j = lane & 15;
        float t[16];
#pragma unroll
        for (int c = 0; c < 16; c++) {
            float s = (c == j) ? 1.f : 0.f;
#pragma unroll
            for (int s2 = 0; s2 < c; s2++) s -= As[(16 * bi + c) * 68 + 16 * bi + s2] * t[s2];
            t[c] = s;
        }
#pragma unroll
        for (int c = 0; c < 16; c++) Tl[(bi * 16 + c) * 16 + j] = t[c];
    }
    __syncthreads();
    {
        f32x4 X[4][4];
#pragma unroll
        for (int i = 0; i < 4; i++) {
#pragma unroll
            for (int r = 0; r < 4; r++) {
                const int row = 16 * i + 4 * g + r;
                const size_t tk = tok_of(row);
                const float sc = half ? betas[row] * __expf(decs[row]) : betas[row];
                const bf16_t* srcp = (half ? GK : GV) + tk * 256 + cb.h * 64 + fr;
#pragma unroll
                for (int nt = 0; nt < 4; nt++) X[i][nt][r] = bf2f(srcp[16 * nt]) * sc;
            }
#pragma unroll
            for (int j = 0; j < 4; j++) {
                if (j < i) {
#pragma unroll
                    for (int ks = 0; ks < 4; ks++) {
                        const float av = -As[(16 * i + fr) * 68 + 16 * j + 4 * g + ks];
#pragma unroll
                        for (int nt = 0; nt < 4; nt++) X[i][nt] = __builtin_amdgcn_mfma_f32_16x16x4f32(av, X[j][nt][ks], X[i][nt], 0, 0, 0);
                    }
                }
            }
            f32x4 Y[4];
#pragma unroll
            for (int nt = 0; nt < 4; nt++) Y[nt] = (f32x4){0.f, 0.f, 0.f, 0.f};
#pragma unroll
            for (int ks = 0; ks < 4; ks++) {
                const float tv = Tl[(i * 16 + fr) * 16 + 4 * g + ks];
#pragma unroll
                for (int nt = 0; nt < 4; nt++) Y[nt] = __builtin_amdgcn_mfma_f32_16x16x4f32(tv, X[i][nt][ks], Y[nt], 0, 0, 0);
            }
#pragma unroll
            for (int nt = 0; nt < 4; nt++) X[i][nt] = Y[nt];
        }
        if (half == 0) {
            bf16_t* dst = wsp<bf16_t>(p, W_GUV) + (size_t)nu * 4096 + lane * 4;
#pragma unroll
            for (int i = 0; i < 4; i++)
#pragma unroll
                for (int nt = 0; nt < 4; nt++) {
                    uint2 w; w.x = pg8::cvt_pk_bf16(X[i][nt][0], X[i][nt][1]); w.y = pg8::cvt_pk_bf16(X[i][nt][2], X[i][nt][3]);
                    *(uint2*)(dst + (nt * 4 + i) * 256) = w;
                }
        } else {
            bf16_t* dst = wsp<bf16_t>(p, W_GW) + (size_t)nu * 4096;
#pragma unroll
            for (int nt = 0; nt < 4; nt++) {
                const int d = 16 * nt + fr;
                const int pcol = 32 * (d >> 5) + 8 * ((d >> 2) & 3) + 4 * ((d >> 4) & 1) + (d & 3);
#pragma unroll
                for (int i = 0; i < 4; i++)
#pragma unroll
                    for (int r = 0; r < 4; r++) dst[(16 * i + 4 * g + r) * 64 + pcol] = f2bf(-X[i][nt][r]);
            }
        }
    }
    {
        const int dkk = tl & 63, chalf = tl >> 6;
        const float dlast = decs[63];
        bf16_t* dst = wsp<bf16_t>(p, W_GKTT) + (size_t)nu * 4096 + dkk * 64 + chalf * 32;
#pragma unroll
        for (int c8 = 0; c8 < 4; c8++) {
            unsigned w[4];
#pragma unroll
            for (int e = 0; e < 8; e += 2) {
                const int c0 = chalf * 32 + c8 * 8 + e;
                float v0 = bf2f(GK[tok_of(c0) * 256 + cb.h * 64 + dkk]) * __expf(dlast - decs[c0]);
                float v1 = bf2f(GK[tok_of(c0 + 1) * 256 + cb.h * 64 + dkk]) * __expf(dlast - decs[c0 + 1]);
                w[e >> 1] = (unsigned)f2bf(v0) | ((unsigned)f2bf(v1) << 16);
            }
            *(uint2*)(dst + 16 * (c8 & 1) + 4 * (c8 >> 1)) = make_uint2(w[0], w[1]);
            *(uint2*)(dst + 16 * (c8 & 1) + 8 + 4 * (c8 >> 1)) = make_uint2(w[2], w[3]);
        }
        if (tl < 64) wsp<float>(p, W_GEDEC)[(size_t)nu * 64 + tl] = __expf(decs[tl]);
        if (tl == 0) wsp<float>(p, W_GTAIL)[nu] = __expf(dlast);
    }
}

constexpr int G2_ROW = 144, G2_MAT = 64 * G2_ROW, G2_UV = 4 * G2_MAT, G2_ED = G2_UV + 8192, G2_BUF = G2_ED + 512, G2_X = 2 * G2_BUF;
__device__ __forceinline__ void gdn_g2_unit(const KP& p, int l, int bu  , unsigned char* lds) {
    const int tid = p.tid, wid = __builtin_amdgcn_readfirstlane(tid >> 6), lane = tid & 63, fr = lane & 15, g = lane >> 4;
    const int cid = (bu < 32) ? 128 + bu : bu - 32;
    const int nb = wid & 3, mh = wid >> 2;
    const GdnCombo cb = gdn_combo(cid);
    const bf16_t* GQ = wsp<bf16_t>(p, W_GQ);
    f32x4 S[4];
    if (cb.lat) {
        const float* st = pin(p, I_STATE) + ((((size_t)cb.b * 2 + l) * 2 + cb.dir) * 4 + cb.h) * 4096;
#pragma unroll
        for (int mt = 0; mt < 4; mt++)
#pragma unroll
            for (int r = 0; r < 4; r++) S[mt][r] = st[(16 * mt + 4 * g + r) * 64 + 16 * nb + fr];
    } else {
#pragma unroll
        for (int mt = 0; mt < 4; mt++) S[mt] = (f32x4){0.f, 0.f, 0.f, 0.f};
    }
    bf16_t* OUT = wsp<bf16_t>(p, cb.dir ? W_OB : W_OF);
    const int lrow = tid >> 3, lpart = tid & 7;
    uint4 rw, rq, ra, rk, ru, re; float rtail;
#define G2_GLOAD(n_) do { const size_t nu_ = (size_t)cb.ubase + (n_); \
        rw = *(const uint4*)(wsp<bf16_t>(p, W_GW) + nu_ * 4096 + lrow * 64 + lpart * 8); \
        ra = *(const uint4*)(wsp<bf16_t>(p, W_GAQK) + nu_ * 4096 + lrow * 64 + lpart * 8); \
        rk = *(const uint4*)(wsp<bf16_t>(p, W_GKTT) + nu_ * 4096 + lrow * 64 + lpart * 8); \
        ru = *(const uint4*)(wsp<bf16_t>(p, W_GUV) + nu_ * 4096 + tid * 8); \
        { const int pos_ = (n_) * 64 + lrow; const size_t tk_ = (size_t)cb.seq0 + (cb.dir ? cb.L - 1 - pos_ : pos_); \
          rq = *(const uint4*)(GQ + tk_ * 256 + cb.h * 64 + lpart * 8); } \
        re = *(const uint4*)(wsp<float>(p, W_GEDEC) + nu_ * 64 + (tid & 15) * 4); \
        rtail = wsp<float>(p, W_GTAIL)[nu_]; } while (0)
#define G2_LSTORE(buf_) do { unsigned char* b_ = lds + (buf_) * G2_BUF; \
        *(uint4*)(b_ + lrow * G2_ROW + lpart * 16) = rw; *(uint4*)(b_ + G2_MAT + lrow * G2_ROW + lpart * 16) = rq; \
        *(uint4*)(b_ + 2 * G2_MAT + lrow * G2_ROW + lpart * 16) = ra; *(uint4*)(b_ + 3 * G2_MAT + lrow * G2_ROW + lpart * 16) = rk; \
        *(uint4*)(b_ + G2_UV + tid * 16) = ru; \
        if (tid < 16) *(uint4*)(b_ + G2_ED + tid * 16) = re; if (tid == 16) *(float*)(b_ + G2_ED + 256) = rtail; } while (0)
    __syncthreads();
    G2_GLOAD(0);
    G2_LSTORE(0);
    __syncthreads();
#pragma unroll 1
    for (int n = 0; n < cb.nch; n++) {
        if (n + 1 < cb.nch) G2_GLOAD(n + 1);
        const unsigned char* bb = lds + (n & 1) * G2_BUF;
        bf16x8 sb[2];
#pragma unroll
        for (int s = 0; s < 2; s++) {
            union { unsigned u[4]; bf16x8 v; } cv;
            cv.u[0] = pg8::cvt_pk_bf16(S[2 * s][0], S[2 * s][1]); cv.u[1] = pg8::cvt_pk_bf16(S[2 * s][2], S[2 * s][3]);
            cv.u[2] = pg8::cvt_pk_bf16(S[2 * s + 1][0], S[2 * s + 1][1]); cv.u[3] = pg8::cvt_pk_bf16(S[2 * s + 1][2], S[2 * s + 1][3]);
            sb[s] = cv.v;
        }
        f32x4 uacc[2], oq[2], oa[2];
#pragma unroll
        for (int i = 0; i < 2; i++) {
            const int mt = 2 * mh + i;
            const uint2 uvw = *(const uint2*)(bb + G2_UV + ((nb * 4 + mt) * 64 + lane) * 8);
            uacc[i][0] = __uint_as_float(uvw.x << 16); uacc[i][1] = __uint_as_float(uvw.x & 0xffff0000u);
            uacc[i][2] = __uint_as_float(uvw.y << 16); uacc[i][3] = __uint_as_float(uvw.y & 0xffff0000u);
            oq[i] = (f32x4){0.f, 0.f, 0.f, 0.f};
            oa[i] = (f32x4){0.f, 0.f, 0.f, 0.f};
#pragma unroll
            for (int s = 0; s < 2; s++) {
                const bf16x8 wf = *(const bf16x8*)(bb + (16 * mt + fr) * G2_ROW + s * 64 + g * 16);
                const unsigned char* qrow = bb + G2_MAT + (16 * mt + fr) * G2_ROW + s * 64 + g * 8;
                const uint2 qlo = *(const uint2*)(qrow), qhi = *(const uint2*)(qrow + 32);
                union { uint4 u; bf16x8 v; } qf; qf.u = make_uint4(qlo.x, qlo.y, qhi.x, qhi.y);
                uacc[i] = __builtin_amdgcn_mfma_f32_16x16x32_bf16(wf, sb[s], uacc[i], 0, 0, 0);
                oq[i] = __builtin_amdgcn_mfma_f32_16x16x32_bf16(qf.v, sb[s], oq[i], 0, 0, 0);
            }
        }
        union { uint4 u; bf16x8 v; } uown, uoth;
        uown.u = make_uint4(pg8::cvt_pk_bf16(uacc[0][0], uacc[0][1]), pg8::cvt_pk_bf16(uacc[0][2], uacc[0][3]), pg8::cvt_pk_bf16(uacc[1][0], uacc[1][1]), pg8::cvt_pk_bf16(uacc[1][2], uacc[1][3]));
        *(uint4*)(lds + G2_X + ((nb * 2 + mh) * 64 + lane) * 16) = uown.u;
        __syncthreads();
        uoth.u = *(const uint4*)(lds + G2_X + ((nb * 2 + (1 - mh)) * 64 + lane) * 16);
        bf16x8 ub[2];
        ub[0] = mh == 0 ? uown.v : uoth.v;
        ub[1] = mh == 0 ? uoth.v : uown.v;
        const float tail = *(const float*)(bb + G2_ED + 256);
#pragma unroll
        for (int i = 0; i < 2; i++) {
            const int mt = 2 * mh + i;
#pragma unroll
            for (int s = 0; s < 2; s++) {
                const bf16x8 af = *(const bf16x8*)(bb + 2 * G2_MAT + (16 * mt + fr) * G2_ROW + s * 64 + g * 16);
                oa[i] = __builtin_amdgcn_mfma_f32_16x16x32_bf16(af, ub[s], oa[i], 0, 0, 0);
            }
        }
#pragma unroll
        for (int mt = 0; mt < 4; mt++) {
            S[mt] *= tail;
#pragma unroll
            for (int s = 0; s < 2; s++) {
                const bf16x8 kt = *(const bf16x8*)(bb + 3 * G2_MAT + (16 * mt + fr) * G2_ROW + s * 64 + g * 16);
                S[mt] = __builtin_amdgcn_mfma_f32_16x16x32_bf16(kt, ub[s], S[mt], 0, 0, 0);
            }
        }
#pragma unroll
        for (int i = 0; i < 2; i++) {
            const int mt = 2 * mh + i;
            const f32x4 ed = *(const f32x4*)(bb + G2_ED + (16 * mt + 4 * g) * 4);
#pragma unroll
            for (int r = 0; r < 4; r++) {
                const int pos = n * 64 + 16 * mt + 4 * g + r;
                const size_t tk = (size_t)cb.seq0 + (cb.dir ? cb.L - 1 - pos : pos);
                OUT[tk * 256 + cb.h * 64 + 16 * nb + fr] = f2bf(ed[r] * oq[i][r] + oa[i][r]);
            }
        }
        if (n + 1 < cb.nch) G2_LSTORE((n + 1) & 1);
        __syncthreads();
    }
    if (!cb.lat && mh == 0) {
        float* so = p.out + O_ST + ((((size_t)cb.b * 2 + l) * 2 + cb.dir) * 4 + cb.h) * 4096;
#pragma unroll
        for (int mt = 0; mt < 4; mt++)
#pragma unroll
            for (int r = 0; r < 4; r++) so[(16 * mt + 4 * g + r) * 64 + 16 * nb + fr] = S[mt][r];
    }
}

__device__ __forceinline__ void hyprep_unit(const KP& p, int l, int tu  ) {
    const int tok0 = tu * 32;
    const bool lat = tok0 >= TC;
    const int L = lat ? 2048 : 256;
    const int t0 = lat ? ((tok0 - TC) & 2047) : (tok0 & 255);
    const bf16_t* PROJ = wsp<bf16_t>(p, W_PROJ);
    const float* cw = pin(p, I_HCONV) + (size_t)l * 3 * 768;
#pragma unroll 1
    for (int pass = 0; pass < 2; pass++) {
        const int ch = p.tid + 512 * pass;
        if (ch < 768) {
            const float w0 = cw[ch], w1 = cw[768 + ch], w2 = cw[1536 + ch];
            const bf16_t* src = PROJ + (size_t)tok0 * INC + C_HU + ch;
            bf16_t* dst = wsp<bf16_t>(p, ch < 256 ? W_HV : (ch < 512 ? W_HX1 : W_HX2)) + (size_t)(ch & 255) * T + tok0;
            float xr[34];
            xr[0] = (t0 > 0) ? bf2f(src[-INC]) : 0.f;
#pragma unroll
            for (int t = 0; t < 32; t++) xr[t + 1] = bf2f(src[(size_t)t * INC]);
            xr[33] = (t0 + 32 < L) ? bf2f(src[(size_t)32 * INC]) : 0.f;
#pragma unroll
            for (int k8 = 0; k8 < 4; k8++) {
                float y[8];
#pragma unroll
                for (int e = 0; e < 8; e++) { const int t = k8 * 8 + e; y[e] = xr[t] * w0 + xr[t + 1] * w1 + xr[t + 2] * w2; }
                *(uint4*)(dst + k8 * 8) = pack8(y);
            }
        }
    }
}

template <int L, int NBATCH>
__device__ __forceinline__ void hyena_mfma_unit(const KP& p, int l, int c, unsigned char* lds) {
    constexpr int NB = L / 16, HRLEN = L + 48, XOFF = L / 2 + 31, UBL = L + 512, NTW = (L / 256) * NBATCH / 8;
    constexpr bool LAT = (L == 2048);
    const int tid = p.tid, wid = __builtin_amdgcn_readfirstlane(tid >> 6), lane = tid & 63, fr = lane & 15, g = lane >> 4;
    bf16_t* hr = (bf16_t*)lds;
    bf16_t* ubuf = hr + 4 * HRLEN;
    bf16_t* zbuf = ubuf + NBATCH * UBL;
    const bf16_t* HVt = wsp<bf16_t>(p, W_HV) + (size_t)c * T;
    const bf16_t* HX1t = wsp<bf16_t>(p, W_HX1) + (size_t)c * T;
    const bf16_t* HX2t = wsp<bf16_t>(p, W_HX2) + (size_t)c * T;
    bf16_t* YT = wsp<bf16_t>(p, W_YT) + (size_t)c * T;
    const bf16_t* FT = wsp<bf16_t>(p, W_FILT) + (size_t)l * 1179648 + (LAT ? 131072 : 0);
    const int sbase = LAT ? TC : 0;
    __syncthreads();
    { unsigned zz = 0u; asm volatile("" : "+v"(zz)); const uint4 z4 = make_uint4(zz, zz, zz, zz);
      for (int i = tid; i < 2 * NBATCH * UBL / 8; i += NT) ((uint4*)ubuf)[i] = z4; }
    for (int x = tid; x < HRLEN; x += NT) {
#pragma unroll
        for (int o = 0; o < 2; o++) {
            const bf16_t* f = FT + (size_t)(o * 256 + c) * L;
            const int i0 = L + 31 - x, i1 = L + 30 - x;
            hr[(o * 2 + 0) * HRLEN + x] = (i0 >= 0 && i0 < L) ? f[i0] : (bf16_t)0;
            hr[(o * 2 + 1) * HRLEN + x] = (i1 >= 0 && i1 < L) ? f[i1] : (bf16_t)0;
        }
    }
    __syncthreads();
    for (int i = tid; i < NBATCH * L / 8; i += NT) {
        const int bt = i / (L / 8), s8 = i % (L / 8);
        *(uint4*)(ubuf + bt * UBL + 256 + s8 * 8) = *(const uint4*)(HVt + sbase + bt * L + s8 * 8);
    }
    __syncthreads();
    const int i0blk = LAT ? 16 * wid : 0;
    int dlo = -(NB / 2); if (i0blk - NB > dlo) dlo = i0blk - NB;
    int dhi = NB / 2; if (i0blk + 15 < dhi) dhi = i0blk + 15;
    const int P = 1 - (fr & 1);
    const float bias0 = pin(p, I_HBIAS)[(l * 2 + 0) * 256 + c], bias1 = pin(p, I_HBIAS)[(l * 2 + 1) * 256 + c];
#pragma unroll 1
    for (int order = 0; order < 2; order++) {
        const bf16_t* hrp = hr + (order * 2 + P) * HRLEN;
        const bf16_t* ub = order == 0 ? ubuf : zbuf;
        f32x4 acc[NTW];
#pragma unroll
        for (int nt = 0; nt < NTW; nt++) acc[nt] = (f32x4){0.f, 0.f, 0.f, 0.f};
#pragma unroll 1
        for (int d = dlo; d <= dhi; d += 2) {
            const int x0 = XOFF - 16 * d - 16 * (g >> 1) + 8 * (g & 1) - fr;
            const unsigned* ap = (const unsigned*)(hrp + (x0 - P));
            union { unsigned u[4]; bf16x8 v; } af;
            af.u[0] = ap[0]; af.u[1] = ap[1]; af.u[2] = ap[2]; af.u[3] = ap[3];
            const int uoff = 16 * (i0blk + fr - d - (g >> 1)) + 8 * (g & 1) + 256;
#pragma unroll
            for (int nt = 0; nt < NTW; nt++) {
                const int bt = LAT ? nt : 2 * wid + nt;
                const bf16x8 bf = *(const bf16x8*)(ub + bt * UBL + uoff);
                acc[nt] = __builtin_amdgcn_mfma_f32_16x16x32_bf16(af.v, bf, acc[nt], 0, 0, 0);
            }
        }
        const int t4 = 16 * (i0blk + fr) + 4 * g;
#pragma unroll
        for (int nt = 0; nt < NTW; nt++) {
            const int bt = LAT ? nt : 2 * wid + nt;
            const uint2 uw = *(const uint2*)(ub + bt * UBL + 256 + t4);
            const uint2 xw = *(const uint2*)((order == 0 ? HX1t : HX2t) + sbase + bt * L + t4);
            const float bias = order == 0 ? bias0 : bias1;
            float o0 = __uint_as_float(xw.x << 16) * (acc[nt][0] + __uint_as_float(uw.x << 16) * bias);
            float o1 = __uint_as_float(xw.x & 0xffff0000u) * (acc[nt][1] + __uint_as_float(uw.x & 0xffff0000u) * bias);
            float o2 = __uint_as_float(xw.y << 16) * (acc[nt][2] + __uint_as_float(uw.y << 16) * bias);
            float o3 = __uint_as_float(xw.y & 0xffff0000u) * (acc[nt][3] + __uint_as_float(uw.y & 0xffff0000u) * bias);
            uint2 w;
            w.x = (unsigned)f2bf(o0) | ((unsigned)f2bf(o1) << 16);
            w.y = (unsigned)f2bf(o2) | ((unsigned)f2bf(o3) << 16);
            if (order == 0) *(uint2*)(zbuf + bt * UBL + 256 + t4) = w;
            else *(uint2*)(YT + sbase + bt * L + t4) = w;
        }
        __syncthreads();
    }
}

__device__ __forceinline__ void yt_transpose_unit(const KP& p, int tu, unsigned char* lds) {
    const int tok0 = tu * 64, tid = p.tid;
    bf16_t* tl = (bf16_t*)lds;
    const bf16_t* YT = wsp<bf16_t>(p, W_YT);
    __syncthreads();
#pragma unroll
    for (int i = 0; i < 4; i++) {
        const int idx = tid + i * 512, c = idx >> 3, part = idx & 7;
        const uint4 v = *(const uint4*)(YT + (size_t)c * T + tok0 + part * 8);
        const unsigned w[4] = {v.x, v.y, v.z, v.w};
#pragma unroll
        for (int e = 0; e < 8; e++) tl[(part * 8 + e) * 264 + c] = (bf16_t)((e & 1) ? (w[e >> 1] >> 16) : (w[e >> 1] & 0xffffu));
    }
    __syncthreads();
    bf16_t* O = wsp<bf16_t>(p, W_H);
#pragma unroll
    for (int i = 0; i < 4; i++) {
        const int idx = tid + i * 512, tk = idx >> 5, cp = idx & 31;
        *(uint4*)(O + (size_t)(tok0 + tk) * 1024 + 768 + cp * 8) = *(const uint4*)(tl + tk * 264 + cp * 8);
    }
}

constexpr size_t W_CTR = W_BAR + 14336;
__device__ __forceinline__ int queue_next(const KP& p, int ph, int nvb, unsigned char* lds) {
    volatile __attribute__((address_space(3))) unsigned* w = (volatile __attribute__((address_space(3))) unsigned*)(lds + 131072 + 8);
    __syncthreads();
    if (p.tid == 0) *w = (unsigned)nvb + __hip_atomic_fetch_add((unsigned*)(p.ws + W_CTR) + ph + 32 * p.pad, 1u, __ATOMIC_RELAXED, __HIP_MEMORY_SCOPE_AGENT);
    __syncthreads();
    return (int)*w;
}

__device__ __forceinline__ void mix_a_phase(const KP& p, int l, int vb, int nvb, unsigned char* lds) {
    for (int u = vb; u < 32 + 256 + 256 + 256 + 128 + 128 + 128 + 256; u = queue_next(p, 1 + 11 * l + 4, nvb, lds)) {
        int v = u, type, b = 0, x1 = 0, x2 = 0; bool lat = true;
        if (v < 32) { type = 0; x1 = v; }
        else if ((v -= 32) < 256) { type = 1; lat = true; b = v >> 6; x1 = (v >> 4) & 3; x2 = v & 15; }
        else if ((v -= 256) < 256) { type = 3; x1 = v; }
        else if ((v -= 256) < 256) { type = 2; lat = true; b = v >> 6; x1 = (v >> 4) & 3; x2 = v & 15; }
        else if ((v -= 256) < 128) { type = 0; x1 = 32 + v; }
        else if ((v -= 128) < 128) { type = 1; lat = false; b = v >> 3; x1 = (v >> 1) & 3; x2 = v & 1; }
        else if ((v -= 128) < 128) { type = 2; lat = false; b = v >> 3; x1 = (v >> 1) & 3; x2 = v & 1; }
        else { v -= 128; type = 4; x1 = v; }
        KP q = p;
        asm volatile("" : "+v"(q.tid));
        if (type == 0) gdn_g2_unit(q, l, x1, lds);
        else if (type == 1) attn_unit<0>(q, l, lat, b, x1, x2, lds);
        else if (type == 2) attn_unit<1>(q, l, lat, b, x1, x2, lds);
        else if (type == 3) hyena_mfma_unit<2048, 4>(q, l, x1, lds);
        else hyena_mfma_unit<256, 16>(q, l, x1, lds);
    }
}

__device__ __forceinline__ void mix_b_phase(const KP& p, int l, int vb, int nvb, unsigned char* lds) {
    const int wid = p.tid >> 6, lane = p.tid & 63;
    for (int u = vb; u < 192 + 1536; u += nvb) {
        if (u < 192) { yt_transpose_unit(p, u, lds); continue; }
        const size_t tok = (size_t)(u - 192) * 8 + wid;
        const bf16_t* OF = wsp<bf16_t>(p, W_OF); const bf16_t* OB = wsp<bf16_t>(p, W_OB);
        const bf16_t* GZ = wsp<bf16_t>(p, W_GZ);
        bf16_t* O = wsp<bf16_t>(p, W_H);
#pragma unroll
        for (int h = 0; h < 4; h++) {
            float o = bf2f(OF[tok * 256 + h * 64 + lane]) + bf2f(OB[tok * 256 + h * 64 + lane]);
            float ss = wave_sum(o * o);
            float r = rsqrtf(ss * (1.f / 64.f) + EPSV);
            float gz = bf2f(GZ[tok * 256 + h * 64 + lane]);
            O[tok * 1024 + 512 + h * 64 + lane] = f2bf(o * r * pin(p, I_GNORM)[l * 64 + lane] * siluf(gz));
        }
    }
}

__device__ __forceinline__ void tr_job(const KP& p, int l, int r, unsigned char* lds) {
    if (r < 768) tr_unit(pin(p, I_WIN) + (size_t)l * D * INC, wsp<bf16_t>(p, W_WIN) + (size_t)l * INCP * D, D, INC, INCP, r / 48, r % 48, (float*)lds, p.tid);
    else if (r < 1024) { r -= 768; tr_unit(pin(p, I_WOUT) + (size_t)l * D * D, wsp<bf16_t>(p, W_WOUT) + (size_t)l * D * D, D, D, D, r / 16, r % 16, (float*)lds, p.tid); }
    else if (r < 2048) { r -= 1024; tr_unit(pin(p, I_W1) + (size_t)l * D * DFF, wsp<bf16_t>(p, W_W1) + (size_t)l * DFF * D, D, DFF, DFF, r / 64, r % 64, (float*)lds, p.tid); }
    else if (r < 3072) { r -= 2048; tr_unit(pin(p, I_W2) + (size_t)l * DFF * D, wsp<bf16_t>(p, W_W2) + (size_t)l * D * DFF, DFF, D, D, r / 16, r % 16, (float*)lds, p.tid); }
    else { r -= 3072; tr_unit(pin(p, I_WUKV) + (size_t)l * 128 * 512, wsp<bf16_t>(p, W_WUKV) + (size_t)l * 512 * 128, 128, 512, 512, r / 8, r % 8, (float*)lds, p.tid); }
}
struct TrDesc { const float* src; bf16_t* dst; int K, N, Npad, kt, nt; };
__device__ __forceinline__ TrDesc tr_desc(const KP& p, int l, int r) {
    TrDesc d;
    if (r < 768) { d.src = pin(p, I_WIN) + (size_t)l * D * INC; d.dst = wsp<bf16_t>(p, W_WIN) + (size_t)l * INCP * D; d.K = D; d.N = INC; d.Npad = INCP; d.kt = r / 48; d.nt = r % 48; }
    else if (r < 1024) { r -= 768; d.src = pin(p, I_WOUT) + (size_t)l * D * D; d.dst = wsp<bf16_t>(p, W_WOUT) + (size_t)l * D * D; d.K = D; d.N = D; d.Npad = D; d.kt = r / 16; d.nt = r % 16; }
    else if (r < 2048) { r -= 1024; d.src = pin(p, I_W1) + (size_t)l * D * DFF; d.dst = wsp<bf16_t>(p, W_W1) + (size_t)l * DFF * D; d.K = D; d.N = DFF; d.Npad = DFF; d.kt = r / 64; d.nt = r % 64; }
    else { r -= 2048; d.src = pin(p, I_W2) + (size_t)l * DFF * D; d.dst = wsp<bf16_t>(p, W_W2) + (size_t)l * D * DFF; d.K = DFF; d.N = D; d.Npad = D; d.kt = r / 16; d.nt = r % 16; }
    return d;
}
__device__ __forceinline__ void tr_filler(const KP& p, int l, int jlo, int jhi, int first, int vb, int nvb, unsigned char* lds) {
    if (vb < first) return;
    const int tid = p.tid, stride = nvb - first;
    float* tl = (float*)lds;
    for (int j = jlo + (vb - first); j < jhi; j += 4 * stride) {
        f32x4 v[4][2];
        TrDesc d[4];
#pragma unroll
        for (int q = 0; q < 4; q++) {
            const int jq = (j + q * stride < jhi) ? j + q * stride : j;
            d[q] = tr_desc(p, l, jq);
#pragma unroll
            for (int i = 0; i < 2; i++) {
                const int c = tid + i * 512, k = c >> 4, n = d[q].nt * 64 + (c & 15) * 4;
                v[q][i] = (n < d[q].N) ? *(const f32x4*)(d[q].src + (size_t)(d[q].kt * 64 + k) * d[q].N + n) : (f32x4){0.f, 0.f, 0.f, 0.f};
            }
        }
        __syncthreads();
#pragma unroll
        for (int q = 0; q < 4; q++)
#pragma unroll
            for (int i = 0; i < 2; i++) {
                const int c = tid + i * 512, k = c >> 4, n4 = (c & 15) * 4;
                float* t = tl + q * 64 * 65 + k * 65 + n4;
                t[0] = v[q][i][0]; t[1] = v[q][i][1]; t[2] = v[q][i][2]; t[3] = v[q][i][3];
            }
        __syncthreads();
#pragma unroll
        for (int q = 0; q < 4; q++) {
            const int n = tid >> 3, k8 = (tid & 7) * 8, gn = d[q].nt * 64 + n;
            float f[8];
#pragma unroll
            for (int e = 0; e < 8; e++) f[e] = tl[q * 64 * 65 + (k8 + e) * 65 + n];
            if (gn < d[q].Npad) *(uint4*)(d[q].dst + (size_t)gn * d[q].K + d[q].kt * 64 + k8) = pack8(f);
        }
    }
    __syncthreads();
}

__device__ __forceinline__ void phase_a(const KP& p, int vb, int nvb, unsigned char* lds) {
    for (int u = vb; u < 192 + 768 + 32 + 576 + 416 + 192; u += nvb) {
        int v = u;
        if (v < 192) { ada_unit(p, v, (float*)lds); continue; }
        v -= 192;
        if (v < 768) { tr_job(p, 0, v, lds); continue; }
        v -= 768;
        if (v < 32) { tr_job(p, v >> 4, 3072 + (v & 15), lds); continue; }
        v -= 32;
        if (v < 576) { filt_unit(p, v, (float*)lds); continue; }
        v -= 576;
        if (v < 416) { cachecvt_unit(p, v); continue; }
        v -= 416;
        rope_unit(p, v);
    }
}

constexpr int NPH = 23;
__device__ __forceinline__ void run_phase(const KP& p, int ph, int vb, int nvb, unsigned char* lds) {
    if (ph == 0) { phase_a(p, vb, nvb, lds); return; }
    const int l = (ph - 1) / 11, s = (ph - 1) % 11;
    const float* MODl = nullptr; (void)MODl;
    switch (s) {
    case 0:
        if (l == 0) resnorm_phase(p, pin(p, I_XP), pin(p, I_XS), nullptr, nullptr, 0, 0, pin(p, I_GPREMIX), 1024, 0, 0, vb, nvb);
        break;
    case 1:
        gemm8_phase(wsp<bf16_t>(p, W_H), wsp<bf16_t>(p, W_WIN) + (size_t)l * INCP * D, T, INCP, D, pg8::EpiBf16<0>{wsp<bf16_t>(p, W_PROJ), INC, INC}, lds, vb, nvb, p.tid);
        if (l == 0) tr_filler(p, 0, 768, 3072, 64, vb, nvb, lds);
        break;
    case 2:
        prep_phase(p, l, vb, nvb);
        for (int u = vb; u < T / 32; u += nvb) hyprep_unit(p, l, u);
        break;
    case 3:
        for (int u = vb; u < 384; u += nvb) { KP q = p; asm volatile("" : "+v"(q.tid)); gdn_g1_unit(q, l, u, lds); }
        for (int u = (vb + 128) % nvb; u < 224; u += nvb) { KP q = p; asm volatile("" : "+v"(q.tid));
            if (u < 192) gemm_tile<EPI_BF16>(wsp<bf16_t>(p, W_CKVN), 128, wsp<bf16_t>(p, W_WUKV) + (size_t)l * 512 * 128, 128, 128, (u % 48) * 256, (u / 48) * 128, 512, wsp<bf16_t>(p, W_KVX), 512, lds, q.tid);
            else { const int tt = u - 192; gemm_tile<EPI_BF16>(wsp<bf16_t>(p, W_CKVC) + (size_t)l * 2048 * 128, 128, wsp<bf16_t>(p, W_WUKV) + (size_t)l * 512 * 128, 128, 128, (tt & 7) * 256, (tt >> 3) * 128, 512,
                                wsp<bf16_t>(p, W_KVC) + (size_t)l * 2048 * 512, 512, lds, q.tid); } }
        break;
    case 4: mix_a_phase(p, l, vb, nvb, lds); break;
    case 5: mix_b_phase(p, l, vb, nvb, lds); break;
    case 6:
        gemm8_phase(wsp<bf16_t>(p, W_H), wsp<bf16_t>(p, W_WOUT) + (size_t)l * D * D, T, D, D, pg8::EpiBf16<0>{wsp<bf16_t>(p, W_OP), D, D}, lds, vb, nvb, p.tid);
        if (l == 0) tr_filler(p, 1, 0, 640, 192, vb, nvb, lds);
        break;
    case 7: resnorm_phase(p, nullptr, nullptr, wsp<bf16_t>(p, W_OP), pin(p, I_GPOSTMIX) + l * D, 2048, l, pin(p, I_GPREMLP) + l * D, 4096, 3072, l, vb, nvb); break;
    case 8: gemm8_phase(wsp<bf16_t>(p, W_H), wsp<bf16_t>(p, W_W1) + (size_t)l * DFF * D, T, DFF, D, pg8::EpiBf16<1>{wsp<bf16_t>(p, W_HID), DFF, DFF}, lds, vb, nvb, p.tid); break;
    case 9:
        gemm8_phase(wsp<bf16_t>(p, W_HID), wsp<bf16_t>(p, W_W2) + (size_t)l * D * DFF, T, D, DFF, pg8::EpiBf16<0>{wsp<bf16_t>(p, W_M), D, D}, lds, vb, nvb, p.tid);
        if (l == 0) tr_filler(p, 1, 640, 3072, 192, vb, nvb, lds);
        break;
    case 10:
        if (l == 0) resnorm_phase(p, nullptr, nullptr, wsp<bf16_t>(p, W_M), pin(p, I_GPOSTMLP) + l * D, 5120, l, pin(p, I_GPREMIX) + (l + 1) * D, 1024, 0, l + 1, vb, nvb);
        else resnorm_phase(p, nullptr, nullptr, wsp<bf16_t>(p, W_M), pin(p, I_GPOSTMLP) + l * D, 5120, l, nullptr, 0, 0, 0, vb, nvb);
        break;
    }
}


#define XB_TMO      128
#define XB_XCNT(j)  (256  + 64 * (j))
#define XB_XSUB(j)  (1280 + 64 * (j))
#define XB_XGEN(j)  (2304 + 64 * (j))
#define XB_TOP      3328
#define XB_TOPGEN   3392
#define XCD_BAR_WORDS 3456
#define XB_SPIN_CAP (1u << 20)
#define LAS3 __attribute__((address_space(3)))
__device__ __forceinline__ unsigned xb_ld(unsigned* p) { return __hip_atomic_load(p, __ATOMIC_RELAXED, __HIP_MEMORY_SCOPE_AGENT); }
__device__ __forceinline__ unsigned xb_add(unsigned* p, unsigned v) { return __hip_atomic_fetch_add(p, v, __ATOMIC_RELAXED, __HIP_MEMORY_SCOPE_AGENT); }
__device__ __forceinline__ unsigned xb_xcc_id() { return (unsigned)__builtin_amdgcn_s_getreg((3 << 11) | 20) & 0xFu; }
#define XB_SPIN(cond, bar) do { unsigned _sp = 0; while (cond) { __builtin_amdgcn_s_sleep(1); \
    if ((++_sp & 255u) == 0u) { if (xb_ld(&(bar)[XB_TMO])) break; if (_sp > XB_SPIN_CAP) { atomicAdd(&(bar)[XB_TMO], 1u); break; } } } } while (0)
struct XcdBarrier { unsigned* bar; unsigned x; volatile LAS3 unsigned* st; };
__device__ __forceinline__ XcdBarrier xcd_barrier_post(unsigned* bar, volatile LAS3 unsigned* st) {
    XcdBarrier b; b.bar = bar; b.x = xb_xcc_id(); b.st = st;
    if (threadIdx.x == 0) (void)xb_add(&bar[XB_XCNT(b.x)], 1u);
    return b;
}
__device__ __forceinline__ void xcd_barrier_complete(unsigned* bar, unsigned x, unsigned& nloc, unsigned& nx) {
    const unsigned G = gridDim.x * gridDim.y * gridDim.z;
    unsigned sum, cnt, mine, sp = 0u;
    for (;;) {
        sum = 0u; cnt = 0u; mine = 0u;
#pragma unroll
        for (unsigned j = 0; j < 16; ++j) { const unsigned c = xb_ld(&bar[XB_XCNT(j)]); sum += c; cnt += (c > 0u) ? 1u : 0u; mine = (j == x) ? c : mine; }
        if (sum == G) break;
        __builtin_amdgcn_s_sleep(1);
        if ((++sp & 255u) == 0u) { if (xb_ld(&bar[XB_TMO])) break; if (sp > XB_SPIN_CAP) { atomicAdd(&bar[XB_TMO], 1u); break; } }
    }
    nloc = mine > 0u ? mine : 1u; nx = cnt > 0u ? cnt : 1u;
}
__device__ __forceinline__ void xcd_barrier(const XcdBarrier& b) {
    asm volatile("s_waitcnt vmcnt(0)" ::: "memory");
    __syncthreads();
    if (threadIdx.x == 0) {
        unsigned* bar = b.bar;
        __builtin_amdgcn_s_waitcnt(0);
        unsigned nloc = b.st[0], nx = b.st[1];
        if (nloc == 0u) { xcd_barrier_complete(bar, b.x, nloc, nx); b.st[0] = nloc; b.st[1] = nx; }
        const unsigned old = xb_add(&bar[XB_XSUB(b.x)], 1u);
        const unsigned gen = old / nloc;
        if (old + 1u == (gen + 1u) * nloc) {
            __builtin_amdgcn_fence(__ATOMIC_RELEASE, "agent");
            asm volatile("s_waitcnt vmcnt(0)" ::: "memory");
            const unsigned og = xb_add(&bar[XB_TOP], 1u);
            const unsigned tg = og / nx;
            if (og + 1u == (tg + 1u) * nx) xb_add(&bar[XB_TOPGEN], 1u);
            else XB_SPIN(xb_ld(&bar[XB_TOPGEN]) == tg, bar);
            __builtin_amdgcn_fence(__ATOMIC_ACQUIRE, "agent");
            xb_add(&bar[XB_XGEN(b.x)], 1u);
            asm volatile("s_waitcnt vmcnt(0)" ::: "memory");
        } else {
            XB_SPIN(xb_ld(&bar[XB_XGEN(b.x)]) == gen, bar);
            __builtin_amdgcn_fence(__ATOMIC_ACQUIRE, "agent");
            asm volatile("s_waitcnt vmcnt(0)" ::: "memory");
        }
    }
    __syncthreads();
}

__global__ void __launch_bounds__(NT) trunk_kernel(KP p) {
    __shared__ __attribute__((aligned(16))) unsigned char lds[131072 + 16];
    cg::grid_group grid = cg::this_grid();
    volatile LAS3 unsigned* st = (volatile LAS3 unsigned*)(lds + 131072);
    if (threadIdx.x == 0) { st[0] = 0u; st[1] = 0u; st[2] = 0u; st[3] = 0u; }
    __syncthreads();
    XcdBarrier xb = xcd_barrier_post((unsigned*)(p.ws + W_BAR), st);
#ifdef PROBE_REPEAT
    int rep = 0;
    for (int ph = p.ph_lo; ph < p.ph_hi; ph++) {
        KP q = p;
        q.tid = threadIdx.x;
        q.pad = rep;
        asm volatile("" : "+v"(q.tid));
        asm volatile("" : "+s"(q.ws), "+s"(q.out));
        q.zoff = 0; asm volatile("" : "+s"(q.zoff));
        int vbq = blockIdx.x, nvbq = gridDim.x; asm volatile("" : "+s"(vbq), "+s"(nvbq));
        run_phase(q, ph, vbq, nvbq, lds);
        if (ph + 1 < p.ph_hi) xcd_barrier(xb);
        if (PROBE_REPEAT(ph) && !rep) { rep = 1; ph--; } else rep = 0;
    }
#else
#pragma unroll
    for (int ph = 0; ph < NPH; ph++) {
        KP q = p;
        q.tid = threadIdx.x;
        asm volatile("" : "+v"(q.tid));
        asm volatile("" : "+s"(q.ws), "+s"(q.out));
        q.zoff = 0; asm volatile("" : "+s"(q.zoff));
        int vbq = blockIdx.x, nvbq = gridDim.x; asm volatile("" : "+s"(vbq), "+s"(nvbq));
        run_phase(q, ph, vbq, nvbq, lds);
        if (ph + 1 < NPH) {
            int hh = q.ph_hi; asm volatile("" : "+s"(hh));
            if (hh > 4096) grid.sync();
            else xcd_barrier(xb);
        }
    }
#endif
}

extern "C" void kernel_launch(void* const* d_in, const int* in_sizes, int n_in, void* d_out, int out_size, void* d_ws, size_t ws_size, hipStream_t stream) {
    static int grid_blocks = 0;
    if (!grid_blocks) {
        int dev = 0, cus = 0, per_cu = 0;
        hipGetDevice(&dev);
        hipDeviceGetAttribute(&cus, hipDeviceAttributeMultiprocessorCount, dev);
        hipOccupancyMaxActiveBlocksPerMultiprocessor(&per_cu, trunk_kernel, NT, 0);
        if (per_cu < 1) per_cu = 1;
        if (per_cu > 1) per_cu = 1;
        grid_blocks = cus * per_cu;
    }
    KP p{};
    for (int i = 0; i < N_IN; i++) p.in[i] = (const float*)d_in[i];
    p.out = (float*)d_out;
    p.ws = (unsigned char*)d_ws;
    p.ph_lo = 0; p.ph_hi = NPH;
    (void)hipMemsetAsync((unsigned char*)d_ws + W_BAR, 0, 16384, stream);
    void* args[] = {&p};
    hipError_t e = hipLaunchCooperativeKernel((void*)trunk_kernel, dim3(grid_blocks), dim3(NT), args, 0, stream);
    if (e != hipSuccess) fprintf(stderr, "cooperative launch failed: %s (grid %d)\n", hipGetErrorString(e), grid_blocks);
}
```

```cpp
#include <hip/hip_runtime.h>
#include <hip/hip_cooperative_groups.h>
#include <cstdio>
#include <cstdint>
namespace cg = cooperative_groups;

typedef unsigned short bf16_t;
typedef short bf16x8 __attribute__((ext_vector_type(8)));
typedef float f32x4 __attribute__((ext_vector_type(4)));

#define NT 512
#define EPSV 1e-6f

constexpr int D = 1024, TC = 4096, TL = 8192, T = TC + TL, INC = 2864, INCP = 3072, DFF = 4096;
enum { I_XP = 0, I_XS, I_CCKV, I_CKPE, I_CSK, I_CSV, I_STATE, I_C, I_CCTX, I_WADA, I_BADA, I_GPREMIX, I_GPOSTMIX, I_GPREMLP, I_GPOSTMLP,
       I_WIN, I_WOUT, I_KVNORM, I_WUKV, I_SINK, I_GCONV, I_GALOG, I_GDT, I_GNORM, I_HCONV, I_HW1, I_HB1, I_HW2, I_HB2, I_HW3, I_HFREQ,
       I_HDECAY, I_HBIAS, I_W1, I_W2, N_IN };
constexpr int C_MQ = 0, C_CKV = 384, C_KPE = 512, C_SQ = 544, C_SK = 800, C_SV = 928, C_GQKV = 1056, C_GZ = 1824, C_GA = 2080, C_GB = 2088, C_HU = 2096;
constexpr size_t O_YP = 0, O_YS = (size_t)TC * D, O_CKV = (size_t)T * D, O_KPE = O_CKV + 16 * 2 * 256 * 128, O_SK = O_KPE + 16 * 2 * 256 * 32,
                 O_SV = O_SK + 16 * 2 * 256 * 128, O_ST = O_SV + 16 * 2 * 256 * 128;

constexpr size_t al(size_t x) { return (x + 255) & ~(size_t)255; }
constexpr size_t W_WIN = 0;
constexpr size_t W_WOUT = W_WIN + al((size_t)2 * INCP * D * 2);
constexpr size_t W_W1 = W_WOUT + al((size_t)2 * D * D * 2);
constexpr size_t W_W2 = W_W1 + al((size_t)2 * DFF * D * 2);
constexpr size_t W_WUKV = W_W2 + al((size_t)2 * DFF * D * 2);
constexpr size_t W_CKVC = W_WUKV + al((size_t)2 * 512 * 128 * 2);
constexpr size_t W_KVC = W_CKVC + al((size_t)2 * 2048 * 128 * 2);
constexpr size_t W_KPEC = W_KVC + al((size_t)2 * 2048 * 512 * 2);
constexpr size_t W_KSWC = W_KPEC + al((size_t)2 * 2048 * 32 * 2);
constexpr size_t W_VSWC = W_KSWC + al((size_t)2 * 2048 * 128 * 2);
constexpr size_t W_MODP = W_VSWC + al((size_t)2 * 2048 * 128 * 2);
constexpr size_t W_MOD = W_MODP + al((size_t)16 * 2 * 5 * 6144 * 4);
constexpr size_t W_FILT = W_MOD + al((size_t)2 * 5 * 6144 * 4);
constexpr size_t W_ROPEA = W_FILT + al((size_t)2 * 2304 * 512 * 4);
constexpr size_t W_ROPEB = W_ROPEA + al((size_t)2048 * 16 * 2 * 4);
constexpr size_t W_BAR = W_ROPEB + al((size_t)2048 * 32 * 2 * 4);
constexpr size_t W_H = W_BAR + al(16384);
constexpr size_t W_BIG = W_H + al((size_t)T * D * 2);
constexpr size_t W_PROJ = W_BIG;
constexpr size_t W_CKVN = W_PROJ + al((size_t)T * INC * 2);
constexpr size_t W_KPE = W_CKVN + al((size_t)T * 128 * 2);
constexpr size_t W_QMLA = W_KPE + al((size_t)T * 32 * 2);
constexpr size_t W_QSWA = W_QMLA + al((size_t)T * 384 * 2);
constexpr size_t W_KSWA = W_QSWA + al((size_t)T * 256 * 2);
constexpr size_t W_VSWA = W_KSWA + al((size_t)T * 128 * 2);
constexpr size_t W_GQ = W_VSWA + al((size_t)T * 128 * 2);
constexpr size_t W_GK = W_GQ + al((size_t)T * 256 * 2);
constexpr size_t W_GV = W_GK + al((size_t)T * 256 * 2);
constexpr size_t W_GZ = W_GV + al((size_t)T * 256 * 2);
constexpr size_t W_GG = W_GZ + al((size_t)T * 256 * 2);
constexpr size_t W_GBETA = W_GG + al((size_t)T * 8 * 4);
constexpr size_t W_HV = W_GBETA + al((size_t)T * 8 * 4);
constexpr size_t W_HX1 = W_HV + al((size_t)T * 256 * 2);
constexpr size_t W_HX2 = W_HX1 + al((size_t)T * 256 * 2);
constexpr size_t W_GAQK = W_HX2 + al((size_t)T * 256 * 2);
constexpr size_t W_GKTT = W_GAQK + al((size_t)1536 * 4096 * 2);
constexpr size_t W_GEDEC = W_GKTT + al((size_t)1536 * 4096 * 2);
constexpr size_t W_GTAIL = W_GEDEC + al((size_t)1536 * 64 * 4);
constexpr size_t W_MIX_END = W_GTAIL + al((size_t)1536 * 4);
constexpr size_t W_KVX = W_PROJ;
constexpr size_t W_OF = W_KVX + al((size_t)T * 512 * 2);
constexpr size_t W_OB = W_OF + al((size_t)T * 256 * 2);
constexpr size_t W_YT = W_OB + al((size_t)T * 256 * 2);
constexpr size_t W_GUV = W_YT + al((size_t)T * 256 * 2);
constexpr size_t W_GW = W_GUV + al((size_t)1536 * 4096 * 2);
constexpr size_t W_OVL_END = W_GW + al((size_t)1536 * 4096 * 2);
static_assert(W_OVL_END <= W_CKVN, "overlay overflow");
constexpr size_t W_OP = W_PROJ;
static_assert(W_OP + (size_t)T * D * 4 <= W_CKVN, "OP overflow");
constexpr size_t W_HID = W_BIG;
constexpr size_t W_M = W_HID + al((size_t)T * DFF * 2);
constexpr size_t W_END = (W_M + (size_t)T * D * 4) > W_MIX_END ? (W_M + (size_t)T * D * 4) : W_MIX_END;
static_assert(W_END <= (size_t)256 * 1024 * 1024, "workspace overflow");

struct KP {
    const float* in[N_IN];
    float* out;
    unsigned char* ws;
    int ph_lo, ph_hi;
    int tid, pad;
    int zoff; float zf;
};

__device__ __forceinline__ const float* pin(const KP& p, int i) {
    const char* kp = (const char*)__builtin_amdgcn_kernarg_segment_ptr();
    return *(const float* const*)(kp + i * 8 + p.zoff);
}
__device__ __forceinline__ float bf2f(bf16_t v) { return __uint_as_float(((unsigned)v) << 16); }
__device__ __forceinline__ bf16_t f2bf(float f) {
    unsigned u = __float_as_uint(f);
    u += 0x7fffu + ((u >> 16) & 1u);
    return (bf16_t)(u >> 16);
}
__device__ __forceinline__ float wave_sum(float v) {
#pragma unroll
    for (int o = 32; o > 0; o >>= 1) v += __shfl_xor(v, o);
    return v;
}
__device__ __forceinline__ float siluf(float x) { return x / (1.f + __expf(-x)); }
__device__ __forceinline__ void unpack8(uint4 w, float* o) {
    o[0] = __uint_as_float(w.x << 16); o[1] = __uint_as_float(w.x & 0xffff0000u);
    o[2] = __uint_as_float(w.y << 16); o[3] = __uint_as_float(w.y & 0xffff0000u);
    o[4] = __uint_as_float(w.z << 16); o[5] = __uint_as_float(w.z & 0xffff0000u);
    o[6] = __uint_as_float(w.w << 16); o[7] = __uint_as_float(w.w & 0xffff0000u);
}
__device__ __forceinline__ int cond_row(int tok) { return tok < TC ? 0 : 1 + ((tok - TC) >> 11); }

template <class TT> __device__ __forceinline__ TT* wsp(const KP& p, size_t off) { return (TT*)(p.ws + off); }

__device__ __forceinline__ void tr_unit(const float* __restrict__ src, bf16_t* __restrict__ dst, int K, int N, int Npad, int kt, int nt, float* lds, int tid_) {
    const int tid = tid_;
#pragma unroll
    for (int i = 0; i < 2; i++) {
        const int c = tid + i * 512, k = c >> 4, n4 = (c & 15) * 4, n = nt * 64 + n4;
        f32x4 v = (f32x4){0.f, 0.f, 0.f, 0.f};
        if (n < N) v = *(const f32x4*)(src + (size_t)(kt * 64 + k) * N + n);
        lds[k * 65 + n4] = v[0]; lds[k * 65 + n4 + 1] = v[1]; lds[k * 65 + n4 + 2] = v[2]; lds[k * 65 + n4 + 3] = v[3];
    }
    __syncthreads();
    {
        const int n = tid >> 3, k8 = (tid & 7) * 8, gn = nt * 64 + n;
        float f[8];
#pragma unroll
        for (int e = 0; e < 8; e++) f[e] = lds[(k8 + e) * 65 + n];
        uint4 w;
        w.x = (unsigned)f2bf(f[0]) | ((unsigned)f2bf(f[1]) << 16); w.y = (unsigned)f2bf(f[2]) | ((unsigned)f2bf(f[3]) << 16);
        w.z = (unsigned)f2bf(f[4]) | ((unsigned)f2bf(f[5]) << 16); w.w = (unsigned)f2bf(f[6]) | ((unsigned)f2bf(f[7]) << 16);
        if (gn < Npad) *(uint4*)(dst + (size_t)gn * K + kt * 64 + k8) = w;
    }
    __syncthreads();
}

__device__ __forceinline__ void ada_unit(const KP& p, int u  , float* lds) {
    const int l = u / 96, e0 = (u % 96) * 64, tid = p.tid, col = tid & 63, ds = tid >> 6;
    float* sc = lds;
    float* red = lds + 5120;
    __syncthreads();
    for (int i = tid; i < 5120; i += NT) {
        const int r = i >> 10, d = i & 1023;
        const float x = (r == 0) ? pin(p, I_CCTX)[d] : pin(p, I_C)[(r - 1) * 1024 + d];
        sc[i] = x / (1.f + __expf(-x));
    }
    __syncthreads();
    float a0 = 0, a1 = 0, a2 = 0, a3 = 0, a4 = 0;
    const float* w = pin(p, I_WADA) + ((size_t)l * 1024 + ds * 128) * 6144 + e0 + col;
    const float* s = sc + ds * 128;
#pragma unroll 16
    for (int d = 0; d < 128; d++) {
        const float wv = w[(size_t)d * 6144];
        a0 += s[d] * wv; a1 += s[1024 + d] * wv; a2 += s[2048 + d] * wv; a3 += s[3072 + d] * wv; a4 += s[4096 + d] * wv;
    }
    red[(ds * 5 + 0) * 64 + col] = a0; red[(ds * 5 + 1) * 64 + col] = a1; red[(ds * 5 + 2) * 64 + col] = a2; red[(ds * 5 + 3) * 64 + col] = a3; red[(ds * 5 + 4) * 64 + col] = a4;
    __syncthreads();
    if (tid < 320) {
        const int r = tid >> 6;
        float t = pin(p, I_BADA)[l * 6144 + e0 + col];
#pragma unroll
        for (int k = 0; k < 8; k++) t += red[(k * 5 + r) * 64 + col];
        wsp<float>(p, W_MOD)[(size_t)(l * 5 + r) * 6144 + e0 + col] = t;
    }
    __syncthreads();
}

__device__ __forceinline__ void filt_unit(const KP& p, int u, float* lds) {
    const int l = u / 288, tg = u % 288, wid = p.tid >> 6, lane = p.tid & 63;
    const int tglob = tg * 8 + wid;
    int L, j;
    if (tglob < 256) { L = 256; j = tglob; } else { L = 2048; j = tglob - 256; }
    float* h1 = lds + wid * 128;
    float* h2 = h1 + 64;
    const float tj = (float)j;
    const float t01 = tj / (float)(L - 1);
    const float w = 6.283185307179586f * tj / (float)L;
    const float* w1 = pin(p, I_HW1) + (size_t)l * 17 * 64;
    float s = t01 * w1[lane];
#pragma unroll
    for (int b = 0; b < 8; b++) {
        float band = 1e-4f + (float)b * ((7.0f - 1e-4f) / 7.0f);
        float a = w * band;
        s += __cosf(a) * w1[(1 + b) * 64 + lane];
        s += -__sinf(a) * w1[(9 + b) * 64 + lane];
    }
    s += pin(p, I_HB1)[l * 64 + lane];
    h1[lane] = __sinf(pin(p, I_HFREQ)[(l * 2 + 0) * 64 + lane] * s);
    __syncthreads();
    const float* w2 = pin(p, I_HW2) + (size_t)l * 64 * 64;
    float s2 = 0;
#pragma unroll 8
    for (int i = 0; i < 64; i++) s2 += h1[i] * w2[i * 64 + lane];
    s2 += pin(p, I_HB2)[l * 64 + lane];
    h2[lane] = __sinf(pin(p, I_HFREQ)[(l * 2 + 1) * 64 + lane] * s2);
    __syncthreads();
    const float* w3 = pin(p, I_HW3) + (size_t)l * 64 * 512;
    const float dist = fabsf(tj - (float)(L / 2)) / (float)(L / 2);
    float* stage = lds + 1024 + wid * 512;
#pragma unroll
    for (int m = 0; m < 8; m++) {
        int col = lane + 64 * m;
        float a = 0;
#pragma unroll 8
        for (int i = 0; i < 64; i++) a += h2[i] * w3[i * 512 + col];
        stage[col] = a * __expf(-dist * fabsf(pin(p, I_HDECAY)[l * 512 + col]));
    }
    __syncthreads();
    {
        const int col = p.tid;
        const int j0 = (tg < 32) ? tg * 8 : tg * 8 - 256;
        const int Lt = (tg < 32) ? 256 : 2048;
        bf16_t* ft = wsp<bf16_t>(p, W_FILT) + (size_t)l * 1179648 + (tg < 32 ? 0 : 131072) + (size_t)col * Lt + j0;
        unsigned w[4];
#pragma unroll
        for (int e = 0; e < 8; e += 2) w[e >> 1] = (unsigned)f2bf(lds[1024 + e * 512 + col]) | ((unsigned)f2bf(lds[1024 + (e + 1) * 512 + col]) << 16);
        *(uint4*)ft = make_uint4(w[0], w[1], w[2], w[3]);
    }
    __syncthreads();
}

__device__ __forceinline__ void cachecvt_unit(const KP& p, int u) {
    const float* src; bf16_t* dst; int Wd; int uu = u;
    if (uu < 128) { src = pin(p, I_CCKV); dst = wsp<bf16_t>(p, W_CKVC); Wd = 128; }
    else if (uu < 160) { uu -= 128; src = pin(p, I_CKPE); dst = wsp<bf16_t>(p, W_KPEC); Wd = 32; }
    else if (uu < 288) { uu -= 160; src = pin(p, I_CSK); dst = wsp<bf16_t>(p, W_KSWC); Wd = 128; }
    else { uu -= 288; src = pin(p, I_CSV); dst = wsp<bf16_t>(p, W_VSWC); Wd = 128; }
#pragma unroll
    for (int i = 0; i < 8; i++) {
        int idx = uu * 4096 + i * 512 + p.tid;
        int per_l = 2048 * Wd;
        int l = idx / per_l, r = idx % per_l, bs = r / Wd, d = r % Wd, b = bs >> 9, s = bs & 511;
        dst[idx] = f2bf(src[((size_t)(b * 2 + l) * 512 + s) * Wd + d]);
    }
}

__device__ __forceinline__ void rope_unit(const KP& p, int u) {
    int idx = u * 512 + p.tid;
    float* ra = wsp<float>(p, W_ROPEA);
    float* rb = wsp<float>(p, W_ROPEB);
    if (idx < 2048 * 16) {
        int t = idx >> 4, pp = idx & 15, row = t >> 6, col = t & 63;
        float inv = __builtin_amdgcn_exp2f(-(float)(pp & 7) * (13.287712379549449f / 8.f));
        float ang = (float)(pp < 8 ? row : col) * inv;
        ra[idx * 2] = __cosf(ang); ra[idx * 2 + 1] = __sinf(ang);
    } else {
        int i2 = idx - 2048 * 16;
        int t = i2 >> 5, pp = i2 & 31, row = t >> 6, col = t & 63;
        float inv = __builtin_amdgcn_exp2f(-(float)(pp & 15) * (13.287712379549449f / 16.f));
        float ang = (float)(pp < 16 ? row : col) * inv;
        rb[i2 * 2] = __cosf(ang); rb[i2 * 2 + 1] = __sinf(ang);
    }
}

enum { EPI_BF16 = 0, EPI_F32 = 1, EPI_RELU2 = 2 };
template <int EPI>
__device__ __forceinline__ void gemm_tile(const bf16_t* __restrict__ A, int lda, const bf16_t* __restrict__ Bt, int ldb, int K, int m0, int n0, int N,
                          void* Cout, int ldc, unsigned char* lds, int tid_) {
    const int tid = tid_, wid = tid >> 6, lane = tid & 63, wr = wid >> 1, wc = wid & 1, fr = lane & 15, fq = lane >> 4;
    unsigned char* As = lds;
    unsigned char* Bs = lds + 256 * 144;
    f32x4 acc[4][4];
#pragma unroll
    for (int m = 0; m < 4; m++)
#pragma unroll
        for (int n = 0; n < 4; n++) acc[m][n] = (f32x4){0.f, 0.f, 0.f, 0.f};
    const int nk = K / 64;
    const int lr = tid >> 3, lkc = tid & 7;
    const bf16_t* ga = A + (size_t)(m0 + lr) * lda + lkc * 8;
    const bf16_t* gb = Bt + (size_t)(n0 + lr) * ldb + lkc * 8;
    uint4 ra0, ra1, ra2, ra3, rb0, rb1;
#define GLOAD(kt_) do { \
    ra0 = *(const uint4*)(ga + (kt_) * 64); ra1 = *(const uint4*)(ga + (size_t)64 * lda + (kt_) * 64); \
    ra2 = *(const uint4*)(ga + (size_t)128 * lda + (kt_) * 64); ra3 = *(const uint4*)(ga + (size_t)192 * lda + (kt_) * 64); \
    rb0 = *(const uint4*)(gb + (kt_) * 64); rb1 = *(const uint4*)(gb + (size_t)64 * ldb + (kt_) * 64); } while (0)
    GLOAD(0);
    for (int kt = 0; kt < nk; kt++) {
        __syncthreads();
        *(uint4*)(As + lr * 144 + lkc * 16) = ra0; *(uint4*)(As + (lr + 64) * 144 + lkc * 16) = ra1;
        *(uint4*)(As + (lr + 128) * 144 + lkc * 16) = ra2; *(uint4*)(As + (lr + 192) * 144 + lkc * 16) = ra3;
        *(uint4*)(Bs + lr * 144 + lkc * 16) = rb0; *(uint4*)(Bs + (lr + 64) * 144 + lkc * 16) = rb1;
        __syncthreads();
        if (kt + 1 < nk) GLOAD(kt + 1);
#pragma unroll
        for (int ks = 0; ks < 2; ks++) {
            bf16x8 a[4], b[4];
#pragma unroll
            for (int m = 0; m < 4; m++) a[m] = *(const bf16x8*)(As + (wr * 64 + m * 16 + fr) * 144 + ks * 64 + fq * 16);
#pragma unroll
            for (int n = 0; n < 4; n++) b[n] = *(const bf16x8*)(Bs + (wc * 64 + n * 16 + fr) * 144 + ks * 64 + fq * 16);
#pragma unroll
            for (int m = 0; m < 4; m++)
#pragma unroll
                for (int n = 0; n < 4; n++) acc[m][n] = __builtin_amdgcn_mfma_f32_16x16x32_bf16(b[n], a[m], acc[m][n], 0, 0, 0);
        }
    }
#pragma unroll
    for (int m = 0; m < 4; m++) {
        const int row = m0 + wr * 64 + m * 16 + fr;
#pragma unroll
        for (int n = 0; n < 4; n++) {
            const int col = n0 + wc * 64 + n * 16 + fq * 4;
            if (col < N) {
                f32x4 v = acc[m][n];
                if (EPI == EPI_F32) {
                    *(f32x4*)((float*)Cout + (size_t)row * ldc + col) = v;
                } else {
                    if (EPI == EPI_RELU2) {
#pragma unroll
                        for (int j = 0; j < 4; j++) { float r = fmaxf(v[j], 0.f); v[j] = r * r; }
                    }
                    uint2 w;
                    w.x = (unsigned)f2bf(v[0]) | ((unsigned)f2bf(v[1]) << 16);
                    w.y = (unsigned)f2bf(v[2]) | ((unsigned)f2bf(v[3]) << 16);
                    *(uint2*)((bf16_t*)Cout + (size_t)row * ldc + col) = w;
                }
            }
        }
    }
    __syncthreads();
}

template <int EPI>
__device__ __forceinline__ void gemm_phase(const bf16_t* A, int lda, const bf16_t* Bt, int ldb, int K, int M, int N, void* C, int ldc, unsigned char* lds, int vb, int nvb, int tid_) {
    const int tm = M / 256, tn = (N + 127) / 128;
    for (int u = vb; u < tm * tn; u += nvb) {
        int pm = u % tm, pn = u / tm;
        gemm_tile<EPI>(A, lda, Bt, ldb, K, pm * 256, pn * 128, N, C, ldc, lds, tid_);
    }
}


namespace pg8 {
#define PG8_LAS __attribute__((address_space(3)))
typedef unsigned u32x4 __attribute__((ext_vector_type(4)));
constexpr int BM = 256, BK = 64, HALF = 128, HTB = HALF * BK * 2, STAGE_BYTES = 8 * HTB, NXCD = 8, WGM = 8;
__device__ __forceinline__ int lds_byte(int r, int c) { const int st = (r >> 4) * 2 + (c >> 5), rr = r & 15, cc = c & 31, ob = rr * 64 + cc * 2; return st * 1024 + (ob ^ (((ob >> 9) & 1) << 5)); }
__device__ __forceinline__ void stage_rc(int b, int& R, int& C) { const int st = b / 1024, sb = b % 1024, swz = sb ^ (((sb >> 9) & 1) << 5); R = (st >> 1) * 16 + swz / 64; C = (st & 1) * 32 + (swz % 64) / 2; }
__device__ __forceinline__ int perm32(int rho) { const int n = rho >> 4, i = rho & 15; return 8 * (i >> 2) + 4 * n + (i & 3); }
struct Unit { int pm, pn; };
struct Gemm { const bf16_t* A; const bf16_t* Bt; int M, N, K; };
struct StaticOrder {
    int nM, nN, nwg, G, c;
    __device__ void init(int M, int N, int G_, int c_) { nM = M / BM; nN = N / BM; nwg = nM * nN; G = G_; c = c_; }
    __device__ bool next(int i, Unit& u) const {
        const long L = (long)i * G + c; if (L >= nwg) return false;
        int wgid = (int)L; { const int q = nwg / NXCD, r = nwg % NXCD, xcd = wgid % NXCD, off = wgid / NXCD; wgid = (xcd < r ? xcd * (q + 1) : r * (q + 1) + (xcd - r) * q) + off; }
        const int nig = WGM * nN, gid = wgid / nig, fm = gid * WGM, gsz = (nM - fm) < WGM ? (nM - fm) : WGM;
        u.pm = fm + ((wgid % nig) % gsz); u.pn = (wgid % nig) / gsz; return true;
    }
};
__device__ __forceinline__ unsigned cvt_pk_bf16(float lo, float hi) { unsigned r; asm volatile("v_cvt_pk_bf16_f32 %0, %1, %2" : "=v"(r) : "v"(lo), "v"(hi)); return r; }
struct EpiF32 {
    static constexpr bool PERM = false;
    float* C; int ldc;
    __device__ __forceinline__ void operator()(const f32x4 (&acc)[2][2][4][2], const Unit& u, int wr, int wc, int fr, int fq) const {
        const int row0 = u.pm * BM + wr * 64 + fr, col0 = u.pn * BM + wc * 32 + 4 * fq;
#pragma unroll
        for (int ai = 0; ai < 2; ++ai)
#pragma unroll
            for (int m = 0; m < 4; ++m) { float* rowp = C + (size_t)(row0 + ai * HALF + m * 16) * ldc + col0;
#pragma unroll
                for (int bj = 0; bj < 2; ++bj)
#pragma unroll
                    for (int n = 0; n < 2; ++n) *(f32x4*)(rowp + bj * HALF + n * 16) = acc[ai][bj][m][n]; }
    }
};
template <int ACT  > struct EpiBf16 {
    static constexpr bool PERM = true;
    bf16_t* O; int ldc; int ncols;
    __device__ __forceinline__ void operator()(const f32x4 (&acc)[2][2][4][2], const Unit& u, int wr, int wc, int fr, int fq) const {
        const int row0 = u.pm * BM + wr * 64 + fr, col0 = u.pn * BM + wc * 32 + 8 * fq;
#pragma unroll
        for (int ai = 0; ai < 2; ++ai)
#pragma unroll
            for (int m = 0; m < 4; ++m) { bf16_t* rowp = O + (size_t)(row0 + ai * HALF + m * 16) * ldc + col0;
#pragma unroll
                for (int bj = 0; bj < 2; ++bj) { f32x4 v0 = acc[ai][bj][m][0], v1 = acc[ai][bj][m][1];
                    if (ACT == 1) {
#pragma unroll
                        for (int j = 0; j < 4; ++j) { const float a = fmaxf(v0[j], 0.f), b = fmaxf(v1[j], 0.f); v0[j] = a * a; v1[j] = b * b; } }
                    u32x4 w; w.x = cvt_pk_bf16(v0[0], v0[1]); w.y = cvt_pk_bf16(v0[2], v0[3]); w.z = cvt_pk_bf16(v1[0], v1[1]); w.w = cvt_pk_bf16(v1[2], v1[3]);
                    if (col0 + bj * HALF < ncols) *(u32x4*)(rowp + bj * HALF) = w; } }
    }
};

template <class Epi>
__device__ __forceinline__ void gemm_phase(PG8_LAS unsigned char* lds, const Gemm g, const StaticOrder& S, const Epi& E, const int tid) {
    const int wid = __builtin_amdgcn_readfirstlane(tid >> 6), lane = tid & 63, wr = wid >> 2, wc = wid & 3, fr = lane & 15, fq = lane >> 4;
    const int K = g.K, nt = K / BK;
    unsigned voffA[2], voffB[2];
#pragma unroll
    for (int i = 0; i < 2; ++i) { int R, C; stage_rc(tid * 16 + i * 8192, R, C); const int Rb = Epi::PERM ? ((R & ~31) + perm32(R & 31)) : R;
        voffA[i] = (unsigned)(R * K + C) * 2u; voffB[i] = (unsigned)(Rb * K + C) * 2u; }
    const size_t kstep = (size_t)(BK * 2);
    const size_t hstep = (size_t)HALF * K * 2;
    const size_t tstep = 2 * hstep;
    const unsigned ldsw = (unsigned)wid * 1024u;
    const int aoff = lds_byte(wr * 64 + fr, fq * 8), boff = lds_byte(wc * 32 + fr, fq * 8);
#define PG8_SA(b, h) (((b) * 2 + (h)) * HTB)
#define PG8_SB(b, h) ((4 + (b) * 2 + (h)) * HTB)
#define PG8_STAGE(bufoff, gbase, voff) do { _Pragma("unroll") for (int _i = 0; _i < 2; ++_i) \
        __builtin_amdgcn_global_load_lds((const unsigned*)((const char*)(gbase) + (voff)[_i]), (PG8_LAS unsigned*)(lds + (bufoff) + ldsw + _i * 8192), 16, 0, 0); } while (0)
#define PG8_LDA(dst, b, h) do { _Pragma("unroll") for (int m = 0; m < 4; ++m) _Pragma("unroll") for (int k = 0; k < 2; ++k) dst[m][k] = *(const PG8_LAS bf16x8*)(lds + PG8_SA(b, h) + aoff + m * 2048 + k * 1024); } while (0)
#define PG8_LDB(dst, b, h) do { _Pragma("unroll") for (int n = 0; n < 2; ++n) _Pragma("unroll") for (int k = 0; k < 2; ++k) dst[n][k] = *(const PG8_LAS bf16x8*)(lds + PG8_SB(b, h) + boff + n * 2048 + k * 1024); } while (0)
#define PG8_MMA(ai, bj, At, Bt) do { __builtin_amdgcn_s_setprio(1); _Pragma("unroll") for (int m = 0; m < 4; ++m) _Pragma("unroll") for (int n = 0; n < 2; ++n) _Pragma("unroll") for (int k = 0; k < 2; ++k) \
        acc[ai][bj][m][n] = __builtin_amdgcn_mfma_f32_16x16x32_bf16(Bt[n][k], At[m][k], acc[ai][bj][m][n], 0, 0, 0); __builtin_amdgcn_s_setprio(0); } while (0)
#define PG8_WAIT_V(n) asm volatile("s_waitcnt vmcnt(" #n ")" ::: "memory")
#define PG8_WAIT_L(n) asm volatile("s_waitcnt lgkmcnt(" #n ")" ::: "memory")
#define PG8_BAR __builtin_amdgcn_s_barrier()
#define PG8_SCHED __builtin_amdgcn_sched_barrier(0)
    Unit cur, nxt; int ui = 0;
    if (!S.next(0, cur)) return;
    f32x4 acc[2][2][4][2];
#pragma unroll
    for (int a = 0; a < 2; ++a)
#pragma unroll
        for (int b = 0; b < 2; ++b)
#pragma unroll
            for (int m = 0; m < 4; ++m)
#pragma unroll
                for (int n = 0; n < 2; ++n) acc[a][b][m][n] = (f32x4){0.f, 0.f, 0.f, 0.f};
    bf16x8 At[4][2], B0[2][2], B1[2][2];
    const char* cA = (const char*)g.A + (size_t)cur.pm * tstep; const char* cB = (const char*)g.Bt + (size_t)cur.pn * tstep;
    PG8_STAGE(PG8_SB(0, 0), cB, voffB); PG8_STAGE(PG8_SA(0, 0), cA, voffA); PG8_STAGE(PG8_SB(0, 1), cB + hstep, voffB); PG8_STAGE(PG8_SA(0, 1), cA + hstep, voffA);
    if (wr == 1) PG8_BAR;
    PG8_WAIT_V(4); PG8_BAR;
    PG8_STAGE(PG8_SB(1, 0), cB + kstep, voffB); PG8_STAGE(PG8_SA(1, 0), cA + kstep, voffA); PG8_STAGE(PG8_SB(1, 1), cB + hstep + kstep, voffB);
    PG8_WAIT_V(6); PG8_BAR;
    for (;;) {
        const bool has_next = S.next(ui + 1, nxt);
        const char* nA = has_next ? (const char*)g.A + (size_t)nxt.pm * tstep : cA; const char* nB = has_next ? (const char*)g.Bt + (size_t)nxt.pn * tstep : cB;
        for (int t = 0; t < nt; t += 2) {
            const bool last = (t == nt - 2);
            const char* a1 = cA + (size_t)(t + 1) * kstep;
            const char* a2 = last ? nA : cA + (size_t)(t + 2) * kstep; const char* b2 = last ? nB : cB + (size_t)(t + 2) * kstep;
            const char* a3 = a2 + kstep; const char* b3 = b2 + kstep;
            PG8_LDB(B0, 0, 0); PG8_SCHED; PG8_LDA(At, 0, 0); PG8_STAGE(PG8_SA(1, 1), a1 + hstep, voffA);
            PG8_WAIT_L(8); PG8_BAR; PG8_WAIT_L(0); PG8_MMA(0, 0, At, B0); PG8_BAR; PG8_SCHED;
            PG8_LDB(B1, 0, 1); PG8_STAGE(PG8_SB(0, 0), b2, voffB);
            PG8_BAR; PG8_WAIT_L(0); PG8_MMA(0, 1, At, B1); PG8_BAR;
            PG8_LDA(At, 0, 1); PG8_STAGE(PG8_SA(0, 0), a2, voffA);
            PG8_BAR; PG8_WAIT_L(0); PG8_MMA(1, 0, At, B0); PG8_BAR; PG8_SCHED;
            PG8_STAGE(PG8_SB(0, 1), b2 + hstep, voffB);
            PG8_WAIT_V(6); PG8_BAR; PG8_MMA(1, 1, At, B1); PG8_BAR;
            PG8_LDB(B0, 1, 0); PG8_SCHED; PG8_LDA(At, 1, 0); PG8_STAGE(PG8_SA(0, 1), a2 + hstep, voffA);
            PG8_WAIT_L(8); PG8_BAR; PG8_WAIT_L(0); PG8_MMA(0, 0, At, B0); PG8_BAR; PG8_SCHED;
            PG8_LDB(B1, 1, 1); PG8_STAGE(PG8_SB(1, 0), b3, voffB);
            PG8_BAR; PG8_WAIT_L(0); PG8_MMA(0, 1, At, B1); PG8_BAR;
            PG8_LDA(At, 1, 1); PG8_STAGE(PG8_SA(1, 0), a3, voffA);
            PG8_BAR; PG8_WAIT_L(0); PG8_MMA(1, 0, At, B0); PG8_BAR; PG8_SCHED;
            PG8_STAGE(PG8_SB(1, 1), b3 + hstep, voffB);
            PG8_WAIT_V(6); PG8_BAR; PG8_MMA(1, 1, At, B1); PG8_BAR;
        }
        E(acc, cur, wr, wc, fr, fq);
        if (!has_next) break;
#pragma unroll
        for (int a = 0; a < 2; ++a)
#pragma unroll
            for (int b = 0; b < 2; ++b)
#pragma unroll
                for (int m = 0; m < 4; ++m)
#pragma unroll
                    for (int n = 0; n < 2; ++n) acc[a][b][m][n] = (f32x4){0.f, 0.f, 0.f, 0.f};
        cur = nxt; cA = nA; cB = nB; ++ui;
    }
    PG8_WAIT_V(0);
    if (wr == 0) PG8_BAR;
    PG8_BAR;
#undef PG8_SA
#undef PG8_SB
#undef PG8_STAGE
#undef PG8_LDA
#undef PG8_LDB
#undef PG8_MMA
#undef PG8_WAIT_V
#undef PG8_WAIT_L
#undef PG8_BAR
#undef PG8_SCHED
}
}

template <class Epi>
__device__ __forceinline__ void gemm8_phase(const bf16_t* A, const bf16_t* Bt, int M, int N, int K, const Epi& E, unsigned char* lds, int vb, int nvb, int tid) {
    pg8::Gemm g{A, Bt, M, N, K};
    pg8::StaticOrder S; S.init(M, N, nvb, vb);
    __syncthreads();
    pg8::gemm_phase<Epi>((PG8_LAS unsigned char*)lds, g, S, E, tid);
    __syncthreads();
}

__device__ __forceinline__ void resnorm_phase(const KP& p, const float* xprompt, const float* xsample, const bf16_t* y, const float* g_post, int gate_off, int ly,
                              const float* g_pre, int sc_off, int sh_off, int lh, int vb, int nvb) {
    const int wid = p.tid >> 6, lane = p.tid & 63;
    float* X = p.out;
    bf16_t* H = wsp<bf16_t>(p, W_H);
    const float* MOD = wsp<float>(p, W_MOD);
    for (int u = vb; u < T / 32; u += nvb) {
        const int tok0 = u * 32 + wid * 4;
        const int cr = cond_row(tok0);
        f32x4 xv[4][4];
        uint4 yw[4][2];
#pragma unroll
        for (int r = 0; r < 4; r++) {
            const int tok = tok0 + r;
            const float* xs = xprompt ? (tok < TC ? xprompt + (size_t)tok * D : xsample + (size_t)(tok - TC) * D) : X + (size_t)tok * D;
#pragma unroll
            for (int i = 0; i < 2; i++) {
                xv[r][2 * i] = *(const f32x4*)(xs + i * 512 + lane * 8);
                xv[r][2 * i + 1] = *(const f32x4*)(xs + i * 512 + lane * 8 + 4);
                if (y) yw[r][i] = *(const uint4*)(y + (size_t)tok * D + i * 512 + lane * 8);
            }
        }
        if (y) {
            const float* gate = MOD + (size_t)(ly * 5 + cr) * 6144 + gate_off;
            f32x4 gg[4];
#pragma unroll
            for (int i = 0; i < 2; i++)
#pragma unroll
                for (int hh = 0; hh < 2; hh++) {
                    const f32x4 gp = *(const f32x4*)(g_post + i * 512 + lane * 8 + hh * 4);
                    const f32x4 gt = *(const f32x4*)(gate + i * 512 + lane * 8 + hh * 4);
                    gg[2 * i + hh] = gp * gt;
                }
#pragma unroll
            for (int r = 0; r < 4; r++) {
                float yf[16];
                unpack8(yw[r][0], yf); unpack8(yw[r][1], yf + 8);
                float ss = 0.f;
#pragma unroll
                for (int e = 0; e < 16; e++) ss += yf[e] * yf[e];
                ss = wave_sum(ss);
                const float rs = rsqrtf(ss * (1.f / 1024.f) + EPSV);
#pragma unroll
                for (int q4 = 0; q4 < 4; q4++)
#pragma unroll
                    for (int j = 0; j < 4; j++) xv[r][q4][j] += gg[q4][j] * (yf[q4 * 4 + j] * rs);
            }
        }
        if (y || xprompt) {
#pragma unroll
            for (int r = 0; r < 4; r++)
#pragma unroll
                for (int i = 0; i < 2; i++) {
                    *(f32x4*)(X + (size_t)(tok0 + r) * D + i * 512 + lane * 8) = xv[r][2 * i];
                    *(f32x4*)(X + (size_t)(tok0 + r) * D + i * 512 + lane * 8 + 4) = xv[r][2 * i + 1];
                }
        }
        if (g_pre) {
            const float* sc = MOD + (size_t)(lh * 5 + cr) * 6144 + sc_off;
            const float* sh = MOD + (size_t)(lh * 5 + cr) * 6144 + sh_off;
            f32x4 mm[4], aa[4];
#pragma unroll
            for (int q4 = 0; q4 < 4; q4++) {
                const int co = (q4 >> 1) * 512 + lane * 8 + (q4 & 1) * 4;
                const f32x4 gp = *(const f32x4*)(g_pre + co);
                const f32x4 s1 = *(const f32x4*)(sc + co);
                aa[q4] = *(const f32x4*)(sh + co);
                mm[q4] = gp * (s1 + 1.f);
            }
#pragma unroll
            for (int r = 0; r < 4; r++) {
                float ss = 0.f;
#pragma unroll
                for (int q4 = 0; q4 < 4; q4++) ss += xv[r][q4][0] * xv[r][q4][0] + xv[r][q4][1] * xv[r][q4][1] + xv[r][q4][2] * xv[r][q4][2] + xv[r][q4][3] * xv[r][q4][3];
                ss = wave_sum(ss);
                const float rs = rsqrtf(ss * (1.f / 1024.f) + EPSV);
#pragma unroll
                for (int i = 0; i < 2; i++) {
                    float hv[8];
#pragma unroll
                    for (int j = 0; j < 4; j++) { hv[j] = xv[r][2 * i][j] * rs * mm[2 * i][j] + aa[2 * i][j]; hv[4 + j] = xv[r][2 * i + 1][j] * rs * mm[2 * i + 1][j] + aa[2 * i + 1][j]; }
                    uint4 w;
                    w.x = pg8::cvt_pk_bf16(hv[0], hv[1]); w.y = pg8::cvt_pk_bf16(hv[2], hv[3]); w.z = pg8::cvt_pk_bf16(hv[4], hv[5]); w.w = pg8::cvt_pk_bf16(hv[6], hv[7]);
                    *(uint4*)(H + (size_t)(tok0 + r) * D + i * 512 + lane * 8) = w;
                }
            }
        }
    }
}

__device__ __forceinline__ void tok_decode(int tok, bool& lat, int& b, int& t, int& L) {
    lat = tok >= TC;
    if (!lat) { b = tok >> 8; t = tok & 255; L = 256; } else { const int q = tok - TC; b = q >> 11; t = q & 2047; L = 2048; }
}
__device__ __forceinline__ uint4 pack8(const float* f) {
    uint4 w;
    w.x = pg8::cvt_pk_bf16(f[0], f[1]); w.y = pg8::cvt_pk_bf16(f[2], f[3]); w.z = pg8::cvt_pk_bf16(f[4], f[5]); w.w = pg8::cvt_pk_bf16(f[6], f[7]);
    return w;
}
template <int U, class LD, class CP>
__device__ __forceinline__ void run_task(int nbi, int vb, int nvb, int tid, LD load, CP comp) {
    for (int u0 = vb; u0 < nbi; u0 += nvb * U) {
        if constexpr (U == 1) { auto d0 = load(u0 * NT + tid); comp(u0 * NT + tid, d0); }
        if constexpr (U == 2) {
            const int i0 = u0 * NT + tid, i1 = ((u0 + nvb < nbi) ? u0 + nvb : u0) * NT + tid;
            auto d0 = load(i0); auto d1 = load(i1);
            comp(i0, d0); comp(i1, d1);
        }
        if constexpr (U == 4) {
            const int i0 = u0 * NT + tid, i1 = ((u0 + nvb < nbi) ? u0 + nvb : u0) * NT + tid, i2 = ((u0 + 2 * nvb < nbi) ? u0 + 2 * nvb : u0) * NT + tid,
                      i3 = ((u0 + 3 * nvb < nbi) ? u0 + 3 * nvb : u0) * NT + tid;
            auto d0 = load(i0); auto d1 = load(i1); auto d2 = load(i2); auto d3 = load(i3);
            comp(i0, d0); comp(i1, d1); comp(i2, d2); comp(i3, d3);
        }
    }
}
struct Ld1 { uint4 a; };
struct Ld2 { uint4 a, b; };
struct Ld3 { uint4 a, b, c; };
__device__ __forceinline__ void prep_phase(const KP& p, int l, int vb, int nvb) {
    const int tid = p.tid;
    const bf16_t* PROJ = wsp<bf16_t>(p, W_PROJ);
    const float* RA = wsp<float>(p, W_ROPEA); const float* RB = wsp<float>(p, W_ROPEB);
    {
        const float* cw = pin(p, I_GCONV) + (size_t)l * 3 * 768;
        bf16_t* GQ = wsp<bf16_t>(p, W_GQ);
        static_assert(W_GK == W_GQ + (size_t)T * 256 * 2 && W_GV == W_GK + (size_t)T * 256 * 2, "GQ/GK/GV must be contiguous");
        run_task<2>(T * 96 / NT, vb, nvb, tid,
            [&](int idx) __attribute__((always_inline)) { const int tok = idx / 96, grp = idx - tok * 96; bool lat; int b, t, L; tok_decode(tok, lat, b, t, L);
                const bf16_t* s = PROJ + (size_t)tok * INC + C_GQKV + grp * 8; Ld3 d;
                d.b = *(const uint4*)s;
                d.a = (t > 0) ? *(const uint4*)(s - INC) : make_uint4(0u, 0u, 0u, 0u);
                d.c = (t < L - 1) ? *(const uint4*)(s + INC) : make_uint4(0u, 0u, 0u, 0u);
                return d; },
            [&](int idx, const Ld3& d) __attribute__((always_inline)) { const int tok = idx / 96, grp = idx - tok * 96;
                float xp[8], xc[8], xn[8], y[8]; unpack8(d.a, xp); unpack8(d.b, xc); unpack8(d.c, xn);
                float ss = 0.f;
#pragma unroll
                for (int e = 0; e < 8; e++) {
                    const int ch = grp * 8 + e;
                    float v = xp[e] * cw[ch] + xc[e] * cw[768 + ch] + xn[e] * cw[1536 + ch];
                    v = v / (1.f + __expf(-v));
                    y[e] = v; ss += v * v;
                }
                ss += __shfl_xor(ss, 1); ss += __shfl_xor(ss, 2); ss += __shfl_xor(ss, 4);
                if (grp < 64) { const float sc = rsqrtf(ss + EPSV) * (grp < 32 ? 0.125f : 1.f);
#pragma unroll
                    for (int e = 0; e < 8; e++) y[e] *= sc; }
                bf16_t* dst = GQ + (size_t)(grp >> 5) * ((size_t)T * 256) + (size_t)tok * 256 + (grp & 31) * 8;
                *(uint4*)dst = pack8(y); });
    }
    {
        bf16_t* CKVN = wsp<bf16_t>(p, W_CKVN);
        run_task<4>(T * 16 / NT, vb, nvb, tid,
            [&](int idx) __attribute__((always_inline)) { const int tok = idx >> 4, grp = idx & 15; Ld1 d; d.a = *(const uint4*)(PROJ + (size_t)tok * INC + C_CKV + grp * 8); return d; },
            [&](int idx, const Ld1& d) __attribute__((always_inline)) { const int tok = idx >> 4, grp = idx & 15; bool lat; int b, t, L; tok_decode(tok, lat, b, t, L);
                float x[8]; unpack8(d.a, x);
                float ss = 0.f;
#pragma unroll
                for (int e = 0; e < 8; e++) ss += x[e] * x[e];
                ss += __shfl_xor(ss, 1); ss += __shfl_xor(ss, 2); ss += __shfl_xor(ss, 4); ss += __shfl_xor(ss, 8);
                const float rs = rsqrtf(ss * (1.f / 128.f) + EPSV);
                const float* gw = pin(p, I_KVNORM) + l * 128 + grp * 8;
#pragma unroll
                for (int e = 0; e < 8; e++) x[e] = x[e] * rs * gw[e];
                *(uint4*)(CKVN + (size_t)tok * 128 + grp * 8) = pack8(x);
                if (!lat) { float* o = p.out + O_CKV + ((size_t)(b * 2 + l) * 256 + t) * 128 + grp * 8;
                    *(f32x4*)o = (f32x4){x[0], x[1], x[2], x[3]}; *(f32x4*)(o + 4) = (f32x4){x[4], x[5], x[6], x[7]}; } });
    }
    {
        run_task<4>(T * 148 / NT, vb, nvb, tid,
            [&](int idx) __attribute__((always_inline)) { const int tok = idx / 148, sg = idx - tok * 148; int col;
                if (sg < 4) col = C_KPE + sg * 8; else if (sg < 52) col = C_MQ + (sg - 4) * 8; else if (sg < 84) col = C_SQ + (sg - 52) * 8;
                else if (sg < 100) col = C_SK + (sg - 84) * 8; else if (sg < 116) col = C_SV + (sg - 100) * 8; else col = C_GZ + (sg - 116) * 8;
                Ld1 d; d.a = *(const uint4*)(PROJ + (size_t)tok * INC + col); return d; },
            [&](int idx, const Ld1& d) __attribute__((always_inline)) { const int tok = idx / 148, sg = idx - tok * 148; bool lat; int b, t, L; tok_decode(tok, lat, b, t, L);
                bf16_t* dst; const float* rope = nullptr; float* cout = nullptr; const size_t ob = (size_t)(b * 2 + l) * 256 + t;
                if (sg < 4) { dst = wsp<bf16_t>(p, W_KPE) + (size_t)tok * 32 + sg * 8; rope = RA + (t * 16 + sg * 4) * 2; cout = p.out + O_KPE + ob * 32 + sg * 8; }
                else if (sg < 52) { const int g2 = sg - 4, part = g2 % 12; dst = wsp<bf16_t>(p, W_QMLA) + (size_t)tok * 384 + g2 * 8; if (part >= 8) rope = RA + (t * 16 + (part - 8) * 4) * 2; }
                else if (sg < 84) { const int g2 = sg - 52; dst = wsp<bf16_t>(p, W_QSWA) + (size_t)tok * 256 + g2 * 8; rope = RB + (t * 32 + (g2 & 7) * 4) * 2; }
                else if (sg < 100) { const int g2 = sg - 84; dst = wsp<bf16_t>(p, W_KSWA) + (size_t)tok * 128 + g2 * 8; rope = RB + (t * 32 + (g2 & 7) * 4) * 2; cout = p.out + O_SK + ob * 128 + g2 * 8; }
                else if (sg < 116) { const int g2 = sg - 100; dst = wsp<bf16_t>(p, W_VSWA) + (size_t)tok * 128 + g2 * 8; cout = p.out + O_SV + ob * 128 + g2 * 8; }
                else { const int g2 = sg - 116; dst = wsp<bf16_t>(p, W_GZ) + (size_t)tok * 256 + g2 * 8; }
                uint4 w = d.a;
                if (lat) {
                    if (rope) {
                        float x[8]; unpack8(d.a, x);
                        const f32x4 c0 = *(const f32x4*)rope, c1 = *(const f32x4*)(rope + 4);
                        float y[8];
                        y[0] = x[0] * c0[0] - x[1] * c0[1]; y[1] = x[0] * c0[1] + x[1] * c0[0];
                        y[2] = x[2] * c0[2] - x[3] * c0[3]; y[3] = x[2] * c0[3] + x[3] * c0[2];
                        y[4] = x[4] * c1[0] - x[5] * c1[1]; y[5] = x[4] * c1[1] + x[5] * c1[0];
                        y[6] = x[6] * c1[2] - x[7] * c1[3]; y[7] = x[6] * c1[3] + x[7] * c1[2];
                        w = pack8(y);
                    }
                } else if (cout) {
                    float x[8]; unpack8(d.a, x);
                    *(f32x4*)cout = (f32x4){x[0], x[1], x[2], x[3]}; *(f32x4*)(cout + 4) = (f32x4){x[4], x[5], x[6], x[7]};
                }
                *(uint4*)dst = w; });
    }
    {
        float* GG = wsp<float>(p, W_GG); float* GBETA = wsp<float>(p, W_GBETA);
        run_task<2>(T / NT, vb, nvb, tid,
            [&](int idx) __attribute__((always_inline)) { Ld2 d; d.a = *(const uint4*)(PROJ + (size_t)idx * INC + C_GA); d.b = *(const uint4*)(PROJ + (size_t)idx * INC + C_GB); return d; },
            [&](int idx, const Ld2& d) __attribute__((always_inline)) { float a[8], bb[8], go[8], bo[8]; unpack8(d.a, a); unpack8(d.b, bb);
#pragma unroll
                for (int e = 0; e < 8; e++) {
                    const float xx = a[e] + pin(p, I_GDT)[l * 8 + e];
                    const float sp = xx > 20.f ? xx : __logf(1.f + __expf(xx));
                    go[e] = -__expf(pin(p, I_GALOG)[l * 8 + e]) * sp;
                    bo[e] = 1.f / (1.f + __expf(-bb[e]));
                }
                *(f32x4*)(GG + (size_t)idx * 8) = (f32x4){go[0], go[1], go[2], go[3]}; *(f32x4*)(GG + (size_t)idx * 8 + 4) = (f32x4){go[4], go[5], go[6], go[7]};
                *(f32x4*)(GBETA + (size_t)idx * 8) = (f32x4){bo[0], bo[1], bo[2], bo[3]}; *(f32x4*)(GBETA + (size_t)idx * 8 + 4) = (f32x4){bo[4], bo[5], bo[6], bo[7]}; });
    }
}

template <int D2, bool MASK>
__device__ __forceinline__ void attn_seg(const float* q, float* acc, float& m, float& lsum, const bf16_t* k1, int s1, const bf16_t* k2, int s2,
                                         const bf16_t* v, int sv, int j0, int j1, int tq) {
#pragma unroll 1
    for (int j = j0; j < j1; j += 2) {
        float sa = 0.f, sb = 0.f;
        const bf16_t* kpa = k1 + (size_t)j * s1;
        const bf16_t* kpb = kpa + s1;
#pragma unroll
        for (int c = 0; c < 8; c++) {
            float ka[8], kb[8]; unpack8(*(const uint4*)(kpa + c * 8), ka); unpack8(*(const uint4*)(kpb + c * 8), kb);
#pragma unroll
            for (int e = 0; e < 8; e++) { sa += q[c * 8 + e] * ka[e]; sb += q[c * 8 + e] * kb[e]; }
        }
        if (D2 > 0) {
            const bf16_t* k2a = k2 + (size_t)j * s2;
            const bf16_t* k2b = k2a + s2;
#pragma unroll
            for (int c = 0; c < D2 / 8; c++) {
                float ka[8], kb[8]; unpack8(*(const uint4*)(k2a + c * 8), ka); unpack8(*(const uint4*)(k2b + c * 8), kb);
#pragma unroll
                for (int e = 0; e < 8; e++) { sa += q[64 + c * 8 + e] * ka[e]; sb += q[64 + c * 8 + e] * kb[e]; }
            }
        }
        if (MASK) {
            int dlt = tq - j; if (dlt > 128 || dlt < -128) sa = -1e30f;
            dlt -= 1; if (dlt > 128 || dlt < -128) sb = -1e30f;
        }
        const float mn = fmaxf(m, fmaxf(sa, sb));
        const float alpha = __expf(m - mn);
        const float pa = __expf(sa - mn), pb = __expf(sb - mn);
        lsum = lsum * alpha + pa + pb;
        m = mn;
        const bf16_t* va = v + (size_t)j * sv;
        const bf16_t* vb = va + sv;
#pragma unroll
        for (int c = 0; c < 8; c++) {
            float xa[8], xb[8]; unpack8(*(const uint4*)(va + c * 8), xa); unpack8(*(const uint4*)(vb + c * 8), xb);
#pragma unroll
            for (int e = 0; e < 8; e++) acc[c * 8 + e] = acc[c * 8 + e] * alpha + pa * xa[e] + pb * xb[e];
        }
    }
}

__device__ __forceinline__ void mla_wave(const KP& p, int l, bool lat, int b, int h, int qblk, int lane) {
    const int L = lat ? 2048 : 256, seq0 = lat ? TC + b * 2048 : b * 256;
    const int tq = seq0 + qblk * 64 + lane;
    const bf16_t* QMLA = wsp<bf16_t>(p, W_QMLA);
    const bf16_t* KVX = wsp<bf16_t>(p, W_KVX);
    const bf16_t* KPE = wsp<bf16_t>(p, W_KPE);
    float q[96], acc[64];
    const float scale = 0.10206207261596577f;
#pragma unroll
    for (int c = 0; c < 12; c++) {
        float t8[8]; unpack8(*(const uint4*)(QMLA + (size_t)tq * 384 + h * 96 + c * 8), t8);
#pragma unroll
        for (int e = 0; e < 8; e++) q[c * 8 + e] = t8[e] * scale;
    }
#pragma unroll
    for (int d = 0; d < 64; d++) acc[d] = 0.f;
    float m = -1e30f, lsum = 0.f;
    attn_seg<32, false>(q, acc, m, lsum, KVX + (size_t)seq0 * 512 + h * 128, 512, KPE + (size_t)seq0 * 32, 32, KVX + (size_t)seq0 * 512 + h * 128 + 64, 512, 0, L, 0);
    if (lat) {
        const bf16_t* KVC = wsp<bf16_t>(p, W_KVC) + ((size_t)l * 2048 + b * 512) * 512;
        const bf16_t* KPEC = wsp<bf16_t>(p, W_KPEC) + ((size_t)l * 2048 + b * 512) * 32;
        attn_seg<32, false>(q, acc, m, lsum, KVC + h * 128, 512, KPEC, 32, KVC + h * 128 + 64, 512, 0, 512, 0);
    }
    const float inv = 1.f / lsum;
    bf16_t* O = wsp<bf16_t>(p, W_H) + (size_t)tq * 1024 + h * 64;
#pragma unroll
    for (int c = 0; c < 8; c++) {
        uint4 w;
        w.x = (unsigned)f2bf(acc[c * 8 + 0] * inv) | ((unsigned)f2bf(acc[c * 8 + 1] * inv) << 16);
        w.y = (unsigned)f2bf(acc[c * 8 + 2] * inv) | ((unsigned)f2bf(acc[c * 8 + 3] * inv) << 16);
        w.z = (unsigned)f2bf(acc[c * 8 + 4] * inv) | ((unsigned)f2bf(acc[c * 8 + 5] * inv) << 16);
        w.w = (unsigned)f2bf(acc[c * 8 + 6] * inv) | ((unsigned)f2bf(acc[c * 8 + 7] * inv) << 16);
        *(uint4*)(O + c * 8) = w;
    }
}

__device__ __forceinline__ void swa_wave(const KP& p, int l, bool lat, int b, int h, int qblk, int lane) {
    const int L = lat ? 2048 : 256, seq0 = lat ? TC + b * 2048 : b * 256;
    const int tql = qblk * 64 + lane, tq = seq0 + tql, hk = h >> 1;
    const bf16_t* QSWA = wsp<bf16_t>(p, W_QSWA);
    const bf16_t* KSWA = wsp<bf16_t>(p, W_KSWA);
    const bf16_t* VSWA = wsp<bf16_t>(p, W_VSWA);
    float q[64], acc[64];
#pragma unroll
    for (int c = 0; c < 8; c++) {
        float t8[8]; unpack8(*(const uint4*)(QSWA + (size_t)tq * 256 + h * 64 + c * 8), t8);
#pragma unroll
        for (int e = 0; e < 8; e++) q[c * 8 + e] = t8[e] * 0.125f;
    }
#pragma unroll
    for (int d = 0; d < 64; d++) acc[d] = 0.f;
    float m = pin(p, I_SINK)[l * 4 + h], lsum = 1.f;
    if (lat) {
        int jlo = qblk * 64 - 128; if (jlo < 0) jlo = 0;
        int jhi = qblk * 64 + 64 + 128; if (jhi > L) jhi = L;
        attn_seg<0, true>(q, acc, m, lsum, KSWA + (size_t)seq0 * 128 + hk * 64, 128, nullptr, 0, VSWA + (size_t)seq0 * 128 + hk * 64, 128, jlo, jhi, tql);
        const bf16_t* KC = wsp<bf16_t>(p, W_KSWC) + ((size_t)l * 2048 + b * 512) * 128 + hk * 64;
        const bf16_t* VC = wsp<bf16_t>(p, W_VSWC) + ((size_t)l * 2048 + b * 512) * 128 + hk * 64;
        attn_seg<0, false>(q, acc, m, lsum, KC, 128, nullptr, 0, VC, 128, 0, 512, 0);
    } else {
        attn_seg<0, false>(q, acc, m, lsum, KSWA + (size_t)seq0 * 128 + hk * 64, 128, nullptr, 0, VSWA + (size_t)seq0 * 128 + hk * 64, 128, 0, L, 0);
    }
    const float inv = 1.f / lsum;
    bf16_t* O = wsp<bf16_t>(p, W_H) + (size_t)tq * 1024 + 256 + h * 64;
#pragma unroll
    for (int c = 0; c < 8; c++) {
        uint4 w;
        w.x = (unsigned)f2bf(acc[c * 8 + 0] * inv) | ((unsigned)f2bf(acc[c * 8 + 1] * inv) << 16);
        w.y = (unsigned)f2bf(acc[c * 8 + 2] * inv) | ((unsigned)f2bf(acc[c * 8 + 3] * inv) << 16);
        w.z = (unsigned)f2bf(acc[c * 8 + 4] * inv) | ((unsigned)f2bf(acc[c * 8 + 5] * inv) << 16);
        w.w = (unsigned)f2bf(acc[c * 8 + 6] * inv) | ((unsigned)f2bf(acc[c * 8 + 7] * inv) << 16);
        *(uint4*)(O + c * 8) = w;
    }
}


__device__ __forceinline__ float xmax16(float v) { auto r = __builtin_amdgcn_permlane16_swap(__float_as_uint(v), __float_as_uint(v), false, false); return fmaxf(__uint_as_float(r[0]), __uint_as_float(r[1])); }
__device__ __forceinline__ float xmax32(float v) { auto r = __builtin_amdgcn_permlane32_swap(__float_as_uint(v), __float_as_uint(v), false, false); return fmaxf(__uint_as_float(r[0]), __uint_as_float(r[1])); }
__device__ __forceinline__ float xsum16(float v) { auto r = __builtin_amdgcn_permlane16_swap(__float_as_uint(v), __float_as_uint(v), false, false); return __uint_as_float(r[0]) + __uint_as_float(r[1]); }
__device__ __forceinline__ float xsum32(float v) { auto r = __builtin_amdgcn_permlane32_swap(__float_as_uint(v), __float_as_uint(v), false, false); return __uint_as_float(r[0]) + __uint_as_float(r[1]); }
typedef short s16x4 __attribute__((ext_vector_type(4)));
#define LDS_AS __attribute__((address_space(3)))
template <int TYPE  >
__device__ __forceinline__ void attn_unit(const KP& p, int l, bool lat, int b, int h, int qb, unsigned char* lds) {
    constexpr int NKS = TYPE == 0 ? 3 : 2;
    constexpr int KSTR = TYPE == 0 ? 208 : 144;
    constexpr int VSTR = 160;
    constexpr int KT = 128, MT = KT / 16;
    constexpr int NQ = 2;
    constexpr int KBUF = KT * KSTR, VBUF = KT * VSTR;
    const int tid = p.tid, wid = tid >> 6, lane = tid & 63, fr = lane & 15, g = lane >> 4;
    const int L = lat ? 2048 : 256, seq0 = lat ? TC + b * 2048 : b * 256;
    const int q0 = qb * 256;
    const int tq0 = q0 + wid * 32 + fr;
    const int hk = h >> 1;
    bf16x8 qf[NQ][NKS];
#pragma unroll
    for (int q = 0; q < NQ; q++) {
        const bf16_t* qp = TYPE == 0 ? wsp<bf16_t>(p, W_QMLA) + (size_t)(seq0 + tq0 + 16 * q) * 384 + h * 96 : wsp<bf16_t>(p, W_QSWA) + (size_t)(seq0 + tq0 + 16 * q) * 256 + h * 64;
#pragma unroll
        for (int ks = 0; ks < NKS; ks++) qf[q][ks] = *(const bf16x8*)(qp + ks * 32 + g * 8);
    }
    const float sc2 = (TYPE == 0 ? 0.10206207261596577f : 0.125f) * 1.4426950408889634f;
    float m2[NQ], lsum[NQ];
    f32x4 oacc[NQ][4];
#pragma unroll
    for (int q = 0; q < NQ; q++) {
        m2[q] = TYPE == 0 ? -1e30f : pin(p, I_SINK)[l * 4 + h] * 1.4426950408889634f;
        lsum[q] = (TYPE == 1 && g == 0) ? 1.f : 0.f;
#pragma unroll
        for (int i = 0; i < 4; i++) oacc[q][i] = (f32x4){p.zf, p.zf, p.zf, p.zf};
    }
    int j0 = 0, j1 = L;
    if (TYPE == 1 && lat) { j0 = q0 - 128; if (j0 < 0) j0 = 0; j1 = q0 + 384; if (j1 > L) j1 = L; }
    const int nt0 = (j1 - j0) / KT, nt = nt0 + (lat ? 512 / KT : 0);
    uint4 ra0, ra1, ra2, ra3, ra4, rb0, rb1, rb2, rb3, rb4;
    auto tile_ptrs = [&](int it, const bf16_t*& kb, int& kstr, const bf16_t*& pb, const bf16_t*& vb, int& vstr) __attribute__((always_inline)) {
        if (it < nt0) {
            const size_t t0 = (size_t)seq0 + j0 + it * KT;
            if (TYPE == 0) { kb = wsp<bf16_t>(p, W_KVX) + t0 * 512 + h * 128; kstr = 512; pb = wsp<bf16_t>(p, W_KPE) + t0 * 32; vb = kb + 64; vstr = 512; }
            else { kb = wsp<bf16_t>(p, W_KSWA) + t0 * 128 + hk * 64; kstr = 128; pb = nullptr; vb = wsp<bf16_t>(p, W_VSWA) + t0 * 128 + hk * 64; vstr = 128; }
        } else {
            const size_t t0 = (size_t)l * 2048 + b * 512 + (it - nt0) * KT;
            if (TYPE == 0) { kb = wsp<bf16_t>(p, W_KVC) + t0 * 512 + h * 128; kstr = 512; pb = wsp<bf16_t>(p, W_KPEC) + t0 * 32; vb = kb + 64; vstr = 512; }
            else { kb = wsp<bf16_t>(p, W_KSWC) + t0 * 128 + hk * 64; kstr = 128; pb = nullptr; vb = wsp<bf16_t>(p, W_VSWC) + t0 * 128 + hk * 64; vstr = 128; }
        }
    };
#define ATT_GLOAD(R0, R1, R2, R3, R4, it_) do { const bf16_t* kb_; const bf16_t* pb_; const bf16_t* vb_; int ks_, vs_; tile_ptrs((it_), kb_, ks_, pb_, vb_, vs_); \
        R0 = *(const uint4*)(kb_ + (size_t)(tid >> 3) * ks_ + (tid & 7) * 8); R1 = *(const uint4*)(kb_ + (size_t)(64 + (tid >> 3)) * ks_ + (tid & 7) * 8); \
        R2 = *(const uint4*)(vb_ + (size_t)(tid >> 3) * vs_ + (tid & 7) * 8); R3 = *(const uint4*)(vb_ + (size_t)(64 + (tid >> 3)) * vs_ + (tid & 7) * 8); \
        if (TYPE == 0) R4 = *(const uint4*)(pb_ + (size_t)(tid >> 2) * 32 + (tid & 3) * 8); } while (0)
#define ATT_LSTORE(R0, R1, R2, R3, R4, buf_) do { unsigned char* kd_ = lds + (buf_) * (KBUF + VBUF); unsigned char* vd_ = kd_ + KBUF; \
        *(uint4*)(kd_ + (tid >> 3) * KSTR + (tid & 7) * 16) = R0; *(uint4*)(kd_ + (64 + (tid >> 3)) * KSTR + (tid & 7) * 16) = R1; \
        *(uint4*)(vd_ + (tid >> 3) * VSTR + (tid & 7) * 16) = R2; *(uint4*)(vd_ + (64 + (tid >> 3)) * VSTR + (tid & 7) * 16) = R3; \
        if (TYPE == 0) *(uint4*)(kd_ + (tid >> 2) * KSTR + 128 + (tid & 3) * 16) = R4; } while (0)
    auto compute_tile = [&](int it) __attribute__((always_inline)) {
        const unsigned char* kd = lds + (it & 1) * (KBUF + VBUF);
        const unsigned char* vd = kd + KBUF;
        const bool domask = (TYPE == 1) && lat && (it < nt0);
#pragma unroll
        for (int hf = 0; hf < 2; hf++) {
            f32x4 sacc[NQ][4];
#pragma unroll
            for (int q = 0; q < NQ; q++)
#pragma unroll
                for (int mt = 0; mt < 4; mt++) sacc[q][mt] = (f32x4){p.zf, p.zf, p.zf, p.zf};
#pragma unroll
            for (int ks = 0; ks < NKS; ks++)
#pragma unroll
                for (int mt = 0; mt < 4; mt++) {
                    bf16x8 a = *(const bf16x8*)(kd + (hf * 64 + mt * 16 + fr) * KSTR + ks * 64 + g * 16);
#pragma unroll
                    for (int q = 0; q < NQ; q++) sacc[q][mt] = __builtin_amdgcn_mfma_f32_16x16x32_bf16(a, qf[q][ks], sacc[q][mt], 0, 0, 0);
                }
            const int jbase = j0 + it * KT + hf * 64 + 4 * g;
            bf16x8 pf[NQ][2];
#pragma unroll
            for (int q = 0; q < NQ; q++) {
                float mx = -3e38f;
#pragma unroll
                for (int mt = 0; mt < 4; mt++)
#pragma unroll
                    for (int r = 0; r < 4; r++) {
                        float s = sacc[q][mt][r] * sc2;
                        if (domask) { int dlt = tq0 + 16 * q - (jbase + mt * 16 + r); if (dlt > 128 || dlt < -128) s = -1e30f; }
                        sacc[q][mt][r] = s;
                        mx = fmaxf(mx, s);
                    }
                mx = xmax16(mx);
                mx = xmax32(mx);
                const float mn = fmaxf(m2[q], mx);
                const float alpha = __builtin_amdgcn_exp2f(m2[q] - mn);
                m2[q] = mn;
                float ps = 0.f;
#pragma unroll
                for (int mt = 0; mt < 4; mt++)
#pragma unroll
                    for (int r = 0; r < 4; r++) { float pv = __builtin_amdgcn_exp2f(sacc[q][mt][r] - mn); sacc[q][mt][r] = pv; ps += pv; }
                lsum[q] = lsum[q] * alpha + ps;
#pragma unroll
                for (int i = 0; i < 4; i++) oacc[q][i] *= alpha;
#pragma unroll
                for (int s = 0; s < 2; s++) {
                    union { unsigned u[4]; bf16x8 v; } cv;
                    cv.u[0] = pg8::cvt_pk_bf16(sacc[q][2 * s][0], sacc[q][2 * s][1]); cv.u[1] = pg8::cvt_pk_bf16(sacc[q][2 * s][2], sacc[q][2 * s][3]);
                    cv.u[2] = pg8::cvt_pk_bf16(sacc[q][2 * s + 1][0], sacc[q][2 * s + 1][1]); cv.u[3] = pg8::cvt_pk_bf16(sacc[q][2 * s + 1][2], sacc[q][2 * s + 1][3]);
                    pf[q][s] = cv.v;
                }
            }
#pragma unroll
            for (int md = 0; md < 4; md++)
#pragma unroll
                for (int s = 0; s < 2; s++) {
                    const unsigned char* va = vd + (hf * 64 + 32 * s + 4 * g + (fr >> 2)) * VSTR + (md * 16 + (fr & 3) * 4) * 2;
                    s16x4 lo = __builtin_amdgcn_ds_read_tr16_b64_v4i16((LDS_AS s16x4*)(va));
                    s16x4 hi = __builtin_amdgcn_ds_read_tr16_b64_v4i16((LDS_AS s16x4*)(va + 16 * VSTR));
                    bf16x8 a;
                    a[0] = lo[0]; a[1] = lo[1]; a[2] = lo[2]; a[3] = lo[3]; a[4] = hi[0]; a[5] = hi[1]; a[6] = hi[2]; a[7] = hi[3];
#pragma unroll
                    for (int q = 0; q < NQ; q++) oacc[q][md] = __builtin_amdgcn_mfma_f32_16x16x32_bf16(a, pf[q][s], oacc[q][md], 0, 0, 0);
                }
        }
    };
    __syncthreads();
    ATT_GLOAD(ra0, ra1, ra2, ra3, ra4, 0);
    ATT_LSTORE(ra0, ra1, ra2, ra3, ra4, 0);
    if (nt > 1) ATT_GLOAD(rb0, rb1, rb2, rb3, rb4, 1);
    __syncthreads();
#pragma unroll 1
    for (int it = 0; it < nt; it += 2) {
        if (it + 2 < nt) ATT_GLOAD(ra0, ra1, ra2, ra3, ra4, it + 2);
        compute_tile(it);
        if (it + 1 < nt) ATT_LSTORE(rb0, rb1, rb2, rb3, rb4, 1);
        __syncthreads();
        if (it + 1 < nt) {
            if (it + 3 < nt) ATT_GLOAD(rb0, rb1, rb2, rb3, rb4, it + 3);
            compute_tile(it + 1);
            if (it + 2 < nt) ATT_LSTORE(ra0, ra1, ra2, ra3, ra4, 0);
            __syncthreads();
        }
    }
#pragma unroll
    for (int q = 0; q < NQ; q++) {
        float ls = xsum16(lsum[q]);
        ls = xsum32(ls);
        const float inv = 1.f / ls;
        bf16_t* O = wsp<bf16_t>(p, W_H) + (size_t)(seq0 + tq0 + 16 * q) * 1024 + (TYPE == 0 ? 0 : 256) + h * 64;
#pragma unroll
        for (int md = 0; md < 4; md++) {
            uint2 w;
            w.x = pg8::cvt_pk_bf16(oacc[q][md][0] * inv, oacc[q][md][1] * inv);
            w.y = pg8::cvt_pk_bf16(oacc[q][md][2] * inv, oacc[q][md][3] * inv);
            *(uint2*)(O + md * 16 + 4 * g) = w;
        }
    }
}

struct GdnCombo { bool lat; int b, dir, h, L, seq0, nch, ubase; };
__device__ __forceinline__ GdnCombo gdn_combo(int cid  ) {
    GdnCombo c;
    c.lat = cid >= 128;
    const int x = c.lat ? cid - 128 : cid;
    c.b = x >> 3; c.dir = (x >> 2) & 1; c.h = x & 3;
    c.L = c.lat ? 2048 : 256; c.seq0 = c.lat ? TC + c.b * 2048 : c.b * 256; c.nch = c.lat ? 32 : 4;
    c.ubase = c.lat ? 512 + x * 32 : x * 4;
    return c;
}
constexpr int G1_SLOT = 64 * 68 * 4 + 512 + 4096;
__device__ __forceinline__ void gdn_g1_unit(const KP& p, int l, int bu  , unsigned char* lds) {
    const int tid = p.tid, wid = tid >> 6, lane = tid & 63, fr = lane & 15, g = lane >> 4;
    const int slot = wid >> 1, half = wid & 1, tl = half * 64 + lane;
    int cid, n0;
    if (bu < 128) { cid = bu; n0 = 0; } else { cid = 128 + ((bu - 128) >> 3); n0 = ((bu - 128) & 7) * 4; }
    const GdnCombo cb = gdn_combo(cid);
    const int n = n0 + slot, nu = cb.ubase + n;
    float* As = (float*)(lds + slot * G1_SLOT);
    float* decs = As + 64 * 68;
    float* betas = decs + 64;
    const bf16_t* GQ = wsp<bf16_t>(p, W_GQ); const bf16_t* GK = wsp<bf16_t>(p, W_GK); const bf16_t* GV = wsp<bf16_t>(p, W_GV);
    const float* GG = wsp<float>(p, W_GG); const float* GBETA = wsp<float>(p, W_GBETA);
    auto tok_of = [&](int c) __attribute__((always_inline)) -> size_t { int pos = n * 64 + c; return (size_t)cb.seq0 + (cb.dir ? cb.L - 1 - pos : pos); };
    __syncthreads();
    if (half == 0) {
        const size_t tk = tok_of(lane);
        float gv = GG[tk * 8 + cb.dir * 4 + cb.h];
#pragma unroll
        for (int o = 1; o < 64; o <<= 1) { float t = __shfl_up(gv, o); if (lane >= o) gv += t; }
        decs[lane] = gv;
        betas[lane] = GBETA[tk * 8 + cb.dir * 4 + cb.h];
    }
    __syncthreads();
    {
        bf16x8 kf[4][2], qf[4][2];
#pragma unroll
        for (int x = 0; x < 4; x++) {
            const size_t tk = tok_of(16 * x + fr);
#pragma unroll
            for (int ks = 0; ks < 2; ks++) {
                kf[x][ks] = *(const bf16x8*)(GK + tk * 256 + cb.h * 64 + ks * 32 + g * 8);
                if (half == 1) qf[x][ks] = *(const bf16x8*)(GQ + tk * 256 + cb.h * 64 + ks * 32 + g * 8);
                else qf[x][ks] = kf[x][ks];
            }
        }
#pragma unroll
        for (int nt = 0; nt < 4; nt++) {
            const int c = 16 * nt + fr;
            const float dc = decs[c], bc = betas[c];
#pragma unroll
            for (int mt = 0; mt < 4; mt++) {
                f32x4 acc = (f32x4){p.zf, p.zf, p.zf, p.zf};
#pragma unroll
                for (int ks = 0; ks < 2; ks++) acc = __builtin_amdgcn_mfma_f32_16x16x32_bf16(kf[mt][ks], qf[nt][ks], acc, 0, 0, 0);
                const int s0 = 16 * mt + 4 * g;
                f32x4 ds = *(const f32x4*)(decs + s0);
                f32x4 o;
#pragma unroll
                for (int r = 0; r < 4; r++) {
                    const int s = s0 + r;
                    const float gm = __expf(dc - ds[r]);
                    if (half == 0) o[r] = (s < c) ? bc * acc[r] * gm : 0.f;
                    else o[r] = (s <= c) ? acc[r] * gm : 0.f;
                }
                if (half == 0) *(f32x4*)(As + c * 68 + s0) = o;
                else {
                    uint2 w;
                    w.x = (unsigned)f2bf(o[0]) | ((unsigned)f2bf(o[1]) << 16);
                    w.y = (unsigned)f2bf(o[2]) | ((unsigned)f2bf(o[3]) << 16);
                    *(uint2*)(wsp<bf16_t>(p, W_GAQK) + (size_t)nu * 4096 + c * 64 + 32 * (mt >> 1) + 8 * g + 4 * (mt & 1)) = w;
                }
            }
        }
    }
    __syncthreads();
    float* Tl = betas + 64;
    if (half == 0) {
        const int bi = lane >> 4, j = lane & 15;
        float t[16];
#pragma unroll
        for (int c = 0; c < 16; c++) {
            float s = (c == j) ? 1.f : 0.f;
#pragma unroll
            for (int s2 = 0; s2 < c; s2++) s -= As[(16 * bi + c) * 68 + 16 * bi + s2] * t[s2];
            t[c] = s;
        }
#pragma unroll
        for (int c = 0; c < 16; c++) Tl[(bi * 16 + c) * 16 + j] = t[c];
    }
    __syncthreads();
    {
        f32x4 X[4][4];
#pragma unroll
        for (int i = 0; i < 4; i++) {
#pragma unroll
            for (int r = 0; r < 4; r++) {
                const int row = 16 * i + 4 * g + r;
                const size_t tk = tok_of(row);
                const float sc = half ? betas[row] * __expf(decs[row]) : betas[row];
                const bf16_t* srcp = (half ? GK : GV) + tk * 256 + cb.h * 64 + fr;
#pragma unroll
                for (int nt = 0; nt < 4; nt++) X[i][nt][r] = bf2f(srcp[16 * nt]) * sc;
            }
#pragma unroll
            for (int j = 0; j < 4; j++) {
                if (j < i) {
#pragma unroll
                    for (int ks = 0; ks < 4; ks++) {
                        const float av = -As[(16 * i + fr) * 68 + 16 * j + 4 * g + ks];
#pragma unroll
                        for (int nt = 0; nt < 4; nt++) X[i][nt] = __builtin_amdgcn_mfma_f32_16x16x4f32(av, X[j][nt][ks], X[i][nt], 0, 0, 0);
                    }
                }
            }
            f32x4 Y[4];
#pragma unroll
            for (int nt = 0; nt < 4; nt++) Y[nt] = (f32x4){p.zf, p.zf, p.zf, p.zf};
#pragma unroll
            for (int ks = 0; ks < 4; ks++) {
                const float tv = Tl[(i * 16 + fr) * 16 + 4 * g + ks];
#pragma unroll
                for (int nt = 0; nt < 4; nt++) Y[nt] = __builtin_amdgcn_mfma_f32_16x16x4f32(tv, X[i][nt][ks], Y[nt], 0, 0, 0);
            }
#pragma unroll
            for (int nt = 0; nt < 4; nt++) X[i][nt] = Y[nt];
        }
        if (half == 0) {
            bf16_t* dst = wsp<bf16_t>(p, W_GUV) + (size_t)nu * 4096 + lane * 4;
#pragma unroll
            for (int i = 0; i < 4; i++)
#pragma unroll
                for (int nt = 0; nt < 4; nt++) {
                    uint2 w; w.x = pg8::cvt_pk_bf16(X[i][nt][0], X[i][nt][1]); w.y = pg8::cvt_pk_bf16(X[i][nt][2], X[i][nt][3]);
                    *(uint2*)(dst + (nt * 4 + i) * 256) = w;
                }
        } else {
            bf16_t* dst = wsp<bf16_t>(p, W_GW) + (size_t)nu * 4096;
#pragma unroll
            for (int nt = 0; nt < 4; nt++) {
                const int d = 16 * nt + fr;
                const int pcol = 32 * (d >> 5) + 8 * ((d >> 2) & 3) + 4 * ((d >> 4) & 1) + (d & 3);
#pragma unroll
                for (int i = 0; i < 4; i++)
#pragma unroll
                    for (int r = 0; r < 4; r++) dst[(16 * i + 4 * g + r) * 64 + pcol] = f2bf(-X[i][nt][r]);
            }
        }
    }
    {
        const int dkk = tl & 63, chalf = tl >> 6;
        const float dlast = decs[63];
        bf16_t* dst = wsp<bf16_t>(p, W_GKTT) + (size_t)nu * 4096 + dkk * 64 + chalf * 32;
#pragma unroll
        for (int c8 = 0; c8 < 4; c8++) {
            unsigned w[4];
#pragma unroll
            for (int e = 0; e < 8; e += 2) {
                const int c0 = chalf * 32 + c8 * 8 + e;
                float v0 = bf2f(GK[tok_of(c0) * 256 + cb.h * 64 + dkk]) * __expf(dlast - decs[c0]);
                float v1 = bf2f(GK[tok_of(c0 + 1) * 256 + cb.h * 64 + dkk]) * __expf(dlast - decs[c0 + 1]);
                w[e >> 1] = (unsigned)f2bf(v0) | ((unsigned)f2bf(v1) << 16);
            }
            *(uint2*)(dst + 16 * (c8 & 1) + 4 * (c8 >> 1)) = make_uint2(w[0], w[1]);
            *(uint2*)(dst + 16 * (c8 & 1) + 8 + 4 * (c8 >> 1)) = make_uint2(w[2], w[3]);
        }
        if (tl < 64) wsp<float>(p, W_GEDEC)[(size_t)nu * 64 + tl] = __expf(decs[tl]);
        if (tl == 0) wsp<float>(p, W_GTAIL)[nu] = __expf(dlast);
    }
}

constexpr int G2_ROW = 144, G2_MAT = 64 * G2_ROW, G2_UV = 4 * G2_MAT, G2_ED = G2_UV + 8192, G2_BUF = G2_ED + 512, G2_X = 2 * G2_BUF;
__device__ __forceinline__ void gdn_g2_unit(const KP& p, int l, int bu  , unsigned char* lds) {
    const int tid = p.tid, wid = __builtin_amdgcn_readfirstlane(tid >> 6), lane = tid & 63, fr = lane & 15, g = lane >> 4;
    const int cid = (bu < 32) ? 128 + bu : bu - 32;
    const int nb = wid & 3, mh = wid >> 2;
    const GdnCombo cb = gdn_combo(cid);
    const bf16_t* GQ = wsp<bf16_t>(p, W_GQ);
    f32x4 S[4];
    if (cb.lat) {
        const float* st = pin(p, I_STATE) + ((((size_t)cb.b * 2 + l) * 2 + cb.dir) * 4 + cb.h) * 4096;
#pragma unroll
        for (int mt = 0; mt < 4; mt++)
#pragma unroll
            for (int r = 0; r < 4; r++) S[mt][r] = st[(16 * mt + 4 * g + r) * 64 + 16 * nb + fr];
    } else {
#pragma unroll
        for (int mt = 0; mt < 4; mt++) S[mt] = (f32x4){p.zf, p.zf, p.zf, p.zf};
    }
    bf16_t* OUT = wsp<bf16_t>(p, cb.dir ? W_OB : W_OF);
    const int lrow = tid >> 3, lpart = tid & 7;
    uint4 rw, rq, ra, rk, ru, re; float rtail;
#define G2_GLOAD(n_) do { const size_t nu_ = (size_t)cb.ubase + (n_); \
        rw = *(const uint4*)(wsp<bf16_t>(p, W_GW) + nu_ * 4096 + lrow * 64 + lpart * 8); \
        ra = *(const uint4*)(wsp<bf16_t>(p, W_GAQK) + nu_ * 4096 + lrow * 64 + lpart * 8); \
        rk = *(const uint4*)(wsp<bf16_t>(p, W_GKTT) + nu_ * 4096 + lrow * 64 + lpart * 8); \
        ru = *(const uint4*)(wsp<bf16_t>(p, W_GUV) + nu_ * 4096 + tid * 8); \
        { const int pos_ = (n_) * 64 + lrow; const size_t tk_ = (size_t)cb.seq0 + (cb.dir ? cb.L - 1 - pos_ : pos_); \
          rq = *(const uint4*)(GQ + tk_ * 256 + cb.h * 64 + lpart * 8); } \
        re = *(const uint4*)(wsp<float>(p, W_GEDEC) + nu_ * 64 + (tid & 15) * 4); \
        rtail = wsp<float>(p, W_GTAIL)[nu_]; } while (0)
#define G2_LSTORE(buf_) do { unsigned char* b_ = lds + (buf_) * G2_BUF; \
        *(uint4*)(b_ + lrow * G2_ROW + lpart * 16) = rw; *(uint4*)(b_ + G2_MAT + lrow * G2_ROW + lpart * 16) = rq; \
        *(uint4*)(b_ + 2 * G2_MAT + lrow * G2_ROW + lpart * 16) = ra; *(uint4*)(b_ + 3 * G2_MAT + lrow * G2_ROW + lpart * 16) = rk; \
        *(uint4*)(b_ + G2_UV + tid * 16) = ru; \
        if (tid < 16) *(uint4*)(b_ + G2_ED + tid * 16) = re; if (tid == 16) *(float*)(b_ + G2_ED + 256) = rtail; } while (0)
    __syncthreads();
    G2_GLOAD(0);
    G2_LSTORE(0);
    __syncthreads();
#pragma unroll 1
    for (int n = 0; n < cb.nch; n++) {
        if (n + 1 < cb.nch) G2_GLOAD(n + 1);
        const unsigned char* bb = lds + (n & 1) * G2_BUF;
        bf16x8 sb[2];
#pragma unroll
        for (int s = 0; s < 2; s++) {
            union { unsigned u[4]; bf16x8 v; } cv;
            cv.u[0] = pg8::cvt_pk_bf16(S[2 * s][0], S[2 * s][1]); cv.u[1] = pg8::cvt_pk_bf16(S[2 * s][2], S[2 * s][3]);
            cv.u[2] = pg8::cvt_pk_bf16(S[2 * s + 1][0], S[2 * s + 1][1]); cv.u[3] = pg8::cvt_pk_bf16(S[2 * s + 1][2], S[2 * s + 1][3]);
            sb[s] = cv.v;
        }
        f32x4 uacc[2], oq[2], oa[2];
#pragma unroll
        for (int i = 0; i < 2; i++) {
            const int mt = 2 * mh + i;
            const uint2 uvw = *(const uint2*)(bb + G2_UV + ((nb * 4 + mt) * 64 + lane) * 8);
            uacc[i][0] = __uint_as_float(uvw.x << 16); uacc[i][1] = __uint_as_float(uvw.x & 0xffff0000u);
            uacc[i][2] = __uint_as_float(uvw.y << 16); uacc[i][3] = __uint_as_float(uvw.y & 0xffff0000u);
            oq[i] = (f32x4){p.zf, p.zf, p.zf, p.zf};
            oa[i] = (f32x4){p.zf, p.zf, p.zf, p.zf};
#pragma unroll
            for (int s = 0; s < 2; s++) {
                const bf16x8 wf = *(const bf16x8*)(bb + (16 * mt + fr) * G2_ROW + s * 64 + g * 16);
                const unsigned char* qrow = bb + G2_MAT + (16 * mt + fr) * G2_ROW + s * 64 + g * 8;
                const uint2 qlo = *(const uint2*)(qrow), qhi = *(const uint2*)(qrow + 32);
                union { uint4 u; bf16x8 v; } qf; qf.u = make_uint4(qlo.x, qlo.y, qhi.x, qhi.y);
                uacc[i] = __builtin_amdgcn_mfma_f32_16x16x32_bf16(wf, sb[s], uacc[i], 0, 0, 0);
                oq[i] = __builtin_amdgcn_mfma_f32_16x16x32_bf16(qf.v, sb[s], oq[i], 0, 0, 0);
            }
        }
        union { uint4 u; bf16x8 v; } uown, uoth;
        uown.u = make_uint4(pg8::cvt_pk_bf16(uacc[0][0], uacc[0][1]), pg8::cvt_pk_bf16(uacc[0][2], uacc[0][3]), pg8::cvt_pk_bf16(uacc[1][0], uacc[1][1]), pg8::cvt_pk_bf16(uacc[1][2], uacc[1][3]));
        *(uint4*)(lds + G2_X + ((nb * 2 + mh) * 64 + lane) * 16) = uown.u;
        __syncthreads();
        uoth.u = *(const uint4*)(lds + G2_X + ((nb * 2 + (1 - mh)) * 64 + lane) * 16);
        bf16x8 ub[2];
        ub[0] = mh == 0 ? uown.v : uoth.v;
        ub[1] = mh == 0 ? uoth.v : uown.v;
        const float tail = *(const float*)(bb + G2_ED + 256);
#pragma unroll
        for (int i = 0; i < 2; i++) {
            const int mt = 2 * mh + i;
#pragma unroll
            for (int s = 0; s < 2; s++) {
                const bf16x8 af = *(const bf16x8*)(bb + 2 * G2_MAT + (16 * mt + fr) * G2_ROW + s * 64 + g * 16);
                oa[i] = __builtin_amdgcn_mfma_f32_16x16x32_bf16(af, ub[s], oa[i], 0, 0, 0);
            }
        }
#pragma unroll
        for (int mt = 0; mt < 4; mt++) {
            S[mt] *= tail;
#pragma unroll
            for (int s = 0; s < 2; s++) {
                const bf16x8 kt = *(const bf16x8*)(bb + 3 * G2_MAT + (16 * mt + fr) * G2_ROW + s * 64 + g * 16);
                S[mt] = __builtin_amdgcn_mfma_f32_16x16x32_bf16(kt, ub[s], S[mt], 0, 0, 0);
            }
        }
#pragma unroll
        for (int i = 0; i < 2; i++) {
            const int mt = 2 * mh + i;
            const f32x4 ed = *(const f32x4*)(bb + G2_ED + (16 * mt + 4 * g) * 4);
#pragma unroll
            for (int r = 0; r < 4; r++) {
                const int pos = n * 64 + 16 * mt + 4 * g + r;
                const size_t tk = (size_t)cb.seq0 + (cb.dir ? cb.L - 1 - pos : pos);
                OUT[tk * 256 + cb.h * 64 + 16 * nb + fr] = f2bf(ed[r] * oq[i][r] + oa[i][r]);
            }
        }
        if (n + 1 < cb.nch) G2_LSTORE((n + 1) & 1);
        __syncthreads();
    }
    if (!cb.lat && mh == 0) {
        float* so = p.out + O_ST + ((((size_t)cb.b * 2 + l) * 2 + cb.dir) * 4 + cb.h) * 4096;
#pragma unroll
        for (int mt = 0; mt < 4; mt++)
#pragma unroll
            for (int r = 0; r < 4; r++) so[(16 * mt + 4 * g + r) * 64 + 16 * nb + fr] = S[mt][r];
    }
}

__device__ __forceinline__ void hyprep_unit(const KP& p, int l, int tu  ) {
    const int tok0 = tu * 32;
    const bool lat = tok0 >= TC;
    const int L = lat ? 2048 : 256;
    const int t0 = lat ? ((tok0 - TC) & 2047) : (tok0 & 255);
    const bf16_t* PROJ = wsp<bf16_t>(p, W_PROJ);
    const float* cw = pin(p, I_HCONV) + (size_t)l * 3 * 768;
#pragma unroll 1
    for (int pass = 0; pass < 2; pass++) {
        const int ch = p.tid + 512 * pass;
        if (ch < 768) {
            const float w0 = cw[ch], w1 = cw[768 + ch], w2 = cw[1536 + ch];
            const bf16_t* src = PROJ + (size_t)tok0 * INC + C_HU + ch;
            bf16_t* dst = wsp<bf16_t>(p, ch < 256 ? W_HV : (ch < 512 ? W_HX1 : W_HX2)) + (size_t)(ch & 255) * T + tok0;
            float xr[34];
            xr[0] = (t0 > 0) ? bf2f(src[-INC]) : 0.f;
#pragma unroll
            for (int t = 0; t < 32; t++) xr[t + 1] = bf2f(src[(size_t)t * INC]);
            xr[33] = (t0 + 32 < L) ? bf2f(src[(size_t)32 * INC]) : 0.f;
#pragma unroll
            for (int k8 = 0; k8 < 4; k8++) {
                float y[8];
#pragma unroll
                for (int e = 0; e < 8; e++) { const int t = k8 * 8 + e; y[e] = xr[t] * w0 + xr[t + 1] * w1 + xr[t + 2] * w2; }
                *(uint4*)(dst + k8 * 8) = pack8(y);
            }
        }
    }
}

template <int L, int NBATCH>
__device__ __forceinline__ void hyena_mfma_unit(const KP& p, int l, int c, unsigned char* lds) {
    constexpr int NB = L / 16, HRLEN = L + 48, XOFF = L / 2 + 31, UBL = L + 512, NTW = (L / 256) * NBATCH / 8;
    constexpr bool LAT = (L == 2048);
    const int tid = p.tid, wid = __builtin_amdgcn_readfirstlane(tid >> 6), lane = tid & 63, fr = lane & 15, g = lane >> 4;
    bf16_t* hr = (bf16_t*)lds;
    bf16_t* ubuf = hr + 4 * HRLEN;
    bf16_t* zbuf = ubuf + NBATCH * UBL;
    const bf16_t* HVt = wsp<bf16_t>(p, W_HV) + (size_t)c * T;
    const bf16_t* HX1t = wsp<bf16_t>(p, W_HX1) + (size_t)c * T;
    const bf16_t* HX2t = wsp<bf16_t>(p, W_HX2) + (size_t)c * T;
    bf16_t* YT = wsp<bf16_t>(p, W_YT) + (size_t)c * T;
    const bf16_t* FT = wsp<bf16_t>(p, W_FILT) + (size_t)l * 1179648 + (LAT ? 131072 : 0);
    const int sbase = LAT ? TC : 0;
    __syncthreads();
    { unsigned zz = 0u; asm volatile("" : "+v"(zz)); const uint4 z4 = make_uint4(zz, zz, zz, zz);
      for (int i = tid; i < 2 * NBATCH * UBL / 8; i += NT) ((uint4*)ubuf)[i] = z4; }
    for (int x = tid; x < HRLEN; x += NT) {
#pragma unroll
        for (int o = 0; o < 2; o++) {
            const bf16_t* f = FT + (size_t)(o * 256 + c) * L;
            const int i0 = L + 31 - x, i1 = L + 30 - x;
            hr[(o * 2 + 0) * HRLEN + x] = (i0 >= 0 && i0 < L) ? f[i0] : (bf16_t)0;
            hr[(o * 2 + 1) * HRLEN + x] = (i1 >= 0 && i1 < L) ? f[i1] : (bf16_t)0;
        }
    }
    __syncthreads();
    for (int i = tid; i < NBATCH * L / 8; i += NT) {
        const int bt = i / (L / 8), s8 = i % (L / 8);
        *(uint4*)(ubuf + bt * UBL + 256 + s8 * 8) = *(const uint4*)(HVt + sbase + bt * L + s8 * 8);
    }
    __syncthreads();
    const int i0blk = LAT ? 16 * wid : 0;
    int dlo = -(NB / 2); if (i0blk - NB > dlo) dlo = i0blk - NB;
    int dhi = NB / 2; if (i0blk + 15 < dhi) dhi = i0blk + 15;
    const int P = 1 - (fr & 1);
    const float bias0 = pin(p, I_HBIAS)[(l * 2 + 0) * 256 + c], bias1 = pin(p, I_HBIAS)[(l * 2 + 1) * 256 + c];
#pragma unroll 1
    for (int order = 0; order < 2; order++) {
        const bf16_t* hrp = hr + (order * 2 + P) * HRLEN;
        const bf16_t* ub = order == 0 ? ubuf : zbuf;
        f32x4 acc[NTW];
#pragma unroll
        for (int nt = 0; nt < NTW; nt++) acc[nt] = (f32x4){p.zf, p.zf, p.zf, p.zf};
#pragma unroll 1
        for (int d = dlo; d <= dhi; d += 2) {
            const int x0 = XOFF - 16 * d - 16 * (g >> 1) + 8 * (g & 1) - fr;
            const unsigned* ap = (const unsigned*)(hrp + (x0 - P));
            union { unsigned u[4]; bf16x8 v; } af;
            af.u[0] = ap[0]; af.u[1] = ap[1]; af.u[2] = ap[2]; af.u[3] = ap[3];
            const int uoff = 16 * (i0blk + fr - d - (g >> 1)) + 8 * (g & 1) + 256;
#pragma unroll
            for (int nt = 0; nt < NTW; nt++) {
                const int bt = LAT ? nt : 2 * wid + nt;
                const bf16x8 bf = *(const bf16x8*)(ub + bt * UBL + uoff);
                acc[nt] = __builtin_amdgcn_mfma_f32_16x16x32_bf16(af.v, bf, acc[nt], 0, 0, 0);
            }
        }
        const int t4 = 16 * (i0blk + fr) + 4 * g;
#pragma unroll
        for (int nt = 0; nt < NTW; nt++) {
            const int bt = LAT ? nt : 2 * wid + nt;
            const uint2 uw = *(const uint2*)(ub + bt * UBL + 256 + t4);
            const uint2 xw = *(const uint2*)((order == 0 ? HX1t : HX2t) + sbase + bt * L + t4);
            const float bias = order == 0 ? bias0 : bias1;
            float o0 = __uint_as_float(xw.x << 16) * (acc[nt][0] + __uint_as_float(uw.x << 16) * bias);
            float o1 = __uint_as_float(xw.x & 0xffff0000u) * (acc[nt][1] + __uint_as_float(uw.x & 0xffff0000u) * bias);
            float o2 = __uint_as_float(xw.y << 16) * (acc[nt][2] + __uint_as_float(uw.y << 16) * bias);
            float o3 = __uint_as_float(xw.y & 0xffff0000u) * (acc[nt][3] + __uint_as_float(uw.y & 0xffff0000u) * bias);
            uint2 w;
            w.x = (unsigned)f2bf(o0) | ((unsigned)f2bf(o1) << 16);
            w.y = (unsigned)f2bf(o2) | ((unsigned)f2bf(o3) << 16);
            if (order == 0) *(uint2*)(zbuf + bt * UBL + 256 + t4) = w;
            else *(uint2*)(YT + sbase + bt * L + t4) = w;
        }
        __syncthreads();
    }
}

__device__ __forceinline__ void yt_transpose_unit(const KP& p, int tu, unsigned char* lds) {
    const int tok0 = tu * 64, tid = p.tid;
    bf16_t* tl = (bf16_t*)lds;
    const bf16_t* YT = wsp<bf16_t>(p, W_YT);
    __syncthreads();
#pragma unroll
    for (int i = 0; i < 4; i++) {
        const int idx = tid + i * 512, c = idx >> 3, part = idx & 7;
        const uint4 v = *(const uint4*)(YT + (size_t)c * T + tok0 + part * 8);
        const unsigned w[4] = {v.x, v.y, v.z, v.w};
#pragma unroll
        for (int e = 0; e < 8; e++) tl[(part * 8 + e) * 264 + c] = (bf16_t)((e & 1) ? (w[e >> 1] >> 16) : (w[e >> 1] & 0xffffu));
    }
    __syncthreads();
    bf16_t* O = wsp<bf16_t>(p, W_H);
#pragma unroll
    for (int i = 0; i < 4; i++) {
        const int idx = tid + i * 512, tk = idx >> 5, cp = idx & 31;
        *(uint4*)(O + (size_t)(tok0 + tk) * 1024 + 768 + cp * 8) = *(const uint4*)(tl + tk * 264 + cp * 8);
    }
}

constexpr size_t W_CTR = W_BAR + 14336;
__device__ __forceinline__ int queue_next(const KP& p, int ph, int nvb, unsigned char* lds) {
    volatile __attribute__((address_space(3))) unsigned* w = (volatile __attribute__((address_space(3))) unsigned*)(lds + 131072 + 8);
    __syncthreads();
    if (p.tid == 0) *w = (unsigned)nvb + __hip_atomic_fetch_add((unsigned*)(p.ws + W_CTR) + ph + 32 * p.pad, 1u, __ATOMIC_RELAXED, __HIP_MEMORY_SCOPE_AGENT);
    __syncthreads();
    return (int)*w;
}

__device__ __forceinline__ void mix_a_phase(const KP& p, int l, int vb, int nvb, unsigned char* lds) {
    const int qb = 8 * l;
    for (int u = vb; u < 160; u = queue_next(p, qb + 0, nvb, lds)) { KP q = p; asm volatile("" : "+v"(q.tid)); gdn_g2_unit(q, l, u, lds); }
    for (int u = queue_next(p, qb + 1, 0, lds); u < 192; u = queue_next(p, qb + 1, 0, lds)) { KP q = p; asm volatile("" : "+v"(q.tid));
        const bool lt = u < 128; const int v = lt ? u : u - 128;
        attn_unit<0>(q, l, lt, lt ? v >> 5 : v >> 2, lt ? (v >> 3) & 3 : v & 3, lt ? v & 7 : 0, lds); }
    for (int u = queue_next(p, qb + 2, 0, lds); u < 192; u = queue_next(p, qb + 2, 0, lds)) { KP q = p; asm volatile("" : "+v"(q.tid));
        const bool lt = u < 128; const int v = lt ? u : u - 128;
        attn_unit<1>(q, l, lt, lt ? v >> 5 : v >> 2, lt ? (v >> 3) & 3 : v & 3, lt ? v & 7 : 0, lds); }
    for (int u = queue_next(p, qb + 3, 0, lds); u < 256; u = queue_next(p, qb + 3, 0, lds)) { KP q = p; asm volatile("" : "+v"(q.tid)); hyena_mfma_unit<2048, 4>(q, l, u, lds); }
    for (int u = queue_next(p, qb + 4, 0, lds); u < 256; u = queue_next(p, qb + 4, 0, lds)) { KP q = p; asm volatile("" : "+v"(q.tid)); hyena_mfma_unit<256, 16>(q, l, u, lds); }
}

__device__ __forceinline__ void mix_b_phase(const KP& p, int l, int vb, int nvb, unsigned char* lds) {
    const int wid = p.tid >> 6, lane = p.tid & 63;
    for (int u = vb; u < 192 + 1536; u += nvb) {
        if (u < 192) { yt_transpose_unit(p, u, lds); continue; }
        const size_t tok = (size_t)(u - 192) * 8 + wid;
        const bf16_t* OF = wsp<bf16_t>(p, W_OF); const bf16_t* OB = wsp<bf16_t>(p, W_OB);
        const bf16_t* GZ = wsp<bf16_t>(p, W_GZ);
        bf16_t* O = wsp<bf16_t>(p, W_H);
#pragma unroll
        for (int h = 0; h < 4; h++) {
            float o = bf2f(OF[tok * 256 + h * 64 + lane]) + bf2f(OB[tok * 256 + h * 64 + lane]);
            float ss = wave_sum(o * o);
            float r = rsqrtf(ss * (1.f / 64.f) + EPSV);
            float gz = bf2f(GZ[tok * 256 + h * 64 + lane]);
            O[tok * 1024 + 512 + h * 64 + lane] = f2bf(o * r * pin(p, I_GNORM)[l * 64 + lane] * siluf(gz));
        }
    }
}

__device__ __forceinline__ void tr_job(const KP& p, int l, int r, unsigned char* lds) {
    if (r < 768) tr_unit(pin(p, I_WIN) + (size_t)l * D * INC, wsp<bf16_t>(p, W_WIN) + (size_t)l * INCP * D, D, INC, INCP, r / 48, r % 48, (float*)lds, p.tid);
    else if (r < 1024) { r -= 768; tr_unit(pin(p, I_WOUT) + (size_t)l * D * D, wsp<bf16_t>(p, W_WOUT) + (size_t)l * D * D, D, D, D, r / 16, r % 16, (float*)lds, p.tid); }
    else if (r < 2048) { r -= 1024; tr_unit(pin(p, I_W1) + (size_t)l * D * DFF, wsp<bf16_t>(p, W_W1) + (size_t)l * DFF * D, D, DFF, DFF, r / 64, r % 64, (float*)lds, p.tid); }
    else if (r < 3072) { r -= 2048; tr_unit(pin(p, I_W2) + (size_t)l * DFF * D, wsp<bf16_t>(p, W_W2) + (size_t)l * D * DFF, DFF, D, D, r / 16, r % 16, (float*)lds, p.tid); }
    else { r -= 3072; tr_unit(pin(p, I_WUKV) + (size_t)l * 128 * 512, wsp<bf16_t>(p, W_WUKV) + (size_t)l * 512 * 128, 128, 512, 512, r / 8, r % 8, (float*)lds, p.tid); }
}
struct TrDesc { const float* src; bf16_t* dst; int K, N, Npad, kt, nt; };
__device__ __forceinline__ TrDesc tr_desc(const KP& p, int l, int r) {
    TrDesc d;
    if (r < 768) { d.src = pin(p, I_WIN) + (size_t)l * D * INC; d.dst = wsp<bf16_t>(p, W_WIN) + (size_t)l * INCP * D; d.K = D; d.N = INC; d.Npad = INCP; d.kt = r / 48; d.nt = r % 48; }
    else if (r < 1024) { r -= 768; d.src = pin(p, I_WOUT) + (size_t)l * D * D; d.dst = wsp<bf16_t>(p, W_WOUT) + (size_t)l * D * D; d.K = D; d.N = D; d.Npad = D; d.kt = r / 16; d.nt = r % 16; }
    else if (r < 2048) { r -= 1024; d.src = pin(p, I_W1) + (size_t)l * D * DFF; d.dst = wsp<bf16_t>(p, W_W1) + (size_t)l * DFF * D; d.K = D; d.N = DFF; d.Npad = DFF; d.kt = r / 64; d.nt = r % 64; }
    else { r -= 2048; d.src = pin(p, I_W2) + (size_t)l * DFF * D; d.dst = wsp<bf16_t>(p, W_W2) + (size_t)l * D * DFF; d.K = DFF; d.N = D; d.Npad = D; d.kt = r / 16; d.nt = r % 16; }
    return d;
}
__device__ __forceinline__ void tr_filler(const KP& p, int l, int jlo, int jhi, int first, int vb, int nvb, unsigned char* lds) {
    if (vb < first) return;
    const int tid = p.tid, stride = nvb - first;
    float* tl = (float*)lds;
    for (int j = jlo + (vb - first); j < jhi; j += 4 * stride) {
        f32x4 v[4][2];
        TrDesc d[4];
#pragma unroll
        for (int q = 0; q < 4; q++) {
            const int jq = (j + q * stride < jhi) ? j + q * stride : j;
            d[q] = tr_desc(p, l, jq);
#pragma unroll
            for (int i = 0; i < 2; i++) {
                const int c = tid + i * 512, k = c >> 4, n = d[q].nt * 64 + (c & 15) * 4;
                v[q][i] = (n < d[q].N) ? *(const f32x4*)(d[q].src + (size_t)(d[q].kt * 64 + k) * d[q].N + n) : (f32x4){0.f, 0.f, 0.f, 0.f};
            }
        }
        __syncthreads();
#pragma unroll
        for (int q = 0; q < 4; q++)
#pragma unroll
            for (int i = 0; i < 2; i++) {
                const int c = tid + i * 512, k = c >> 4, n4 = (c & 15) * 4;
                float* t = tl + q * 64 * 65 + k * 65 + n4;
                t[0] = v[q][i][0]; t[1] = v[q][i][1]; t[2] = v[q][i][2]; t[3] = v[q][i][3];
            }
        __syncthreads();
#pragma unroll
        for (int q = 0; q < 4; q++) {
            const int n = tid >> 3, k8 = (tid & 7) * 8, gn = d[q].nt * 64 + n;
            float f[8];
#pragma unroll
            for (int e = 0; e < 8; e++) f[e] = tl[q * 64 * 65 + (k8 + e) * 65 + n];
            if (gn < d[q].Npad) *(uint4*)(d[q].dst + (size_t)gn * d[q].K + d[q].kt * 64 + k8) = pack8(f);
        }
    }
    __syncthreads();
}

__device__ __forceinline__ void phase_a(const KP& p, int vb, int nvb, unsigned char* lds) {
    for (int u = vb; u < 192 + 768 + 32 + 576 + 416 + 192; u += nvb) {
        int v = u;
        if (v < 192) { ada_unit(p, v, (float*)lds); continue; }
        v -= 192;
        if (v < 768) { tr_job(p, 0, v, lds); continue; }
        v -= 768;
        if (v < 32) { tr_job(p, v >> 4, 3072 + (v & 15), lds); continue; }
        v -= 32;
        if (v < 576) { filt_unit(p, v, (float*)lds); continue; }
        v -= 576;
        if (v < 416) { cachecvt_unit(p, v); continue; }
        v -= 416;
        rope_unit(p, v);
    }
}

constexpr int NPH = 23;
__device__ __forceinline__ void run_phase(const KP& p, int ph, int vb, int nvb, unsigned char* lds) {
    if (ph == 0) { phase_a(p, vb, nvb, lds); return; }
    const int l = (ph - 1) / 11, s = (ph - 1) % 11;
    const float* MODl = nullptr; (void)MODl;
    switch (s) {
    case 0:
        if (l == 0) resnorm_phase(p, pin(p, I_XP), pin(p, I_XS), nullptr, nullptr, 0, 0, pin(p, I_GPREMIX), 1024, 0, 0, vb, nvb);
        break;
    case 1:
        gemm8_phase(wsp<bf16_t>(p, W_H), wsp<bf16_t>(p, W_WIN) + (size_t)l * INCP * D, T, INCP, D, pg8::EpiBf16<0>{wsp<bf16_t>(p, W_PROJ), INC, INC}, lds, vb, nvb, p.tid);
        if (l == 0) tr_filler(p, 0, 768, 3072, 64, vb, nvb, lds);
        break;
    case 2:
        prep_phase(p, l, vb, nvb);
        for (int u = vb; u < T / 32; u += nvb) hyprep_unit(p, l, u);
        break;
    case 3:
        for (int u = vb; u < 384; u += nvb) { KP q = p; asm volatile("" : "+v"(q.tid)); gdn_g1_unit(q, l, u, lds); }
        for (int u = (vb + 128) % nvb; u < 224; u += nvb) { KP q = p; asm volatile("" : "+v"(q.tid));
            if (u < 192) gemm_tile<EPI_BF16>(wsp<bf16_t>(p, W_CKVN), 128, wsp<bf16_t>(p, W_WUKV) + (size_t)l * 512 * 128, 128, 128, (u % 48) * 256, (u / 48) * 128, 512, wsp<bf16_t>(p, W_KVX), 512, lds, q.tid);
            else { const int tt = u - 192; gemm_tile<EPI_BF16>(wsp<bf16_t>(p, W_CKVC) + (size_t)l * 2048 * 128, 128, wsp<bf16_t>(p, W_WUKV) + (size_t)l * 512 * 128, 128, 128, (tt & 7) * 256, (tt >> 3) * 128, 512,
                                wsp<bf16_t>(p, W_KVC) + (size_t)l * 2048 * 512, 512, lds, q.tid); } }
        break;
    case 4: mix_a_phase(p, l, vb, nvb, lds); break;
    case 5: mix_b_phase(p, l, vb, nvb, lds); break;
    case 6:
        gemm8_phase(wsp<bf16_t>(p, W_H), wsp<bf16_t>(p, W_WOUT) + (size_t)l * D * D, T, D, D, pg8::EpiBf16<0>{wsp<bf16_t>(p, W_OP), D, D}, lds, vb, nvb, p.tid);
        if (l == 0) tr_filler(p, 1, 0, 640, 192, vb, nvb, lds);
        break;
    case 7: resnorm_phase(p, nullptr, nullptr, wsp<bf16_t>(p, W_OP), pin(p, I_GPOSTMIX) + l * D, 2048, l, pin(p, I_GPREMLP) + l * D, 4096, 3072, l, vb, nvb); break;
    case 8: gemm8_phase(wsp<bf16_t>(p, W_H), wsp<bf16_t>(p, W_W1) + (size_t)l * DFF * D, T, DFF, D, pg8::EpiBf16<1>{wsp<bf16_t>(p, W_HID), DFF, DFF}, lds, vb, nvb, p.tid); break;
    case 9:
        gemm8_phase(wsp<bf16_t>(p, W_HID), wsp<bf16_t>(p, W_W2) + (size_t)l * D * DFF, T, D, DFF, pg8::EpiBf16<0>{wsp<bf16_t>(p, W_M), D, D}, lds, vb, nvb, p.tid);
        if (l == 0) tr_filler(p, 1, 640, 3072, 192, vb, nvb, lds);
        break;
    case 10:
        if (l == 0) resnorm_phase(p, nullptr, nullptr, wsp<bf16_t>(p, W_M), pin(p, I_GPOSTMLP) + l * D, 5120, l, pin(p, I_GPREMIX) + (l + 1) * D, 1024, 0, l + 1, vb, nvb);
        else resnorm_phase(p, nullptr, nullptr, wsp<bf16_t>(p, W_M), pin(p, I_GPOSTMLP) + l * D, 5120, l, nullptr, 0, 0, 0, vb, nvb);
        break;
    }
}


#define XB_TMO      128
#define XB_XCNT(j)  (256  + 64 * (j))
#define XB_XSUB(j)  (1280 + 64 * (j))
#define XB_XGEN(j)  (2304 + 64 * (j))
#define XB_TOP      3328
#define XB_TOPGEN   3392
#define XCD_BAR_WORDS 3456
#define XB_SPIN_CAP (1u << 20)
#define LAS3 __attribute__((address_space(3)))
__device__ __forceinline__ unsigned xb_ld(unsigned* p) { return __hip_atomic_load(p, __ATOMIC_RELAXED, __HIP_MEMORY_SCOPE_AGENT); }
__device__ __forceinline__ unsigned xb_add(unsigned* p, unsigned v) { return __hip_atomic_fetch_add(p, v, __ATOMIC_RELAXED, __HIP_MEMORY_SCOPE_AGENT); }
__device__ __forceinline__ unsigned xb_xcc_id() { return (unsigned)__builtin_amdgcn_s_getreg((3 << 11) | 20) & 0xFu; }
#define XB_SPIN(cond, bar) do { unsigned _sp = 0; while (cond) { __builtin_amdgcn_s_sleep(1); \
    if ((++_sp & 255u) == 0u) { if (xb_ld(&(bar)[XB_TMO])) break; if (_sp > XB_SPIN_CAP) { atomicAdd(&(bar)[XB_TMO], 1u); break; } } } } while (0)
struct XcdBarrier { unsigned* bar; unsigned x; volatile LAS3 unsigned* st; };
__device__ __forceinline__ XcdBarrier xcd_barrier_post(unsigned* bar, volatile LAS3 unsigned* st) {
    XcdBarrier b; b.bar = bar; b.x = xb_xcc_id(); b.st = st;
    if (threadIdx.x == 0) (void)xb_add(&bar[XB_XCNT(b.x)], 1u);
    return b;
}
__device__ __forceinline__ void xcd_barrier_complete(unsigned* bar, unsigned x, unsigned& nloc, unsigned& nx) {
    const unsigned G = gridDim.x * gridDim.y * gridDim.z;
    unsigned sum, cnt, mine, sp = 0u;
    for (;;) {
        sum = 0u; cnt = 0u; mine = 0u;
#pragma unroll
        for (unsigned j = 0; j < 16; ++j) { const unsigned c = xb_ld(&bar[XB_XCNT(j)]); sum += c; cnt += (c > 0u) ? 1u : 0u; mine = (j == x) ? c : mine; }
        if (sum == G) break;
        __builtin_amdgcn_s_sleep(1);
        if ((++sp & 255u) == 0u) { if (xb_ld(&bar[XB_TMO])) break; if (sp > XB_SPIN_CAP) { atomicAdd(&bar[XB_TMO], 1u); break; } }
    }
    nloc = mine > 0u ? mine : 1u; nx = cnt > 0u ? cnt : 1u;
}
__device__ __forceinline__ void xcd_barrier(const XcdBarrier& b) {
    asm volatile("s_waitcnt vmcnt(0)" ::: "memory");
    __syncthreads();
    if (threadIdx.x == 0) {
        unsigned* bar = b.bar;
        __builtin_amdgcn_s_waitcnt(0);
        unsigned nloc = b.st[0], nx = b.st[1];
        if (nloc == 0u) { xcd_barrier_complete(bar, b.x, nloc, nx); b.st[0] = nloc; b.st[1] = nx; }
        const unsigned old = xb_add(&bar[XB_XSUB(b.x)], 1u);
        const unsigned gen = old / nloc;
        if (old + 1u == (gen + 1u) * nloc) {
            __builtin_amdgcn_fence(__ATOMIC_RELEASE, "agent");
            asm volatile("s_waitcnt vmcnt(0)" ::: "memory");
            const unsigned og = xb_add(&bar[XB_TOP], 1u);
            const unsigned tg = og / nx;
            if (og + 1u == (tg + 1u) * nx) xb_add(&bar[XB_TOPGEN], 1u);
            else XB_SPIN(xb_ld(&bar[XB_TOPGEN]) == tg, bar);
            __builtin_amdgcn_fence(__ATOMIC_ACQUIRE, "agent");
            xb_add(&bar[XB_XGEN(b.x)], 1u);
            asm volatile("s_waitcnt vmcnt(0)" ::: "memory");
        } else {
            XB_SPIN(xb_ld(&bar[XB_XGEN(b.x)]) == gen, bar);
            __builtin_amdgcn_fence(__ATOMIC_ACQUIRE, "agent");
            asm volatile("s_waitcnt vmcnt(0)" ::: "memory");
        }
    }
    __syncthreads();
}

__global__ void __launch_bounds__(NT) trunk_kernel(KP p) {
    __shared__ __attribute__((aligned(16))) unsigned char lds[131072 + 16];
    cg::grid_group grid = cg::this_grid();
    volatile LAS3 unsigned* st = (volatile LAS3 unsigned*)(lds + 131072);
    if (threadIdx.x == 0) { st[0] = 0u; st[1] = 0u; st[2] = 0u; st[3] = 0u; }
    __syncthreads();
    XcdBarrier xb = xcd_barrier_post((unsigned*)(p.ws + W_BAR), st);
#ifdef PROBE_REPEAT
    int rep = 0;
    for (int ph = p.ph_lo; ph < p.ph_hi; ph++) {
        KP q = p;
        q.tid = threadIdx.x;
        q.pad = rep;
        asm volatile("" : "+v"(q.tid));
        asm volatile("" : "+s"(q.ws), "+s"(q.out));
        q.zoff = 0; asm volatile("" : "+s"(q.zoff));
        q.zf = 0.f; asm volatile("" : "+v"(q.zf));
        int vbq = blockIdx.x, nvbq = gridDim.x; asm volatile("" : "+s"(vbq), "+s"(nvbq));
        run_phase(q, ph, vbq, nvbq, lds);
        if (ph + 1 < p.ph_hi) xcd_barrier(xb);
        if (PROBE_REPEAT(ph) && !rep) { rep = 1; ph--; } else rep = 0;
    }
#else
#pragma unroll
    for (int ph = 0; ph < NPH; ph++) {
        KP q = p;
        q.tid = threadIdx.x;
        asm volatile("" : "+v"(q.tid));
        asm volatile("" : "+s"(q.ws), "+s"(q.out));
        q.zoff = 0; asm volatile("" : "+s"(q.zoff));
        q.zf = 0.f; asm volatile("" : "+v"(q.zf));
        int vbq = blockIdx.x, nvbq = gridDim.x; asm volatile("" : "+s"(vbq), "+s"(nvbq));
        run_phase(q, ph, vbq, nvbq, lds);
        if (ph + 1 < NPH) {
            int hh = q.ph_hi; asm volatile("" : "+s"(hh));
            if (hh > 4096) grid.sync();
            else xcd_barrier(xb);
        }
    }
#endif
}

extern "C" void kernel_launch(void* const* d_in, const int* in_sizes, int n_in, void* d_out, int out_size, void* d_ws, size_t ws_size, hipStream_t stream) {
    static int grid_blocks = 0;
    if (!grid_blocks) {
        int dev = 0, cus = 0, per_cu = 0;
        hipGetDevice(&dev);
        hipDeviceGetAttribute(&cus, hipDeviceAttributeMultiprocessorCount, dev);
        hipOccupancyMaxActiveBlocksPerMultiprocessor(&per_cu, trunk_kernel, NT, 0);
        if (per_cu < 1) per_cu = 1;
        if (per_cu > 1) per_cu = 1;
        grid_blocks = cus * per_cu;
    }
    KP p{};
    for (int i = 0; i < N_IN; i++) p.in[i] = (const float*)d_in[i];
    p.out = (float*)d_out;
    p.ws = (unsigned char*)d_ws;
    p.ph_lo = 0; p.ph_hi = NPH;
    (void)hipMemsetAsync((unsigned char*)d_ws + W_BAR, 0, 16384, stream);
    void* args[] = {&p};
    hipError_t e = hipLaunchCooperativeKernel((void*)trunk_kernel, dim3(grid_blocks), dim3(NT), args, 0, stream);
    if (e != hipSuccess) fprintf(stderr, "cooperative launch failed: %s (grid %d)\n", hipGetErrorString(e), grid_blocks);
}
```
